# Optimizing an MI355X kernel written in HIP

```python
import math
import jax
import jax.numpy as jnp
from jax import lax
import numpy as np

D_MODEL = 1024
BATCH = 8
SEQ = 4096
DEPTH = 2

D_MIX = D_MODEL
N_MIXERS = 4
G_WIDTH = D_MIX // N_MIXERS
HEAD_DIM = 64
G_HEADS = G_WIDTH // HEAD_DIM
N_DIR = 2
CONV_K = 4
LRU_BLOCKS = G_HEADS
LRU_C = 8.0
CHUNK = 64
GATE_CAP = 15.0
RWKV_W_RANK = 32
RWKV_A_RANK = 32
RWKV_G_RANK = 64
RWKV_GN_EPS = 64e-5
RMS_EPS = 1e-6
D_FF = -(-(8 * D_MODEL) // (3 * 256)) * 256

A_COLS = 2 * G_WIDTH
B_COLS = 4 * G_WIDTH + 2 * N_DIR * G_HEADS
C_COLS = 4 * G_WIDTH + 2 * N_DIR * G_HEADS
D_COLS = 3 * G_WIDTH + N_DIR * RWKV_W_RANK + N_DIR * RWKV_A_RANK + RWKV_G_RANK
P_IN = A_COLS + B_COLS + C_COLS + D_COLS

kernel_name = 'hymba_style_bidir_hybrid_block'


def rms_norm(x, g, eps=RMS_EPS):
    xf = x.astype(jnp.float32)
    y = xf * lax.rsqrt(jnp.mean(xf * xf, axis=-1, keepdims=True) + eps)
    return (y * g.astype(jnp.float32)).astype(x.dtype)


def head_rms(x, eps=RMS_EPS):
    return x * lax.rsqrt(jnp.mean(x * x, axis=-1, keepdims=True) + eps)


def l2_normalize(x, eps=1e-6):
    return x * lax.rsqrt(jnp.sum(x * x, axis=-1, keepdims=True) + eps)


def soft_cap(x):
    return GATE_CAP * jnp.tanh(x / GATE_CAP)


def flip_seq(t):
    return jnp.flip(t, axis=1)


def split_heads(t):
    return t.reshape(*t.shape[:-1], G_HEADS, HEAD_DIM)


def conv_centred(x, w):
    k_w, ch = w.shape
    return lax.conv_general_dilated(
        x, w[:, None, :].astype(x.dtype), window_strides=(1,),
        padding=[(k_w // 2, k_w - 1 - k_w // 2)],
        dimension_numbers=('NWC', 'WIO', 'NWC'), feature_group_count=ch)


def to_chunks(t, size):
    bsz, seq, nh = t.shape[:3]
    t = t.reshape(bsz, seq // size, size, nh, *t.shape[3:])
    return jnp.moveaxis(t, 3, 1)


def from_chunks(o):
    nc, bsz, nh, size, d = o.shape
    return jnp.transpose(o, (1, 0, 3, 2, 4)).reshape(bsz, nc * size, nh, d)


def linear_scan(a, b, reverse):
    def combine(left, right):
        return left[0] * right[0], right[0] * left[1] + right[1]
    return lax.associative_scan(combine, (a, b), reverse=reverse, axis=1)[1]


def rglru_mixer(u, conv_w, conv_b, gate_w, gate_b, lam):
    bsz, seq, _ = u.shape
    xb, yb = jnp.split(u, 2, axis=-1)
    xc = conv_centred(xb, conv_w) + conv_b
    xr = xc.reshape(bsz, seq, LRU_BLOCKS, G_WIDTH // LRU_BLOCKS)
    pre = jnp.einsum('bsni,dgnio->bsdgno', xr, gate_w).reshape(bsz, seq, N_DIR, 2, G_WIDTH) + gate_b
    r = jax.nn.sigmoid(pre[:, :, :, 0])
    i = jax.nn.sigmoid(pre[:, :, :, 1])
    log_a = -LRU_C * r * jax.nn.softplus(-lam)
    a = jnp.exp(log_a)
    b = jnp.sqrt(-jnp.expm1(2.0 * log_a)) * i * xc[:, :, None, :]
    h = linear_scan(a[:, :, 0], b[:, :, 0], False) + linear_scan(a[:, :, 1], b[:, :, 1], True)
    return h * jax.nn.gelu(yb)


def gated_delta_chunked(q, k, v, g, beta):
    dk = q.shape[-1]
    dv = v.shape[-1]
    q = q * dk ** -0.5
    q, k, v = (to_chunks(t, CHUNK) for t in (q, k, v))
    g, beta = (to_chunks(t, CHUNK) for t in (g, beta))
    gc = jnp.cumsum(g, axis=-1)
    tri = jnp.tril(jnp.ones((CHUNK, CHUNK), bool))
    strict = jnp.tril(jnp.ones((CHUNK, CHUNK), bool), -1)
    decay = jnp.exp(jnp.where(tri, gc[..., :, None] - gc[..., None, :], -jnp.inf))
    kb = k * beta[..., None]
    lower = jnp.where(strict, jnp.einsum('bhcld,bhcmd->bhclm', kb, k) * decay, 0.0)
    a_mat = lower + jnp.eye(CHUNK, dtype=lower.dtype)
    rhs = jnp.concatenate([v * beta[..., None], kb * jnp.exp(gc)[..., None]], axis=-1)
    sol = lax.linalg.triangular_solve(a_mat, rhs, left_side=True, lower=True, unit_diagonal=True)
    u_c, w_c = sol[..., :dv], sol[..., dv:]
    qk = jnp.einsum('bhcld,bhcmd->bhclm', q, k) * decay
    xs = tuple(jnp.moveaxis(t, 2, 0) for t in (q, k, u_c, w_c, qk, gc))

    def step(state, inp):
        q_c, k_c, u_i, w_i, qk_c, g_c = inp
        v_new = u_i - jnp.einsum('bhlk,bhkv->bhlv', w_i, state)
        o = (jnp.einsum('bhlk,bhkv->bhlv', q_c * jnp.exp(g_c)[..., None], state)
             + jnp.einsum('bhlm,bhmv->bhlv', qk_c, v_new))
        g_last = g_c[..., -1]
        state = (state * jnp.exp(g_last)[..., None, None]
                 + jnp.einsum('bhlk,bhlv->bhkv', k_c * jnp.exp(g_last[..., None] - g_c)[..., None], v_new))
        return state, o

    bsz, nh = q.shape[:2]
    s0 = jnp.zeros((bsz, nh, dk, dv), jnp.float32)
    _, o = lax.scan(step, s0, xs)
    return from_chunks(o)


def gdn_mixer(u, conv_w, a_log, dt_bias, norm_g):
    bsz, seq, _ = u.shape
    nh = N_DIR * G_HEADS
    qkv, z, alpha, beta = jnp.split(u, [3 * G_WIDTH, 4 * G_WIDTH, 4 * G_WIDTH + nh], axis=-1)
    qkv = jax.nn.silu(conv_centred(qkv, conv_w))
    q, k, v = (split_heads(t) for t in jnp.split(qkv, 3, axis=-1))
    q, k = l2_normalize(q), l2_normalize(k)
    g = -jnp.exp(a_log) * jax.nn.softplus(alpha.reshape(bsz, seq, N_DIR, G_HEADS) + dt_bias)
    beta = jax.nn.sigmoid(beta.reshape(bsz, seq, N_DIR, G_HEADS))
    o_f = gated_delta_chunked(q, k, v, g[:, :, 0], beta[:, :, 0])
    o_b = flip_seq(gated_delta_chunked(flip_seq(q), flip_seq(k), flip_seq(v),
                                       flip_seq(g[:, :, 1]), flip_seq(beta[:, :, 1])))
    o = head_rms(o_f + o_b) * norm_g * jax.nn.silu(split_heads(z))
    return o.reshape(bsz, seq, G_WIDTH)


def mlstm_chunked(q, k, v, ig, lf):
    dk = q.shape[-1]
    dv = v.shape[-1]
    k = k * dk ** -0.5
    q, k, v = (to_chunks(t, CHUNK) for t in (q, k, v))
    ig, lf = (to_chunks(t, CHUNK) for t in (ig, lf))
    b = jnp.cumsum(lf, axis=-1)
    tri = jnp.tril(jnp.ones((CHUNK, CHUNK), bool))
    d_log = jnp.where(tri, b[..., :, None] - b[..., None, :] + ig[..., None, :], -jnp.inf)
    d_max = jnp.max(d_log, axis=-1)
    qk = jnp.einsum('bhcld,bhcmd->bhclm', q, k)
    w_end = b[..., -1:] - b + ig
    w_end_max = jnp.max(w_end, axis=-1)
    xs = tuple(jnp.moveaxis(t, 2, 0) for t in (q, k, v, b, d_log, d_max, qk, w_end, w_end_max))

    def step(carry, inp):
        c_st, n_st, m_st = carry
        q_c, k_c, v_c, b_c, dl_c, dm_c, qk_c, we_c, wem_c = inp
        inter = b_c + m_st[..., None]
        m_t = jnp.maximum(inter, dm_c)
        p = qk_c * jnp.exp(dl_c - m_t[..., None])
        s_inter = jnp.exp(inter - m_t)
        num = (jnp.einsum('bhlm,bhmd->bhld', p, v_c)
               + s_inter[..., None] * jnp.einsum('bhlk,bhkv->bhlv', q_c, c_st))
        den = jnp.sum(p, axis=-1) + s_inter * jnp.einsum('bhlk,bhk->bhl', q_c, n_st)
        h = num / jnp.maximum(jnp.abs(den), jnp.exp(-m_t))[..., None]
        m_new = jnp.maximum(b_c[..., -1] + m_st, wem_c)
        dec = jnp.exp(b_c[..., -1] + m_st - m_new)
        sc = jnp.exp(we_c - m_new[..., None])
        c_st = dec[..., None, None] * c_st + jnp.einsum('bhl,bhlk,bhlv->bhkv', sc, k_c, v_c)
        n_st = dec[..., None] * n_st + jnp.einsum('bhl,bhlk->bhk', sc, k_c)
        return (c_st, n_st, m_new), h

    bsz, nh = q.shape[:2]
    init = (jnp.zeros((bsz, nh, dk, dv), jnp.float32),
            jnp.zeros((bsz, nh, dk), jnp.float32),
            jnp.zeros((bsz, nh), jnp.float32))
    _, h = lax.scan(step, init, xs)
    return from_chunks(h)


def mlstm_mixer(u, gate_bias, norm_g):
    bsz, seq, _ = u.shape
    nh = N_DIR * G_HEADS
    q, k, v, o, gi, gf = jnp.split(
        u, [G_WIDTH, 2 * G_WIDTH, 3 * G_WIDTH, 4 * G_WIDTH, 4 * G_WIDTH + nh], axis=-1)
    q, k, v = split_heads(q), split_heads(k), split_heads(v)
    ig = soft_cap(gi.reshape(bsz, seq, N_DIR, G_HEADS) + gate_bias[:, 0])
    lf = jax.nn.log_sigmoid(soft_cap(gf.reshape(bsz, seq, N_DIR, G_HEADS) + gate_bias[:, 1]))
    h_f = mlstm_chunked(q, k, v, ig[:, :, 0], lf[:, :, 0])
    h_b = flip_seq(mlstm_chunked(flip_seq(q), flip_seq(k), flip_seq(v),
                                 flip_seq(ig[:, :, 1]), flip_seq(lf[:, :, 1])))
    h = head_rms(h_f + h_b) * split_heads(norm_g) * jax.nn.sigmoid(split_heads(o))
    return h.reshape(bsz, seq, G_WIDTH)


def rwkv_scan(r, w, k, v, kk, a, reverse):
    bsz, _, nh, d = r.shape

    def step(state, inp):
        r_t, w_t, k_t, v_t, kk_t, a_t = inp
        sa = jnp.einsum('bhij,bhj->bhi', state, -kk_t)
        state = (state * w_t[:, :, None, :] + sa[..., None] * (kk_t * a_t)[:, :, None, :]
                 + v_t[..., None] * k_t[:, :, None, :])
        return state, jnp.einsum('bhij,bhj->bhi', state, r_t)

    s0 = jnp.zeros((bsz, nh, d, d), jnp.float32)
    xs = tuple(jnp.moveaxis(t, 1, 0) for t in (r, w, k, v, kk, a))
    _, y = lax.scan(step, s0, xs, reverse=reverse)
    return jnp.moveaxis(y, 0, 1)


def rwkv_mixer(u, mu, w0, w_up, a0, a_up, g_up, k_k, k_a, r_k, gn_w, gn_b):
    bsz, seq, _ = u.shape
    u_prev = jnp.pad(u, ((0, 0), (1, 0), (0, 0)))[:, :-1]
    u_next = jnp.pad(u, ((0, 0), (0, 1), (0, 0)))[:, 1:]
    u = u + mu[0] * (u_prev - u) + mu[1] * (u_next - u)
    c1 = 3 * G_WIDTH + N_DIR * RWKV_W_RANK
    c2 = c1 + N_DIR * RWKV_A_RANK
    r, k, v, wd, ad, gd = jnp.split(u, [G_WIDTH, 2 * G_WIDTH, 3 * G_WIDTH, c1, c2], axis=-1)
    wd = wd.reshape(bsz, seq, N_DIR, RWKV_W_RANK)
    ad = ad.reshape(bsz, seq, N_DIR, RWKV_A_RANK)
    z_w = w0 + jnp.einsum('bsnr,nrc->bsnc', jnp.tanh(wd), w_up)
    w = jnp.exp(-jnp.exp(-jax.nn.softplus(-z_w) - 0.5))
    a = jax.nn.sigmoid(a0 + jnp.einsum('bsnr,nrc->bsnc', ad, a_up))
    gate = jnp.einsum('bsr,rc->bsc', jax.nn.sigmoid(gd), g_up)
    kk = l2_normalize(split_heads(k * k_k))
    k_dir = k[:, :, None, :] * (1.0 + (a - 1.0) * k_a)
    rh, vh = split_heads(r), split_heads(v)
    y_f = rwkv_scan(rh, split_heads(w[:, :, 0]), split_heads(k_dir[:, :, 0]), vh, kk,
                    split_heads(a[:, :, 0]), False)
    y_b = rwkv_scan(rh, split_heads(w[:, :, 1]), split_heads(k_dir[:, :, 1]), vh, kk,
                    split_heads(a[:, :, 1]), True)
    y = y_f + y_b
    mean = jnp.mean(y, axis=-1, keepdims=True)
    var = jnp.mean(jnp.square(y - mean), axis=-1, keepdims=True)
    y = (y - mean) * lax.rsqrt(var + RWKV_GN_EPS) * split_heads(gn_w) + split_heads(gn_b)
    bonus = jnp.sum(rh * split_heads(k) * r_k, axis=-1, keepdims=True) * vh
    return (y + bonus).reshape(bsz, seq, G_WIDTH) * gate


def hybrid_layer(x, n_mix_pre, n_mix_post, n_ffn_pre, n_ffn_post, w_in, w_out,
                 lru_conv_w, lru_conv_b, lru_gate_w, lru_gate_b, lru_lambda,
                 gdn_conv_w, gdn_a_log, gdn_dt_bias, gdn_norm,
                 mlstm_gate_bias, mlstm_norm,
                 rwkv_mu, rwkv_w0, rwkv_w_up, rwkv_a0, rwkv_a_up, rwkv_g_up,
                 rwkv_k_k, rwkv_k_a, rwkv_r_k, rwkv_gn_w, rwkv_gn_b,
                 ffn_w_in, ffn_w_out):
    h = rms_norm(x, n_mix_pre)
    u = jnp.einsum('bsd,dp->bsp', h, w_in).astype(jnp.float32)
    u_a, u_b, u_c, u_d = jnp.split(u, [A_COLS, A_COLS + B_COLS, A_COLS + B_COLS + C_COLS], axis=-1)
    y = jnp.concatenate([
        rglru_mixer(u_a, lru_conv_w, lru_conv_b, lru_gate_w, lru_gate_b, lru_lambda),
        gdn_mixer(u_b, gdn_conv_w, gdn_a_log, gdn_dt_bias, gdn_norm),
        mlstm_mixer(u_c, mlstm_gate_bias, mlstm_norm),
        rwkv_mixer(u_d, rwkv_mu, rwkv_w0, rwkv_w_up, rwkv_a0, rwkv_a_up, rwkv_g_up,
                   rwkv_k_k, rwkv_k_a, rwkv_r_k, rwkv_gn_w, rwkv_gn_b),
    ], axis=-1).astype(x.dtype)
    x = x + rms_norm(jnp.einsum('bsm,md->bsd', y, w_out), n_mix_post)
    h = rms_norm(x, n_ffn_pre)
    gate, up = jnp.split(jnp.einsum('bsd,df->bsf', h, ffn_w_in), 2, axis=-1)
    ff = jnp.einsum('bsf,fd->bsd', jax.nn.silu(gate) * up, ffn_w_out)
    return x + rms_norm(ff, n_ffn_post)


def setup_inputs(seed: int = 0) -> dict:
    key = jax.random.key(seed)
    ks = iter(jax.random.split(key, 40))
    L = DEPTH

    def nrm(shape, scale):
        return scale * jax.random.normal(next(ks), shape, jnp.float32)

    def uni(shape, lo, hi):
        return jax.random.uniform(next(ks), shape, jnp.float32, lo, hi)

    def gain(shape):
        return 1.0 + nrm(shape, 0.02)

    x = nrm((BATCH, SEQ, D_MODEL), 1.0)
    a_init = uni((L, N_DIR, G_WIDTH), 0.9, 0.999)
    dt = jnp.exp(uni((L, N_DIR, G_HEADS), math.log(1e-3), math.log(1e-1)))
    mlstm_gate_bias = jnp.stack([nrm((L, N_DIR, G_HEADS), 0.1),
                                 uni((L, N_DIR, G_HEADS), 3.0, 6.0)], axis=2)
    bw = G_WIDTH // LRU_BLOCKS
    return {
        'x': x,
        'norm_mix_pre': gain((L, D_MODEL)),
        'norm_mix_post': gain((L, D_MODEL)),
        'norm_ffn_pre': gain((L, D_MODEL)),
        'norm_ffn_post': gain((L, D_MODEL)),
        'w_in': nrm((L, D_MODEL, P_IN), D_MODEL ** -0.5),
        'w_out': nrm((L, D_MIX, D_MODEL), D_MIX ** -0.5),
        'lru_conv_w': nrm((L, CONV_K, G_WIDTH), CONV_K ** -0.5),
        'lru_conv_b': nrm((L, G_WIDTH), 0.02),
        'lru_gate_w': nrm((L, N_DIR, 2, LRU_BLOCKS, bw, bw), bw ** -0.5),
        'lru_gate_b': nrm((L, N_DIR, 2, G_WIDTH), 0.02),
        'lru_lambda': jnp.log(a_init) - jnp.log1p(-a_init),
        'gdn_conv_w': nrm((L, CONV_K, 3 * G_WIDTH), CONV_K ** -0.5),
        'gdn_a_log': jnp.log(uni((L, N_DIR, G_HEADS), 1.0, 16.0)),
        'gdn_dt_bias': dt + jnp.log(-jnp.expm1(-dt)),
        'gdn_norm': gain((L, HEAD_DIM)),
        'mlstm_gate_bias': mlstm_gate_bias,
        'mlstm_norm': gain((L, G_WIDTH)),
        'rwkv_mu': uni((L, 2, D_COLS), 0.0, 0.5),
        'rwkv_w0': uni((L, N_DIR, G_WIDTH), -6.0, 1.0),
        'rwkv_w_up': nrm((L, N_DIR, RWKV_W_RANK, G_WIDTH), 0.1 * RWKV_W_RANK ** -0.5),
        'rwkv_a0': nrm((L, N_DIR, G_WIDTH), 0.1),
        'rwkv_a_up': nrm((L, N_DIR, RWKV_A_RANK, G_WIDTH), 0.1 * RWKV_A_RANK ** -0.5),
        'rwkv_g_up': nrm((L, RWKV_G_RANK, G_WIDTH), RWKV_G_RANK ** -0.5),
        'rwkv_k_k': 0.85 + nrm((L, G_WIDTH), 0.02),
        'rwkv_k_a': gain((L, G_WIDTH)),
        'rwkv_r_k': nrm((L, G_HEADS, HEAD_DIM), 0.1),
        'rwkv_gn_w': gain((L, G_WIDTH)),
        'rwkv_gn_b': nrm((L, G_WIDTH), 0.02),
        'ffn_w_in': nrm((L, D_MODEL, 2 * D_FF), D_MODEL ** -0.5),
        'ffn_w_out': nrm((L, D_FF, D_MODEL), D_FF ** -0.5),
    }


def reference(x, norm_mix_pre, norm_mix_post, norm_ffn_pre, norm_ffn_post, w_in, w_out,
              lru_conv_w, lru_conv_b, lru_gate_w, lru_gate_b, lru_lambda,
              gdn_conv_w, gdn_a_log, gdn_dt_bias, gdn_norm,
              mlstm_gate_bias, mlstm_norm,
              rwkv_mu, rwkv_w0, rwkv_w_up, rwkv_a0, rwkv_a_up, rwkv_g_up,
              rwkv_k_k, rwkv_k_a, rwkv_r_k, rwkv_gn_w, rwkv_gn_b,
              ffn_w_in, ffn_w_out):
    for l in range(DEPTH):
        x = hybrid_layer(
            x, norm_mix_pre[l], norm_mix_post[l], norm_ffn_pre[l], norm_ffn_post[l], w_in[l], w_out[l],
            lru_conv_w[l], lru_conv_b[l], lru_gate_w[l], lru_gate_b[l], lru_lambda[l],
            gdn_conv_w[l], gdn_a_log[l], gdn_dt_bias[l], gdn_norm[l],
            mlstm_gate_bias[l], mlstm_norm[l],
            rwkv_mu[l], rwkv_w0[l], rwkv_w_up[l], rwkv_a0[l], rwkv_a_up[l], rwkv_g_up[l],
            rwkv_k_k[l], rwkv_k_a[l], rwkv_r_k[l], rwkv_gn_w[l], rwkv_gn_b[l],
            ffn_w_in[l], ffn_w_out[l])
    return x
```

```cpp
#include <hip/hip_runtime.h>
#include <hip/hip_cooperative_groups.h>
#include <cstdio>
namespace cg = cooperative_groups;

#define LAS __attribute__((address_space(3)))
typedef unsigned short bf16_t;
typedef short bf16x8 __attribute__((ext_vector_type(8)));
typedef float f32x4 __attribute__((ext_vector_type(4)));
typedef float f32x2 __attribute__((ext_vector_type(2)));
typedef unsigned u32x4 __attribute__((ext_vector_type(4)));
typedef unsigned u32x2 __attribute__((ext_vector_type(2)));

constexpr int T_TOK = 32768, SEQ = 4096, DM = 1024, NU = 3328, NGATE = 256, NIN = 3584, DFF = 2816, NSC = 2048;
constexpr int LDS_BYTES = 131072;
constexpr size_t WS_WIN = 0;
constexpr size_t WS_WOUT = WS_WIN + (size_t)2 * NIN * DM * 2;
constexpr size_t WS_WF1 = WS_WOUT + (size_t)2 * DM * DM * 2;
constexpr size_t WS_WF2 = WS_WF1 + (size_t)2 * 2 * DFF * DM * 2;
constexpr size_t WS_U = WS_WF2 + (size_t)2 * DM * DFF * 2;
constexpr size_t WS_G = WS_U + (size_t)T_TOK * NU * 2;
constexpr size_t WS_ACT = WS_G + (size_t)T_TOK * NGATE * 4;
constexpr size_t WS_SC = WS_ACT + (size_t)T_TOK * DM * 2;
constexpr size_t WS_END = WS_SC + (size_t)T_TOK * NSC * 2;

struct Params { const float* in[31]; float* out; unsigned char* ws; int ph_lo, ph_hi; };

__device__ __forceinline__ int otid() { int t = threadIdx.x; asm volatile("" : "+v"(t)); return t; }
__device__ __forceinline__ int obid() { int t = blockIdx.x; asm volatile("" : "+s"(t)); return t; }
__device__ __forceinline__ float bf2f(unsigned short b) { return __uint_as_float(((unsigned)b) << 16); }
__device__ __forceinline__ unsigned short f2bf(float f) { unsigned u = __float_as_uint(f); u += 0x7FFFu + ((u >> 16) & 1u); return (unsigned short)(u >> 16); }
__device__ __forceinline__ unsigned pk2(float lo, float hi) { return (unsigned)f2bf(lo) | ((unsigned)f2bf(hi) << 16); }
__device__ __forceinline__ f32x4 ld4bf(const bf16_t* p) {
    const u32x2 v = *(const u32x2*)p; f32x4 r;
    r.x = __uint_as_float(v.x << 16); r.y = __uint_as_float(v.x & 0xffff0000u); r.z = __uint_as_float(v.y << 16); r.w = __uint_as_float(v.y & 0xffff0000u); return r;
}
__device__ __forceinline__ void st4bf(bf16_t* p, f32x4 v) { u32x2 o; o.x = pk2(v.x, v.y); o.y = pk2(v.z, v.w); *(u32x2*)p = o; }
__device__ __forceinline__ float sigmoidf_(float x) { return 1.f / (1.f + __expf(-x)); }
__device__ __forceinline__ float siluf_(float x) { return x / (1.f + __expf(-x)); }
__device__ __forceinline__ float softplusf_(float x) { return fmaxf(x, 0.f) + log1pf(__expf(-fabsf(x))); }
__device__ __forceinline__ float gelu_tanh(float x) { const float u = 0.7978845608028654f * (x + 0.044715f * x * x * x); return 0.5f * x * (1.f + tanhf(u)); }
__device__ __forceinline__ float hsum4(f32x4 v) { return (v.x + v.y) + (v.z + v.w); }
__device__ __forceinline__ float red16(float v) { v += __shfl_xor(v, 1); v += __shfl_xor(v, 2); v += __shfl_xor(v, 4); v += __shfl_xor(v, 8); return v; }
__device__ __forceinline__ float red64(float v) { v = red16(v); v += __shfl_xor(v, 16); v += __shfl_xor(v, 32); return v; }
template <int CTRL> __device__ __forceinline__ float dppf(float x) { return __int_as_float(__builtin_amdgcn_update_dpp(0, __float_as_int(x), CTRL, 0xF, 0xF, true)); }
__device__ __forceinline__ float sum4l(float x) { x += dppf<0xB1>(x); x += dppf<0x4E>(x); return x; }
__device__ __forceinline__ unsigned cvt_pk_bf16(float lo, float hi) { unsigned r; asm volatile("v_cvt_pk_bf16_f32 %0, %1, %2" : "=v"(r) : "v"(lo), "v"(hi)); return r; }

namespace pg8 {
constexpr int BM = 256, BK = 64, HALF = 128, HTB = HALF * BK * 2, STAGE_BYTES = 8 * HTB, NXCD = 8, WGM = 8;
__device__ __forceinline__ int lds_byte(int r, int c) { const int st = (r >> 4) * 2 + (c >> 5), rr = r & 15, cc = c & 31, ob = rr * 64 + cc * 2; return st * 1024 + (ob ^ (((ob >> 9) & 1) << 5)); }
__device__ __forceinline__ void stage_rc(int b, int& R, int& C) { const int st = b / 1024, sb = b % 1024, swz = sb ^ (((sb >> 9) & 1) << 5); R = (st >> 1) * 16 + swz / 64; C = (st & 1) * 32 + (swz % 64) / 2; }
__device__ __forceinline__ int perm32(int rho) { const int n = rho >> 4, i = rho & 15; return 8 * (i >> 2) + 4 * n + (i & 3); }
struct Unit { int pm, pn; };
struct Gemm { const bf16_t* A; const bf16_t* Bt; int M, N, K; };
struct StaticOrder {
    int nM, nN, nwg, G, c;
    __device__ void init(int M, int N, int G_, int c_) { nM = M / BM; nN = N / BM; nwg = nM * nN; G = G_; c = c_; }
    __device__ bool next(int i, Unit& u) const {
        const long L = (long)i * G + c; if (L >= nwg) return false;
        int wgid = (int)L; { const int q = nwg / NXCD, r = nwg % NXCD, xcd = wgid % NXCD, off = wgid / NXCD; wgid = (xcd < r ? xcd * (q + 1) : r * (q + 1) + (xcd - r) * q) + off; }
        const int nig = WGM * nN, gid = wgid / nig, fm = gid * WGM, gsz = (nM - fm) < WGM ? (nM - fm) : WGM;
        u.pm = fm + ((wgid % nig) % gsz); u.pn = (wgid % nig) / gsz; return true;
    }
};
struct EpiF32 {
    static constexpr bool PERM = false;
    float* C; int ldc;
    __device__ __forceinline__ void operator()(const f32x4 (&acc)[2][2][4][2], const Unit& u, int wr, int wc, int fr, int fq) const {
        const int row0 = u.pm * BM + wr * 64 + fr, col0 = u.pn * BM + wc * 32 + 4 * fq;
#pragma unroll
        for (int ai = 0; ai < 2; ++ai)
#pragma unroll
            for (int m = 0; m < 4; ++m) { float* rowp = C + (size_t)(row0 + ai * HALF + m * 16) * ldc + col0;
#pragma unroll
                for (int bj = 0; bj < 2; ++bj)
#pragma unroll
                    for (int n = 0; n < 2; ++n) *(f32x4*)(rowp + bj * HALF + n * 16) = acc[ai][bj][m][n]; }
    }
};
struct EpiU {
    static constexpr bool PERM = true;
    bf16_t* U; float* G;
    __device__ __forceinline__ void operator()(const f32x4 (&acc)[2][2][4][2], const Unit& u, int wr, int wc, int fr, int fq) const {
        const int row0 = u.pm * BM + wr * 64 + fr;
        if (u.pn < 13) {
            const int col0 = u.pn * BM + wc * 32 + 8 * fq;
#pragma unroll
            for (int ai = 0; ai < 2; ++ai)
#pragma unroll
                for (int m = 0; m < 4; ++m) { bf16_t* rowp = U + (size_t)(row0 + ai * HALF + m * 16) * NU + col0;
#pragma unroll
                    for (int bj = 0; bj < 2; ++bj) { const f32x4 v0 = acc[ai][bj][m][0], v1 = acc[ai][bj][m][1];
                        u32x4 o; o.x = cvt_pk_bf16(v0[0], v0[1]); o.y = cvt_pk_bf16(v0[2], v0[3]); o.z = cvt_pk_bf16(v1[0], v1[1]); o.w = cvt_pk_bf16(v1[2], v1[3]);
                        *(u32x4*)(rowp + bj * HALF) = o; } }
        } else {
            const int col0 = wc * 32 + 8 * fq;
#pragma unroll
            for (int ai = 0; ai < 2; ++ai)
#pragma unroll
                for (int m = 0; m < 4; ++m) { float* rowp = G + (size_t)(row0 + ai * HALF + m * 16) * NGATE + col0;
#pragma unroll
                    for (int bj = 0; bj < 2; ++bj) { *(f32x4*)(rowp + bj * HALF) = acc[ai][bj][m][0]; *(f32x4*)(rowp + bj * HALF + 4) = acc[ai][bj][m][1]; } }
        }
    }
};
struct EpiSwi {
    static constexpr bool PERM = true;
    bf16_t* H;
    __device__ __forceinline__ void operator()(const f32x4 (&acc)[2][2][4][2], const Unit& u, int wr, int wc, int fr, int fq) const {
        const int row0 = u.pm * BM + wr * 64 + fr, col0 = u.pn * HALF + wc * 32 + 8 * fq;
#pragma unroll
        for (int ai = 0; ai < 2; ++ai)
#pragma unroll
            for (int m = 0; m < 4; ++m) { bf16_t* rowp = H + (size_t)(row0 + ai * HALF + m * 16) * DFF + col0;
                float r[8];
#pragma unroll
                for (int n = 0; n < 2; ++n)
#pragma unroll
                    for (int j = 0; j < 4; ++j) { const float g = acc[ai][0][m][n][j], up = acc[ai][1][m][n][j]; r[n * 4 + j] = g * up * __builtin_amdgcn_rcpf(1.f + __expf(-g)); }
                u32x4 o; o.x = cvt_pk_bf16(r[0], r[1]); o.y = cvt_pk_bf16(r[2], r[3]); o.z = cvt_pk_bf16(r[4], r[5]); o.w = cvt_pk_bf16(r[6], r[7]);
                *(u32x4*)rowp = o; }
    }
};

template <class Epi>
__device__ __forceinline__ void gemm_phase(LAS unsigned char* lds, const Gemm g, const StaticOrder& S, const Epi& E) {
    const int tid = otid(), wid = __builtin_amdgcn_readfirstlane(tid >> 6), lane = tid & 63, wr = wid >> 2, wc = wid & 3, fr = lane & 15, fq = lane >> 4;
    const int K = g.K, nt = K / BK;
    unsigned voffA[2], voffB[2];
#pragma unroll
    for (int i = 0; i < 2; ++i) { int R, C; stage_rc(tid * 16 + i * 8192, R, C); const int Rb = Epi::PERM ? ((R & ~31) + perm32(R & 31)) : R;
        voffA[i] = (unsigned)(R * K + C) * 2u; voffB[i] = (unsigned)(Rb * K + C) * 2u; }
    const size_t kstep = (size_t)(BK * 2);
    const size_t hstep = (size_t)HALF * K * 2;
    const size_t tstep = 2 * hstep;
    const unsigned ldsw = (unsigned)wid * 1024u;
    const int aoff = lds_byte(wr * 64 + fr, fq * 8), boff = lds_byte(wc * 32 + fr, fq * 8);
#define PG8_SA(b, h) (((b) * 2 + (h)) * HTB)
#define PG8_SB(b, h) ((4 + (b) * 2 + (h)) * HTB)
#define PG8_STAGE(bufoff, gbase, voff) do { _Pragma("unroll") for (int _i = 0; _i < 2; ++_i) \
        __builtin_amdgcn_global_load_lds((const unsigned*)((const char*)(gbase) + (voff)[_i]), (LAS unsigned*)(lds + (bufoff) + ldsw + _i * 8192), 16, 0, 0); } while (0)
#define PG8_LDA(dst, b, h) do { _Pragma("unroll") for (int m = 0; m < 4; ++m) _Pragma("unroll") for (int k = 0; k < 2; ++k) dst[m][k] = *(const LAS bf16x8*)(lds + PG8_SA(b, h) + aoff + m * 2048 + k * 1024); } while (0)
#define PG8_LDB(dst, b, h) do { _Pragma("unroll") for (int n = 0; n < 2; ++n) _Pragma("unroll") for (int k = 0; k < 2; ++k) dst[n][k] = *(const LAS bf16x8*)(lds + PG8_SB(b, h) + boff + n * 2048 + k * 1024); } while (0)
#define PG8_MMA(ai, bj, At, Bt) do { __builtin_amdgcn_s_setprio(1); _Pragma("unroll") for (int m = 0; m < 4; ++m) _Pragma("unroll") for (int n = 0; n < 2; ++n) _Pragma("unroll") for (int k = 0; k < 2; ++k) \
        acc[ai][bj][m][n] = __builtin_amdgcn_mfma_f32_16x16x32_bf16(Bt[n][k], At[m][k], acc[ai][bj][m][n], 0, 0, 0); __builtin_amdgcn_s_setprio(0); } while (0)
#define PG8_WAIT_V(n) asm volatile("s_waitcnt vmcnt(" #n ")" ::: "memory")
#define PG8_WAIT_L(n) asm volatile("s_waitcnt lgkmcnt(" #n ")" ::: "memory")
#define PG8_BAR __builtin_amdgcn_s_barrier()
#define PG8_SCHED __builtin_amdgcn_sched_barrier(0)
    Unit cur, nxt; int ui = 0;
    if (!S.next(0, cur)) return;
    f32x4 acc[2][2][4][2];
#pragma unroll
    for (int a = 0; a < 2; ++a)
#pragma unroll
        for (int b = 0; b < 2; ++b)
#pragma unroll
            for (int m = 0; m < 4; ++m)
#pragma unroll
                for (int n = 0; n < 2; ++n) acc[a][b][m][n] = (f32x4){0.f, 0.f, 0.f, 0.f};
    bf16x8 At[4][2], B0[2][2], B1[2][2];
    const char* cA = (const char*)g.A + (size_t)cur.pm * tstep; const char* cB = (const char*)g.Bt + (size_t)cur.pn * tstep;
    PG8_STAGE(PG8_SB(0, 0), cB, voffB); PG8_STAGE(PG8_SA(0, 0), cA, voffA); PG8_STAGE(PG8_SB(0, 1), cB + hstep, voffB); PG8_STAGE(PG8_SA(0, 1), cA + hstep, voffA);
    if (wr == 1) PG8_BAR;
    PG8_WAIT_V(4); PG8_BAR;
    PG8_STAGE(PG8_SB(1, 0), cB + kstep, voffB); PG8_STAGE(PG8_SA(1, 0), cA + kstep, voffA); PG8_STAGE(PG8_SB(1, 1), cB + hstep + kstep, voffB);
    PG8_WAIT_V(6); PG8_BAR;
    for (;;) {
        const bool has_next = S.next(ui + 1, nxt);
        const char* nA = has_next ? (const char*)g.A + (size_t)nxt.pm * tstep : cA; const char* nB = has_next ? (const char*)g.Bt + (size_t)nxt.pn * tstep : cB;
        for (int t = 0; t < nt; t += 2) {
            const bool last = (t == nt - 2);
            const char* a1 = cA + (size_t)(t + 1) * kstep;
            const char* a2 = last ? nA : cA + (size_t)(t + 2) * kstep; const char* b2 = last ? nB : cB + (size_t)(t + 2) * kstep;
            const char* a3 = a2 + kstep; const char* b3 = b2 + kstep;
            PG8_LDB(B0, 0, 0); PG8_SCHED; PG8_LDA(At, 0, 0); PG8_STAGE(PG8_SA(1, 1), a1 + hstep, voffA);
            PG8_WAIT_L(8); PG8_BAR; PG8_WAIT_L(0); PG8_MMA(0, 0, At, B0); PG8_BAR; PG8_SCHED;
            PG8_LDB(B1, 0, 1); PG8_STAGE(PG8_SB(0, 0), b2, voffB);
            PG8_BAR; PG8_WAIT_L(0); PG8_MMA(0, 1, At, B1); PG8_BAR;
            PG8_LDA(At, 0, 1); PG8_STAGE(PG8_SA(0, 0), a2, voffA);
            PG8_BAR; PG8_WAIT_L(0); PG8_MMA(1, 0, At, B0); PG8_BAR; PG8_SCHED;
            PG8_STAGE(PG8_SB(0, 1), b2 + hstep, voffB);
            PG8_WAIT_V(6); PG8_BAR; PG8_MMA(1, 1, At, B1); PG8_BAR;
            PG8_LDB(B0, 1, 0); PG8_SCHED; PG8_LDA(At, 1, 0); PG8_STAGE(PG8_SA(0, 1), a2 + hstep, voffA);
            PG8_WAIT_L(8); PG8_BAR; PG8_WAIT_L(0); PG8_MMA(0, 0, At, B0); PG8_BAR; PG8_SCHED;
            PG8_LDB(B1, 1, 1); PG8_STAGE(PG8_SB(1, 0), b3, voffB);
            PG8_BAR; PG8_WAIT_L(0); PG8_MMA(0, 1, At, B1); PG8_BAR;
            PG8_LDA(At, 1, 1); PG8_STAGE(PG8_SA(1, 0), a3, voffA);
            PG8_BAR; PG8_WAIT_L(0); PG8_MMA(1, 0, At, B0); PG8_BAR; PG8_SCHED;
            PG8_STAGE(PG8_SB(1, 1), b3 + hstep, voffB);
            PG8_WAIT_V(6); PG8_BAR; PG8_MMA(1, 1, At, B1); PG8_BAR;
        }
        E(acc, cur, wr, wc, fr, fq);
        if (!has_next) break;
#pragma unroll
        for (int a = 0; a < 2; ++a)
#pragma unroll
            for (int b = 0; b < 2; ++b)
#pragma unroll
                for (int m = 0; m < 4; ++m)
#pragma unroll
                    for (int n = 0; n < 2; ++n) acc[a][b][m][n] = (f32x4){0.f, 0.f, 0.f, 0.f};
        cur = nxt; cA = nA; cB = nB; ++ui;
    }
    PG8_WAIT_V(0);
    if (wr == 0) PG8_BAR;
    PG8_BAR;
#undef PG8_SA
#undef PG8_SB
#undef PG8_STAGE
#undef PG8_LDA
#undef PG8_LDB
#undef PG8_MMA
#undef PG8_WAIT_V
#undef PG8_WAIT_L
#undef PG8_BAR
#undef PG8_SCHED
}
}

__device__ __forceinline__ int src_col(int kind, int n) {
    if (kind == 0) {
        if (n < 1536) return n;
        if (n < 2560) return n + 16;
        if (n < 3328) return n + 32;
        const int j = n - 3328;
        if (j < 16) return 1536 + j;
        if (j < 32) return 2576 + (j - 16);
        if (j < 224) return 3360 + (j - 32);
        return -1;
    }
    if (kind == 2) return ((n & 255) >> 7) * DFF + (n >> 8) * 128 + (n & 127);
    return n;
}
__device__ void phase_convert(const Params& p, LAS float* tile) {
    const int tid = otid();
    bf16_t* WIN = (bf16_t*)(p.ws + WS_WIN); bf16_t* WOUT = (bf16_t*)(p.ws + WS_WOUT); bf16_t* WF1 = (bf16_t*)(p.ws + WS_WF1); bf16_t* WF2 = (bf16_t*)(p.ws + WS_WF2);
    for (int it = blockIdx.x; it < 6528; it += gridDim.x) {
        const int l = it / 3264; int r = it % 3264; int kind, nt, kt, K, Nsrc; const float* W; bf16_t* dst;
        if (r < 896) { kind = 0; nt = r / 16; kt = r % 16; K = 1024; Nsrc = 3552; W = p.in[5] + (size_t)l * 1024 * 3552; dst = WIN + (size_t)l * NIN * 1024; }
        else if (r < 1152) { r -= 896; kind = 1; nt = r / 16; kt = r % 16; K = 1024; Nsrc = 1024; W = p.in[6] + (size_t)l * 1024 * 1024; dst = WOUT + (size_t)l * 1024 * 1024; }
        else if (r < 2560) { r -= 1152; kind = 2; nt = r / 16; kt = r % 16; K = 1024; Nsrc = 5632; W = p.in[29] + (size_t)l * 1024 * 5632; dst = WF1 + (size_t)l * 5632 * 1024; }
        else { r -= 2560; kind = 3; nt = r / 44; kt = r % 44; K = 2816; Nsrc = 1024; W = p.in[30] + (size_t)l * 2816 * 1024; dst = WF2 + (size_t)l * 1024 * 2816; }
        for (int idx = tid; idx < 4096; idx += 512) {
            const int i = idx >> 6, j = idx & 63; const int sc = src_col(kind, nt * 64 + j);
            tile[i * 65 + j] = (sc >= 0) ? W[(size_t)(kt * 64 + i) * Nsrc + sc] : 0.f;
        }
        __syncthreads();
        for (int idx = tid; idx < 4096; idx += 512) {
            const int jn = idx >> 6, ik = idx & 63;
            dst[(size_t)(nt * 64 + jn) * K + kt * 64 + ik] = f2bf(tile[ik * 65 + jn]);
        }
        __syncthreads();
    }
}
__device__ void row_pass(const float* O, const float* g1, const float* xres, float* xout, const float* g2, bf16_t* hb) {
    const int tid = otid(); const int lane = tid & 63, gw = blockIdx.x * 8 + (tid >> 6), nw = gridDim.x * 8;
    for (int row = gw; row < T_TOK; row += nw) {
        f32x4 v[4];
        if (O) {
            const f32x4* op = (const f32x4*)(O + (size_t)row * DM) + lane; const f32x4* xp = (const f32x4*)(xres + (size_t)row * DM) + lane;
            float ss = 0.f;
#pragma unroll
            for (int j = 0; j < 4; ++j) { v[j] = op[64 * j]; ss += hsum4(v[j] * v[j]); }
            const float inv = rsqrtf(red64(ss) * (1.f / DM) + 1e-6f);
#pragma unroll
            for (int j = 0; j < 4; ++j) { const f32x4 gg = *((const f32x4*)g1 + lane + 64 * j); v[j] = xp[64 * j] + v[j] * inv * gg; }
            f32x4* xo = (f32x4*)(xout + (size_t)row * DM) + lane;
#pragma unroll
            for (int j = 0; j < 4; ++j) xo[64 * j] = v[j];
        } else {
            const f32x4* xp = (const f32x4*)(xres + (size_t)row * DM) + lane;
#pragma unroll
            for (int j = 0; j < 4; ++j) v[j] = xp[64 * j];
        }
        if (g2) {
            float ss = 0.f;
#pragma unroll
            for (int j = 0; j < 4; ++j) ss += hsum4(v[j] * v[j]);
            const float inv = rsqrtf(red64(ss) * (1.f / DM) + 1e-6f);
            bf16_t* hp = hb + (size_t)row * DM;
#pragma unroll
            for (int j = 0; j < 4; ++j) { const f32x4 gg = *((const f32x4*)g2 + lane + 64 * j); st4bf(hp + 4 * (lane + 64 * j), v[j] * inv * gg); }
        }
    }
}

constexpr int TT = 32, NTILE = SEQ / TT;

__device__ void gdn_task(const Params& p, int l, int b, int h, int dir, LAS float* sm) {
    const int tid = otid(), wave = tid >> 6, lane = tid & 63;
    LAS float* Qs = sm; LAS float* Ks = sm + 2048; LAS float* Vs = sm + 4096; LAS float* Os = sm + 6144; LAS float* AB = sm + 8192;
    const bf16_t* U = (const bf16_t*)(p.ws + WS_U); const float* G = (const float*)(p.ws + WS_G); bf16_t* SC = (bf16_t*)(p.ws + WS_SC);
    const int pt = tid >> 4, c4 = (tid & 15) * 4;
    const float* cw = p.in[12] + (size_t)l * 4 * 768 + h * 64 + c4;
    f32x4 wq[4], wk[4], wv[4];
#pragma unroll
    for (int j = 0; j < 4; ++j) { wq[j] = *(const f32x4*)(cw + j * 768); wk[j] = *(const f32x4*)(cw + j * 768 + 256); wv[j] = *(const f32x4*)(cw + j * 768 + 512); }
    const float nea = -__expf(p.in[13][l * 8 + dir * 4 + h]), dtb = p.in[14][l * 8 + dir * 4 + h];
    const int row = (wave & 3) * 16 + (lane >> 2), sub = lane & 3;
    f32x4 s4[4];
#pragma unroll
    for (int j = 0; j < 4; ++j) s4[j] = (f32x4){0.f, 0.f, 0.f, 0.f};
    for (int kt = 0; kt < NTILE; ++kt) {
        const int t0 = (dir ? NTILE - 1 - kt : kt) * TT;
        {
            const int t = t0 + pt;
            f32x4 aq = (f32x4){0.f, 0.f, 0.f, 0.f}, ak = aq, av = aq;
#pragma unroll
            for (int j = 0; j < 4; ++j) { const int ts = t + j - 2;
                if (ts >= 0 && ts < SEQ) { const bf16_t* up = U + (size_t)(b * SEQ + ts) * NU + 512 + h * 64 + c4;
                    aq += wq[j] * ld4bf(up); ak += wk[j] * ld4bf(up + 256); av += wv[j] * ld4bf(up + 512); } }
#pragma unroll
            for (int e = 0; e < 4; ++e) { aq[e] = siluf_(aq[e]); ak[e] = siluf_(ak[e]); av[e] = siluf_(av[e]); }
            const float sq = red16(hsum4(aq * aq)), sk = red16(hsum4(ak * ak));
            aq = aq * (rsqrtf(sq + 1e-6f) * 0.125f); ak = ak * rsqrtf(sk + 1e-6f);
            *(LAS f32x4*)(Qs + pt * 64 + c4) = aq; *(LAS f32x4*)(Ks + pt * 64 + c4) = ak; *(LAS f32x4*)(Vs + pt * 64 + c4) = av;
            if (tid < TT) { const float* gp = G + (size_t)(b * SEQ + t0 + tid) * NGATE;
                const float g = nea * softplusf_(gp[dir * 4 + h] + dtb);
                AB[tid * 2] = __expf(g); AB[tid * 2 + 1] = sigmoidf_(gp[8 + dir * 4 + h]); }
        }
        __syncthreads();
        if (wave < 4) {
            for (int gq = 0; gq < TT / 4; ++gq) {
                float okeep = 0.f;
#pragma unroll
                for (int u = 0; u < 4; ++u) {
                    const int i = gq * 4 + u, tt = dir ? TT - 1 - i : i;
                    const LAS float* kp = Ks + tt * 64 + 4 * sub; const LAS float* qp = Qs + tt * 64 + 4 * sub;
                    f32x4 k4[4], q4[4];
#pragma unroll
                    for (int j = 0; j < 4; ++j) { k4[j] = *(const LAS f32x4*)(kp + 16 * j); q4[j] = *(const LAS f32x4*)(qp + 16 * j); }
                    const float a = AB[tt * 2], be = AB[tt * 2 + 1], vi = Vs[tt * 64 + row];
                    f32x4 d4 = s4[0] * k4[0] + s4[1] * k4[1]; d4 += s4[2] * k4[2] + s4[3] * k4[3];
                    const float d = sum4l(hsum4(d4));
                    const float c = be * (vi - a * d);
#pragma unroll
                    for (int j = 0; j < 4; ++j) s4[j] = s4[j] * a + k4[j] * c;
                    f32x4 o4 = s4[0] * q4[0] + s4[1] * q4[1]; o4 += s4[2] * q4[2] + s4[3] * q4[3];
                    const float o = sum4l(hsum4(o4));
                    okeep = (sub == u) ? o : okeep;
                }
                const int is = gq * 4 + sub, tts = dir ? TT - 1 - is : is;
                Os[tts * 64 + row] = okeep;
            }
        }
        __syncthreads();
        st4bf(SC + (size_t)(b * SEQ + t0 + pt) * NSC + 512 + dir * 256 + h * 64 + c4, *(const LAS f32x4*)(Os + pt * 64 + c4));
    }
    __syncthreads();
}

__device__ void mlstm_task(const Params& p, int l, int b, int h, int dir, LAS float* sm) {
    const int tid = otid(), wave = tid >> 6, lane = tid & 63;
    LAS float* Qs = sm; LAS float* Ks = sm + 2048; LAS float* Vs = sm + 4096; LAS float* Os = sm + 6144; LAS float* Dn = sm + 8192; LAS float* FI = sm + 10240;
    const bf16_t* U = (const bf16_t*)(p.ws + WS_U); const float* G = (const float*)(p.ws + WS_G); bf16_t* SC = (bf16_t*)(p.ws + WS_SC);
    const int pt = tid >> 4, c4 = (tid & 15) * 4;
    const float bias_i = p.in[16][l * 16 + dir * 8 + h], bias_f = p.in[16][l * 16 + dir * 8 + 4 + h];
    const int row = (wave & 3) * 16 + (lane >> 2), sub = lane & 3;
    f32x4 s4[4];
#pragma unroll
    for (int j = 0; j < 4; ++j) s4[j] = (f32x4){0.f, 0.f, 0.f, 0.f};
    float nst = 0.f;
    for (int kt = 0; kt < NTILE; ++kt) {
        const int t0 = (dir ? NTILE - 1 - kt : kt) * TT;
        {
            const bf16_t* up = U + (size_t)(b * SEQ + t0 + pt) * NU + 1536 + h * 64 + c4;
            *(LAS f32x4*)(Qs + pt * 64 + c4) = ld4bf(up); *(LAS f32x4*)(Ks + pt * 64 + c4) = ld4bf(up + 256) * 0.125f; *(LAS f32x4*)(Vs + pt * 64 + c4) = ld4bf(up + 512);
            if (tid < TT) { const float* gp = G + (size_t)(b * SEQ + t0 + tid) * NGATE + 16;
                const float ig = 15.f * tanhf((gp[dir * 4 + h] + bias_i) * (1.f / 15.f));
                const float fp = 15.f * tanhf((gp[8 + dir * 4 + h] + bias_f) * (1.f / 15.f));
                FI[tid * 2] = sigmoidf_(fp); FI[tid * 2 + 1] = __expf(ig); }
        }
        __syncthreads();
        if (wave < 4) {
            for (int gq = 0; gq < TT / 4; ++gq) {
                float okeep = 0.f;
#pragma unroll
                for (int u = 0; u < 4; ++u) {
                    const int i = gq * 4 + u, tt = dir ? TT - 1 - i : i;
                    const LAS float* kp = Ks + tt * 64 + 4 * sub; const LAS float* qp = Qs + tt * 64 + 4 * sub;
                    f32x4 k4[4], q4[4];
#pragma unroll
                    for (int j = 0; j < 4; ++j) { k4[j] = *(const LAS f32x4*)(kp + 16 * j); q4[j] = *(const LAS f32x4*)(qp + 16 * j); }
                    const float f = FI[tt * 2], iv = FI[tt * 2 + 1] * Vs[tt * 64 + row];
#pragma unroll
                    for (int j = 0; j < 4; ++j) s4[j] = s4[j] * f + k4[j] * iv;
                    f32x4 o4 = s4[0] * q4[0] + s4[1] * q4[1]; o4 += s4[2] * q4[2] + s4[3] * q4[3];
                    const float o = sum4l(hsum4(o4));
                    okeep = (sub == u) ? o : okeep;
                }
                const int is = gq * 4 + sub, tts = dir ? TT - 1 - is : is;
                Os[tts * 64 + row] = okeep;
            }
        } else if (wave == 4) {
            for (int i = 0; i < TT; ++i) { const int tt = dir ? TT - 1 - i : i;
                nst = nst * FI[tt * 2] + FI[tt * 2 + 1] * Ks[tt * 64 + lane];
                Dn[tt * 64 + lane] = nst * Qs[tt * 64 + lane]; }
        }
        __syncthreads();
        {
            const float den = red16(hsum4(*(const LAS f32x4*)(Dn + pt * 64 + c4)));
            const float sc = 1.f / fmaxf(fabsf(den), 1.f);
            st4bf(SC + (size_t)(b * SEQ + t0 + pt) * NSC + 1024 + dir * 256 + h * 64 + c4, *(const LAS f32x4*)(Os + pt * 64 + c4) * sc);
        }
    }
    __syncthreads();
}

__device__ void rwkv_task(const Params& p, int l, int b, int h, int dir, LAS float* sm) {
    const int tid = otid(), wave = tid >> 6, lane = tid & 63;
    LAS float* Rs = sm; LAS float* Ws = sm + 2048; LAS float* KKs = sm + 4096; LAS float* KAs = sm + 6144; LAS float* KDs = sm + 8192; LAS float* Vs = sm + 10240;
    LAS float* Os = sm + 12288; LAS float* WA = sm + 14336; LAS float* WUP = sm + 16384; LAS float* AUP = sm + 18432;
    const bf16_t* U = (const bf16_t*)(p.ws + WS_U); const float* G = (const float*)(p.ws + WS_G); bf16_t* SC = (bf16_t*)(p.ws + WS_SC);
    const int pt = tid >> 4, c4 = (tid & 15) * 4, hc = h * 64 + c4;
    for (int i = tid; i < 2048; i += 512) { const int r = i >> 6, c = i & 63;
        WUP[i] = p.in[20][(size_t)((l * 2 + dir) * 32 + r) * 256 + h * 64 + c]; AUP[i] = p.in[22][(size_t)((l * 2 + dir) * 32 + r) * 256 + h * 64 + c]; }
    const float* mu0 = p.in[18] + (size_t)l * 2 * 960; const float* mu1 = mu0 + 960;
    const f32x4 mr0 = *(const f32x4*)(mu0 + hc), mr1 = *(const f32x4*)(mu1 + hc), mk0 = *(const f32x4*)(mu0 + 256 + hc), mk1 = *(const f32x4*)(mu1 + 256 + hc),
                mv0 = *(const f32x4*)(mu0 + 512 + hc), mv1 = *(const f32x4*)(mu1 + 512 + hc);
    const int lrg = (c4 < 32) ? (32 + dir * 32 + c4) : (96 + dir * 32 + (c4 - 32));
    const int lrd = (c4 < 32) ? (768 + dir * 32 + c4) : (832 + dir * 32 + (c4 - 32));
    const f32x4 ml0 = *(const f32x4*)(mu0 + lrd), ml1 = *(const f32x4*)(mu1 + lrd);
    const f32x4 w0v = *(const f32x4*)(p.in[19] + (size_t)(l * 2 + dir) * 256 + hc), a0v = *(const f32x4*)(p.in[21] + (size_t)(l * 2 + dir) * 256 + hc);
    const f32x4 kkv = *(const f32x4*)(p.in[24] + (size_t)l * 256 + hc), kav = *(const f32x4*)(p.in[25] + (size_t)l * 256 + hc);
    const int row = (wave & 3) * 16 + (lane >> 2), sub = lane & 3;
    f32x4 s4[4];
#pragma unroll
    for (int j = 0; j < 4; ++j) s4[j] = (f32x4){0.f, 0.f, 0.f, 0.f};
    const f32x4 z4 = (f32x4){0.f, 0.f, 0.f, 0.f};
    for (int kt = 0; kt < NTILE; ++kt) {
        const int t0 = (dir ? NTILE - 1 - kt : kt) * TT;
        f32x4 rr, kk, vv;
        {
            const int t = t0 + pt; const bool hp = t > 0, hn = t < SEQ - 1;
            const bf16_t* up = U + (size_t)(b * SEQ + t) * NU + 2560 + hc;
            { const f32x4 c = ld4bf(up), pv = hp ? ld4bf(up - NU) : z4, nx = hn ? ld4bf(up + NU) : z4; rr = c + mr0 * (pv - c) + mr1 * (nx - c); }
            { const f32x4 c = ld4bf(up + 256), pv = hp ? ld4bf(up + 256 - NU) : z4, nx = hn ? ld4bf(up + 256 + NU) : z4; kk = c + mk0 * (pv - c) + mk1 * (nx - c); }
            { const f32x4 c = ld4bf(up + 512), pv = hp ? ld4bf(up + 512 - NU) : z4, nx = hn ? ld4bf(up + 512 + NU) : z4; vv = c + mv0 * (pv - c) + mv1 * (nx - c); }
            const float* gp = G + (size_t)(b * SEQ + t) * NGATE + lrg;
            const f32x4 c = *(const f32x4*)gp, pv = hp ? *(const f32x4*)(gp - NGATE) : z4, nx = hn ? *(const f32x4*)(gp + NGATE) : z4;
            f32x4 lr = c + ml0 * (pv - c) + ml1 * (nx - c);
            if (c4 < 32) { lr.x = tanhf(lr.x); lr.y = tanhf(lr.y); lr.z = tanhf(lr.z); lr.w = tanhf(lr.w); }
            *(LAS f32x4*)(WA + pt * 64 + c4) = lr;
        }
        __syncthreads();
        {
            f32x4 zw = w0v, za = a0v;
            const LAS float* wa = WA + pt * 64;
#pragma unroll 8
            for (int r = 0; r < 32; ++r) { zw += *(const LAS f32x4*)(WUP + r * 64 + c4) * wa[r]; za += *(const LAS f32x4*)(AUP + r * 64 + c4) * wa[32 + r]; }
            f32x4 w, a;
#pragma unroll
            for (int e = 0; e < 4; ++e) { w[e] = __expf(-0.6065306597126334f * sigmoidf_(zw[e])); a[e] = sigmoidf_(za[e]); }
            f32x4 kn = kk * kkv; const float ss = red16(hsum4(kn * kn)); kn = kn * rsqrtf(ss + 1e-6f);
            *(LAS f32x4*)(Rs + pt * 64 + c4) = rr; *(LAS f32x4*)(Ws + pt * 64 + c4) = w; *(LAS f32x4*)(KKs + pt * 64 + c4) = kn;
            *(LAS f32x4*)(KAs + pt * 64 + c4) = kn * a; *(LAS f32x4*)(KDs + pt * 64 + c4) = kk * (1.f + (a - 1.f) * kav); *(LAS f32x4*)(Vs + pt * 64 + c4) = vv;
        }
        __syncthreads();
        if (wave < 4) {
            for (int gq = 0; gq < TT / 4; ++gq) {
                float okeep = 0.f;
#pragma unroll
                for (int u = 0; u < 4; ++u) {
                    const int i = gq * 4 + u, tt = dir ? TT - 1 - i : i; const int o16 = tt * 64 + 4 * sub;
                    f32x4 w4[4], n4[4], a4[4], d4[4], r4[4];
#pragma unroll
                    for (int j = 0; j < 4; ++j) { w4[j] = *(const LAS f32x4*)(Ws + o16 + 16 * j); n4[j] = *(const LAS f32x4*)(KKs + o16 + 16 * j); a4[j] = *(const LAS f32x4*)(KAs + o16 + 16 * j);
                        d4[j] = *(const LAS f32x4*)(KDs + o16 + 16 * j); r4[j] = *(const LAS f32x4*)(Rs + o16 + 16 * j); }
                    const float vi = Vs[tt * 64 + row];
                    f32x4 x4 = s4[0] * n4[0] + s4[1] * n4[1]; x4 += s4[2] * n4[2] + s4[3] * n4[3];
                    const float sa = -sum4l(hsum4(x4));
#pragma unroll
                    for (int j = 0; j < 4; ++j) s4[j] = s4[j] * w4[j] + a4[j] * sa + d4[j] * vi;
                    f32x4 o4 = s4[0] * r4[0] + s4[1] * r4[1]; o4 += s4[2] * r4[2] + s4[3] * r4[3];
                    const float o = sum4l(hsum4(o4));
                    okeep = (sub == u) ? o : okeep;
                }
                const int is = gq * 4 + sub, tts = dir ? TT - 1 - is : is;
                Os[tts * 64 + row] = okeep;
            }
        }
        __syncthreads();
        st4bf(SC + (size_t)(b * SEQ + t0 + pt) * NSC + 1536 + dir * 256 + h * 64 + c4, *(const LAS f32x4*)(Os + pt * 64 + c4));
    }
    __syncthreads();
}

__device__ void lru_task(const Params& p, int l, int b, int n, int dir, LAS float* sm) {
    const int tid = otid(), wave = tid >> 6, lane = tid & 63;
    LAS float* WG = sm;
    LAS float* XC = sm + 8192;
    LAS float* As = sm + 10240; LAS float* Bs = sm + 12288; LAS float* Os = sm + 14336;
    const bf16_t* U = (const bf16_t*)(p.ws + WS_U); bf16_t* SC = (bf16_t*)(p.ws + WS_SC);
    const int pt = tid >> 4, c4 = (tid & 15) * 4, nc = n * 64 + c4;
    for (int i = tid; i < 8192; i += 512) { const int g = i >> 12, r = i & 4095;
        WG[i] = p.in[9][((size_t)((l * 2 + dir) * 2 + g) * 4 + n) * 4096 + r]; }
    f32x4 cwv[4];
#pragma unroll
    for (int j = 0; j < 4; ++j) cwv[j] = *(const f32x4*)(p.in[7] + (size_t)l * 4 * 256 + j * 256 + nc);
    const f32x4 cb = *(const f32x4*)(p.in[8] + (size_t)l * 256 + nc);
    const f32x4 gbr = *(const f32x4*)(p.in[10] + (size_t)((l * 2 + dir) * 2 + 0) * 256 + nc), gbi = *(const f32x4*)(p.in[10] + (size_t)((l * 2 + dir) * 2 + 1) * 256 + nc);
    f32x4 sp;
    { const f32x4 lam = *(const f32x4*)(p.in[11] + (size_t)(l * 2 + dir) * 256 + nc); for (int e = 0; e < 4; ++e) sp[e] = softplusf_(-lam[e]); }
    float hst = 0.f;
    __syncthreads();
    for (int kt = 0; kt < NTILE; ++kt) {
        const int t0 = (dir ? NTILE - 1 - kt : kt) * TT;
        f32x4 xc = cb;
        {
            const int t = t0 + pt;
#pragma unroll
            for (int j = 0; j < 4; ++j) { const int ts = t + j - 2; if (ts >= 0 && ts < SEQ) xc += cwv[j] * ld4bf(U + (size_t)(b * SEQ + ts) * NU + nc); }
            *(LAS f32x4*)(XC + pt * 64 + c4) = xc;
        }
        __syncthreads();
        {
            f32x4 pr = gbr, pi = gbi; const LAS float* xr = XC + pt * 64;
#pragma unroll 8
            for (int i = 0; i < 64; ++i) { const float x = xr[i]; pr += *(const LAS f32x4*)(WG + i * 64 + c4) * x; pi += *(const LAS f32x4*)(WG + 4096 + i * 64 + c4) * x; }
            f32x4 av, bv;
#pragma unroll
            for (int e = 0; e < 4; ++e) { const float la = -8.f * sigmoidf_(pr[e]) * sp[e]; av[e] = __expf(la); bv[e] = sqrtf(-expm1f(2.f * la)) * sigmoidf_(pi[e]) * xc[e]; }
            *(LAS f32x4*)(As + pt * 64 + c4) = av; *(LAS f32x4*)(Bs + pt * 64 + c4) = bv;
        }
        __syncthreads();
        if (wave == 0) {
#pragma unroll 8
            for (int i = 0; i < TT; ++i) { const int tt = dir ? TT - 1 - i : i; hst = As[tt * 64 + lane] * hst + Bs[tt * 64 + lane]; Os[tt * 64 + lane] = hst; }
        }
        __syncthreads();
        st4bf(SC + (size_t)(b * SEQ + t0 + pt) * NSC + dir * 256 + nc, *(const LAS f32x4*)(Os + pt * 64 + c4));
    }
    __syncthreads();
}

__device__ void phase_scan(const Params& p, int l, LAS float* sm) {
    for (int task = blockIdx.x; task < 256; task += gridDim.x) {
        const int mixer = task & 3, rest = task >> 2, b = rest & 7, dir = (rest >> 3) & 1, h = rest >> 4;
        if (mixer == 0) lru_task(p, l, b, h, dir, sm);
        else if (mixer == 1) gdn_task(p, l, b, h, dir, sm);
        else if (mixer == 2) mlstm_task(p, l, b, h, dir, sm);
        else rwkv_task(p, l, b, h, dir, sm);
    }
}

__device__ void phase_finalize(const Params& p, int l, LAS float* sm) {
    const int tid = otid(), lane = tid & 63;
    LAS float* GUP = sm;
    for (int i = tid; i < 16384; i += 512) GUP[i] = p.in[23][(size_t)l * 16384 + i];
    __syncthreads();
    const bf16_t* U = (const bf16_t*)(p.ws + WS_U); const float* G = (const float*)(p.ws + WS_G); const bf16_t* SC = (const bf16_t*)(p.ws + WS_SC); bf16_t* Y = (bf16_t*)(p.ws + WS_ACT);
    const int c = lane * 4, hc = c & 63;
    const f32x4 gdn_g = *(const f32x4*)(p.in[15] + (size_t)l * 64 + hc), ml_g = *(const f32x4*)(p.in[17] + (size_t)l * 256 + c);
    const float* mu0 = p.in[18] + (size_t)l * 2 * 960; const float* mu1 = mu0 + 960;
    const f32x4 mr0 = *(const f32x4*)(mu0 + c), mr1 = *(const f32x4*)(mu1 + c), mk0 = *(const f32x4*)(mu0 + 256 + c), mk1 = *(const f32x4*)(mu1 + 256 + c),
                mv0 = *(const f32x4*)(mu0 + 512 + c), mv1 = *(const f32x4*)(mu1 + 512 + c);
    const float mg0 = mu0[896 + lane], mg1 = mu1[896 + lane];
    const f32x4 rk = *(const f32x4*)(p.in[26] + (size_t)l * 256 + c), gnw = *(const f32x4*)(p.in[27] + (size_t)l * 256 + c), gnb = *(const f32x4*)(p.in[28] + (size_t)l * 256 + c);
    const f32x4 z4 = (f32x4){0.f, 0.f, 0.f, 0.f};
    const int gw = blockIdx.x * 8 + (tid >> 6), nw = gridDim.x * 8;
    for (int tok = gw; tok < T_TOK; tok += nw) {
        const int t = tok & (SEQ - 1); const bool hp = t > 0, hn = t < SEQ - 1;
        const bf16_t* u = U + (size_t)tok * NU; const bf16_t* sc = SC + (size_t)tok * NSC; bf16_t* y = Y + (size_t)tok * DM;
        { const f32x4 hh = ld4bf(sc + c) + ld4bf(sc + 256 + c), yb = ld4bf(u + 256 + c); f32x4 o;
          for (int e = 0; e < 4; ++e) o[e] = hh[e] * gelu_tanh(yb[e]);
          st4bf(y + c, o); }
        { const f32x4 o = ld4bf(sc + 512 + c) + ld4bf(sc + 768 + c), z = ld4bf(u + 1280 + c);
          const float inv = rsqrtf(red16(hsum4(o * o)) * (1.f / 64.f) + 1e-6f); f32x4 r;
          for (int e = 0; e < 4; ++e) r[e] = o[e] * inv * gdn_g[e] * siluf_(z[e]);
          st4bf(y + 256 + c, r); }
        { const f32x4 o = ld4bf(sc + 1024 + c) + ld4bf(sc + 1280 + c), og = ld4bf(u + 2304 + c);
          const float inv = rsqrtf(red16(hsum4(o * o)) * (1.f / 64.f) + 1e-6f); f32x4 r;
          for (int e = 0; e < 4; ++e) r[e] = o[e] * inv * ml_g[e] * sigmoidf_(og[e]);
          st4bf(y + 512 + c, r); }
        {
            const f32x4 yy = ld4bf(sc + 1536 + c) + ld4bf(sc + 1792 + c);
            const float mean = red16(hsum4(yy)) * (1.f / 64.f); const f32x4 dv = yy - mean;
            const float var = red16(hsum4(dv * dv)) * (1.f / 64.f); const float inv = rsqrtf(var + 64e-5f);
            const bf16_t* up = u + 2560 + c;
            f32x4 rr, kk, vv;
            { const f32x4 cc = ld4bf(up), pv = hp ? ld4bf(up - NU) : z4, nx = hn ? ld4bf(up + NU) : z4; rr = cc + mr0 * (pv - cc) + mr1 * (nx - cc); }
            { const f32x4 cc = ld4bf(up + 256), pv = hp ? ld4bf(up + 256 - NU) : z4, nx = hn ? ld4bf(up + 256 + NU) : z4; kk = cc + mk0 * (pv - cc) + mk1 * (nx - cc); }
            { const f32x4 cc = ld4bf(up + 512), pv = hp ? ld4bf(up + 512 - NU) : z4, nx = hn ? ld4bf(up + 512 + NU) : z4; vv = cc + mv0 * (pv - cc) + mv1 * (nx - cc); }
            const float bsum = red16(hsum4(rr * kk * rk));
            const float* gp = G + (size_t)tok * NGATE + 160 + lane;
            const float gc = gp[0], gpv = hp ? gp[-NGATE] : 0.f, gnx = hn ? gp[NGATE] : 0.f;
            const float sg = sigmoidf_(gc + mg0 * (gpv - gc) + mg1 * (gnx - gc));
            f32x4 gate = z4;
#pragma unroll 16
            for (int r = 0; r < 64; ++r) gate += *(const LAS f32x4*)(GUP + r * 256 + c) * __shfl(sg, r);
            f32x4 o;
            for (int e = 0; e < 4; ++e) o[e] = (dv[e] * inv * gnw[e] + gnb[e] + bsum * vv[e]) * gate[e];
            st4bf(y + 768 + c, o);
        }
    }
    __syncthreads();
}

#ifndef EN_GEMM
#define EN_GEMM 1
#endif
#ifndef EN_SCAN
#define EN_SCAN 1
#endif
#ifndef EN_FIN
#define EN_FIN 1
#endif
#ifndef EN_ROW
#define EN_ROW 1
#endif
__global__ void __launch_bounds__(512) mega(Params p) {
    extern __shared__ __attribute__((aligned(16))) unsigned char smem[];
    cg::grid_group grid = cg::this_grid();
    LAS unsigned char* lds = (LAS unsigned char*)smem; LAS float* sm = (LAS float*)smem;
    bf16_t* WIN = (bf16_t*)(p.ws + WS_WIN); bf16_t* WOUT = (bf16_t*)(p.ws + WS_WOUT); bf16_t* WF1 = (bf16_t*)(p.ws + WS_WF1); bf16_t* WF2 = (bf16_t*)(p.ws + WS_WF2);
    bf16_t* Ub = (bf16_t*)(p.ws + WS_U); float* Gf = (float*)(p.ws + WS_G); bf16_t* ACT = (bf16_t*)(p.ws + WS_ACT);
    float* O1 = (float*)(p.ws + WS_U); bf16_t* HD = (bf16_t*)(p.ws + WS_U); float* O2 = (float*)(p.ws + WS_SC);
    for (int ph = p.ph_lo; ph < p.ph_hi; ++ph) {
        if (ph > p.ph_lo) grid.sync();
        if (ph == 0) {
            phase_convert(p, sm);
            row_pass(nullptr, nullptr, p.in[0], nullptr, p.in[1], ACT);
            continue;
        }
        const int l = (ph - 1) >> 3, s = (ph - 1) & 7;
        pg8::StaticOrder S;
        if (s == 0) { if (EN_GEMM) { pg8::Gemm g{ACT, WIN + (size_t)l * NIN * DM, T_TOK, NIN, DM}; S.init(g.M, g.N, gridDim.x, blockIdx.x); pg8::EpiU E{Ub, Gf}; pg8::gemm_phase(lds, g, S, E); } }
        else if (s == 1) { if (EN_SCAN) phase_scan(p, l, sm); }
        else if (s == 2) { if (EN_FIN) phase_finalize(p, l, sm); }
        else if (s == 3) { if (EN_GEMM) { pg8::Gemm g{ACT, WOUT + (size_t)l * DM * DM, T_TOK, DM, DM}; S.init(g.M, g.N, gridDim.x, blockIdx.x); pg8::EpiF32 E{O1, DM}; pg8::gemm_phase(lds, g, S, E); } }
        else if (s == 4) { if (EN_ROW) row_pass(O1, p.in[2] + (size_t)l * DM, l == 0 ? p.in[0] : p.out, p.out, p.in[3] + (size_t)l * DM, ACT); }
        else if (s == 5) { if (EN_GEMM) { pg8::Gemm g{ACT, WF1 + (size_t)l * 2 * DFF * DM, T_TOK, 2 * DFF, DM}; S.init(g.M, g.N, gridDim.x, blockIdx.x); pg8::EpiSwi E{HD}; pg8::gemm_phase(lds, g, S, E); } }
        else if (s == 6) { if (EN_GEMM) { pg8::Gemm g{HD, WF2 + (size_t)l * DM * DFF, T_TOK, DM, DFF}; S.init(g.M, g.N, gridDim.x, blockIdx.x); pg8::EpiF32 E{O2, DM}; pg8::gemm_phase(lds, g, S, E); } }
        else { if (EN_ROW) row_pass(O2, p.in[4] + (size_t)l * DM, p.out, p.out, l == 0 ? p.in[1] + DM : nullptr, ACT); }
    }
}

extern "C" void kernel_launch(void* const* d_in, const int* in_sizes, int n_in, void* d_out, int out_size, void* d_ws, size_t ws_size, hipStream_t stream) {
    static int grid_blocks = 0;
    if (grid_blocks == 0) {
        if (n_in != 31 || ws_size < WS_END || out_size != T_TOK * DM) { fprintf(stderr, "kernel_launch: unexpected shapes (n_in %d, ws %zu need %zu, out %d)\n", n_in, ws_size, (size_t)WS_END, out_size); grid_blocks = -1; return; }
        int dev = 0, cus = 0, per_cu = 0;
        (void)hipGetDevice(&dev);
        (void)hipDeviceGetAttribute(&cus, hipDeviceAttributeMultiprocessorCount, dev);
        if (hipFuncSetAttribute((const void*)mega, hipFuncAttributeMaxDynamicSharedMemorySize, LDS_BYTES) != hipSuccess) { fprintf(stderr, "kernel_launch: hipFuncSetAttribute failed\n"); grid_blocks = -1; return; }
        if (hipOccupancyMaxActiveBlocksPerMultiprocessor(&per_cu, (const void*)mega, 512, LDS_BYTES) != hipSuccess || per_cu < 1) { fprintf(stderr, "kernel_launch: occupancy query says %d blocks per CU\n", per_cu); per_cu = 1; (void)hipGetLastError(); }
        grid_blocks = cus * 1;
        (void)per_cu;
    }
    if (grid_blocks < 0) return;
    Params p{};
    for (int i = 0; i < 31; ++i) p.in[i] = (const float*)d_in[i];
    p.out = (float*)d_out; p.ws = (unsigned char*)d_ws; p.ph_lo = 0; p.ph_hi = 17;
    void* args[] = {&p};
    hipError_t e = hipLaunchCooperativeKernel((const void*)mega, dim3(grid_blocks), dim3(512), args, LDS_BYTES, stream);
    if (e != hipSuccess) fprintf(stderr, "cooperative launch failed: %s (grid %d)\n", hipGetErrorString(e), grid_blocks);
}
```

```cpp
#include <hip/hip_runtime.h>
#include <hip/hip_cooperative_groups.h>
#include <cstdio>
namespace cg = cooperative_groups;

#define LAS __attribute__((address_space(3)))
typedef unsigned short bf16_t;
typedef short bf16x8 __attribute__((ext_vector_type(8)));
typedef float f32x4 __attribute__((ext_vector_type(4)));
typedef float f32x2 __attribute__((ext_vector_type(2)));
typedef unsigned u32x4 __attribute__((ext_vector_type(4)));
typedef unsigned u32x2 __attribute__((ext_vector_type(2)));

constexpr int T_TOK = 32768, SEQ = 4096, DM = 1024, NU = 3328, NGATE = 256, NIN = 3584, DFF = 2816, NSC = 2048;
constexpr int LDS_BYTES = 131072;
constexpr size_t WS_WIN = 0;
constexpr size_t WS_WOUT = WS_WIN + (size_t)2 * NIN * DM * 2;
constexpr size_t WS_WF1 = WS_WOUT + (size_t)2 * DM * DM * 2;
constexpr size_t WS_WF2 = WS_WF1 + (size_t)2 * 2 * DFF * DM * 2;
constexpr size_t WS_U = WS_WF2 + (size_t)2 * DM * DFF * 2;
constexpr size_t WS_G = WS_U + (size_t)T_TOK * NU * 2;
constexpr size_t WS_ACT = WS_G + (size_t)T_TOK * NGATE * 4;
constexpr size_t WS_SC = WS_ACT + (size_t)T_TOK * DM * 2;
constexpr size_t WS_A2 = WS_SC + (size_t)T_TOK * NSC * 2;
constexpr size_t WS_BT2 = WS_A2 + (size_t)T_TOK * 384 * 2;
constexpr size_t WS_SPT = WS_BT2 + (size_t)2 * 2048 * 384 * 2;
constexpr size_t WS_END = WS_SPT + 4096;

struct Params { const float* in[31]; float* out; unsigned char* ws; int ph_lo, ph_hi; };
__device__ __forceinline__ const float* pin(const Params& p, int i) { asm volatile("" : "+s"(i)); return p.in[i]; }

__device__ __forceinline__ int otid() { int t = threadIdx.x; asm volatile("" : "+v"(t)); return t; }
__device__ __forceinline__ int obid() { int t = blockIdx.x; asm volatile("" : "+s"(t)); return t; }
__device__ __forceinline__ float bf2f(unsigned short b) { return __uint_as_float(((unsigned)b) << 16); }
__device__ __forceinline__ unsigned short f2bf(float f) { unsigned u = __float_as_uint(f); u += 0x7FFFu + ((u >> 16) & 1u); return (unsigned short)(u >> 16); }
__device__ __forceinline__ unsigned pk2(float lo, float hi) { return (unsigned)f2bf(lo) | ((unsigned)f2bf(hi) << 16); }
__device__ __forceinline__ f32x4 ld4bf(const bf16_t* p) {
    const u32x2 v = *(const u32x2*)p; f32x4 r;
    r.x = __uint_as_float(v.x << 16); r.y = __uint_as_float(v.x & 0xffff0000u); r.z = __uint_as_float(v.y << 16); r.w = __uint_as_float(v.y & 0xffff0000u); return r;
}
__device__ __forceinline__ void st4bf(bf16_t* p, f32x4 v) { u32x2 o; o.x = pk2(v.x, v.y); o.y = pk2(v.z, v.w); *(u32x2*)p = o; }
__device__ __forceinline__ float sigmoidf_(float x) { return 1.f / (1.f + __expf(-x)); }
__device__ __forceinline__ float siluf_(float x) { return x / (1.f + __expf(-x)); }
__device__ __forceinline__ float softplusf_(float x) { return fmaxf(x, 0.f) + log1pf(__expf(-fabsf(x))); }
__device__ __forceinline__ float gelu_tanh(float x) { const float u = 0.7978845608028654f * (x + 0.044715f * x * x * x); return 0.5f * x * (1.f + tanhf(u)); }
__device__ __forceinline__ float hsum4(f32x4 v) { return (v.x + v.y) + (v.z + v.w); }
__device__ __forceinline__ float red16(float v) { v += __shfl_xor(v, 1); v += __shfl_xor(v, 2); v += __shfl_xor(v, 4); v += __shfl_xor(v, 8); return v; }
__device__ __forceinline__ float red64(float v) { v = red16(v); v += __shfl_xor(v, 16); v += __shfl_xor(v, 32); return v; }
template <int CTRL> __device__ __forceinline__ float dppf(float x) { return __int_as_float(__builtin_amdgcn_update_dpp(0, __float_as_int(x), CTRL, 0xF, 0xF, true)); }
__device__ __forceinline__ float sum4l(float x) { x += dppf<0xB1>(x); x += dppf<0x4E>(x); return x; }
__device__ __forceinline__ unsigned cvt_pk_bf16(float lo, float hi) { unsigned r; asm volatile("v_cvt_pk_bf16_f32 %0, %1, %2" : "=v"(r) : "v"(lo), "v"(hi)); return r; }

namespace pg8 {
constexpr int BM = 256, BK = 64, HALF = 128, HTB = HALF * BK * 2, STAGE_BYTES = 8 * HTB, NXCD = 8, WGM = 8;
__device__ __forceinline__ int lds_byte(int r, int c) { const int st = (r >> 4) * 2 + (c >> 5), rr = r & 15, cc = c & 31, ob = rr * 64 + cc * 2; return st * 1024 + (ob ^ (((ob >> 9) & 1) << 5)); }
__device__ __forceinline__ void stage_rc(int b, int& R, int& C) { const int st = b / 1024, sb = b % 1024, swz = sb ^ (((sb >> 9) & 1) << 5); R = (st >> 1) * 16 + swz / 64; C = (st & 1) * 32 + (swz % 64) / 2; }
__device__ __forceinline__ int perm32(int rho) { const int n = rho >> 4, i = rho & 15; return 8 * (i >> 2) + 4 * n + (i & 3); }
struct Unit { int pm, pn; };
struct Gemm { const bf16_t* A; const bf16_t* Bt; int M, N, K; };
struct StaticOrder {
    int nM, nN, nwg, G, c;
    __device__ void init(int M, int N, int G_, int c_) { nM = M / BM; nN = N / BM; nwg = nM * nN; G = G_; c = c_; }
    __device__ bool next(int i, Unit& u) const {
        const long L = (long)i * G + c; if (L >= nwg) return false;
        int wgid = (int)L; { const int q = nwg / NXCD, r = nwg % NXCD, xcd = wgid % NXCD, off = wgid / NXCD; wgid = (xcd < r ? xcd * (q + 1) : r * (q + 1) + (xcd - r) * q) + off; }
        const int nig = WGM * nN, gid = wgid / nig, fm = gid * WGM, gsz = (nM - fm) < WGM ? (nM - fm) : WGM;
        u.pm = fm + ((wgid % nig) % gsz); u.pn = (wgid % nig) / gsz; return true;
    }
};
struct EpiF32 {
    static constexpr bool PERM = false;
    float* C; int ldc;
    __device__ __forceinline__ void operator()(const f32x4 (&acc)[2][2][4][2], const Unit& u, int wr, int wc, int fr, int fq) const {
        const int row0 = u.pm * BM + wr * 64 + fr, col0 = u.pn * BM + wc * 32 + 4 * fq;
#pragma unroll
        for (int ai = 0; ai < 2; ++ai)
#pragma unroll
            for (int m = 0; m < 4; ++m) { float* rowp = C + (size_t)(row0 + ai * HALF + m * 16) * ldc + col0;
#pragma unroll
                for (int bj = 0; bj < 2; ++bj)
#pragma unroll
                    for (int n = 0; n < 2; ++n) *(f32x4*)(rowp + bj * HALF + n * 16) = acc[ai][bj][m][n]; }
    }
};
struct EpiU {
    static constexpr bool PERM = true;
    bf16_t* U; float* G;
    __device__ __forceinline__ void operator()(const f32x4 (&acc)[2][2][4][2], const Unit& u, int wr, int wc, int fr, int fq) const {
        const int row0 = u.pm * BM + wr * 64 + fr;
        if (u.pn < 13) {
            const int col0 = u.pn * BM + wc * 32 + 8 * fq;
#pragma unroll
            for (int ai = 0; ai < 2; ++ai)
#pragma unroll
                for (int m = 0; m < 4; ++m) { bf16_t* rowp = U + (size_t)(row0 + ai * HALF + m * 16) * NU + col0;
#pragma unroll
                    for (int bj = 0; bj < 2; ++bj) { const f32x4 v0 = acc[ai][bj][m][0], v1 = acc[ai][bj][m][1];
                        u32x4 o; o.x = cvt_pk_bf16(v0[0], v0[1]); o.y = cvt_pk_bf16(v0[2], v0[3]); o.z = cvt_pk_bf16(v1[0], v1[1]); o.w = cvt_pk_bf16(v1[2], v1[3]);
                        *(u32x4*)(rowp + bj * HALF) = o; } }
        } else {
            const int col0 = wc * 32 + 8 * fq;
#pragma unroll
            for (int ai = 0; ai < 2; ++ai)
#pragma unroll
                for (int m = 0; m < 4; ++m) { float* rowp = G + (size_t)(row0 + ai * HALF + m * 16) * NGATE + col0;
#pragma unroll
                    for (int bj = 0; bj < 2; ++bj) { *(f32x4*)(rowp + bj * HALF) = acc[ai][bj][m][0]; *(f32x4*)(rowp + bj * HALF + 4) = acc[ai][bj][m][1]; } }
        }
    }
};
struct EpiSwi {
    static constexpr bool PERM = true;
    bf16_t* H;
    __device__ __forceinline__ void operator()(const f32x4 (&acc)[2][2][4][2], const Unit& u, int wr, int wc, int fr, int fq) const {
        const int row0 = u.pm * BM + wr * 64 + fr, col0 = u.pn * HALF + wc * 32 + 8 * fq;
#pragma unroll
        for (int ai = 0; ai < 2; ++ai)
#pragma unroll
            for (int m = 0; m < 4; ++m) { bf16_t* rowp = H + (size_t)(row0 + ai * HALF + m * 16) * DFF + col0;
                float r[8];
#pragma unroll
                for (int n = 0; n < 2; ++n)
#pragma unroll
                    for (int j = 0; j < 4; ++j) { const float g = acc[ai][0][m][n][j], up = acc[ai][1][m][n][j]; r[n * 4 + j] = g * up * __builtin_amdgcn_rcpf(1.f + __expf(-g)); }
                u32x4 o; o.x = cvt_pk_bf16(r[0], r[1]); o.y = cvt_pk_bf16(r[2], r[3]); o.z = cvt_pk_bf16(r[4], r[5]); o.w = cvt_pk_bf16(r[6], r[7]);
                *(u32x4*)rowp = o; }
    }
};

struct EpiPre {
    static constexpr bool PERM = true;
    unsigned char* ws; const float* gb; const float* lam; const float* w0; const float* a0;
    __device__ __forceinline__ void operator()(const f32x4 (&acc)[2][2][4][2], const Unit& u, int wr_, int wc_, int fr_, int fq_) const {
        const int t_ = otid(); const int wr = t_ >> 8, wc = (t_ >> 6) & 3, fr = t_ & 15, fq = (t_ >> 4) & 3;
        (void)wr_; (void)wc_; (void)fr_; (void)fq_;
        const unsigned row0 = u.pm * BM + wr * 64 + fr;
        if (u.pn < 4) {
            const int dir = u.pn >> 1;
#pragma unroll
            for (int n = 0; n < 2; ++n) { const unsigned c = (u.pn & 1) * 128 + wc * 32 + 8 * fq + 4 * n;
                const f32x4 sp = *(const f32x4*)(lam + dir * 256 + c); const f32x4 gr = *(const f32x4*)(gb + (dir * 2 + 0) * 256 + c), gi = *(const f32x4*)(gb + (dir * 2 + 1) * 256 + c);
#pragma unroll
                for (int ai = 0; ai < 2; ++ai)
#pragma unroll
                    for (int m = 0; m < 4; ++m) { const unsigned row = row0 + ai * HALF + m * 16;
                        const f32x4 xc = ld4bf((const bf16_t*)(ws + (unsigned)WS_A2 + (row * 384u + c) * 2u)); f32x4 la, bb;
#pragma unroll
                        for (int j = 0; j < 4; ++j) { const float rp = acc[ai][0][m][n][j] + gr[j], ip = acc[ai][1][m][n][j] + gi[j];
                            const float l_ = sp[j] * __builtin_amdgcn_rcpf(1.f + __expf(-rp)); const float a_ = __expf(l_);
                            la[j] = l_; bb[j] = __builtin_amdgcn_sqrtf(fmaxf(1.f - a_ * a_, 0.f)) * __builtin_amdgcn_rcpf(1.f + __expf(-ip)) * xc[j]; }
                        u32x2 o; o.x = cvt_pk_bf16(la[0], la[1]); o.y = cvt_pk_bf16(la[2], la[3]); *(u32x2*)(ws + (unsigned)WS_ACT + (row * (unsigned)DM + dir * 256u + c) * 2u) = o;
                        o.x = cvt_pk_bf16(bb[0], bb[1]); o.y = cvt_pk_bf16(bb[2], bb[3]); *(u32x2*)(ws + (unsigned)WS_SC + (row * (unsigned)NSC + dir * 256u + c) * 2u) = o; } }
        } else {
            const int q = u.pn - 4, kind = q >> 1, d = q & 1;
            const float* cst = (kind ? a0 : w0) + d * 256; const float mul = kind ? 1.f : -0.6065306597126334f;
            const unsigned dbase = kind ? (unsigned)WS_ACT + (512u + d * 256u) * 2u : (d ? (unsigned)WS_G + 64u * 2u : (unsigned)WS_U);
            const unsigned dstride = kind ? (unsigned)DM * 2u : (d ? 512u * 2u : (unsigned)NU * 2u);
#pragma unroll
            for (int bj = 0; bj < 2; ++bj)
#pragma unroll
                for (int n = 0; n < 2; ++n) { const unsigned c = bj * HALF + wc * 32 + 8 * fq + 4 * n; const f32x4 cv = *(const f32x4*)(cst + c);
#pragma unroll
                    for (int ai = 0; ai < 2; ++ai)
#pragma unroll
                        for (int m = 0; m < 4; ++m) { const unsigned row = row0 + ai * HALF + m * 16; f32x4 r;
#pragma unroll
                            for (int j = 0; j < 4; ++j) r[j] = mul * __builtin_amdgcn_rcpf(1.f + __expf(-(acc[ai][bj][m][n][j] + cv[j])));
                            u32x2 o; o.x = cvt_pk_bf16(r[0], r[1]); o.y = cvt_pk_bf16(r[2], r[3]);
                            *(u32x2*)(ws + dbase + row * dstride + c * 2u) = o; } }
        }
    }
};

template <class Epi>
__device__ __forceinline__ void gemm_phase(LAS unsigned char* lds, const Gemm g, const StaticOrder& S, const Epi& E) {
    const int tid = otid(), wid = __builtin_amdgcn_readfirstlane(tid >> 6), lane = tid & 63, wr = wid >> 2, wc = wid & 3, fr = lane & 15, fq = lane >> 4;
    const int K = g.K, nt = K / BK;
    unsigned voffA[2], voffB[2];
#pragma unroll
    for (int i = 0; i < 2; ++i) { int R, C; stage_rc(tid * 16 + i * 8192, R, C); const int Rb = Epi::PERM ? ((R & ~31) + perm32(R & 31)) : R;
        voffA[i] = (unsigned)(R * K + C) * 2u; voffB[i] = (unsigned)(Rb * K + C) * 2u; }
    const size_t kstep = (size_t)(BK * 2);
    const size_t hstep = (size_t)HALF * K * 2;
    const size_t tstep = 2 * hstep;
    const unsigned ldsw = (unsigned)wid * 1024u;
    const int aoff = lds_byte(wr * 64 + fr, fq * 8), boff = lds_byte(wc * 32 + fr, fq * 8);
#define PG8_SA(b, h) (((b) * 2 + (h)) * HTB)
#define PG8_SB(b, h) ((4 + (b) * 2 + (h)) * HTB)
#define PG8_STAGE(bufoff, gbase, voff) do { _Pragma("unroll") for (int _i = 0; _i < 2; ++_i) \
        __builtin_amdgcn_global_load_lds((const unsigned*)((const char*)(gbase) + (voff)[_i]), (LAS unsigned*)(lds + (bufoff) + ldsw + _i * 8192), 16, 0, 0); } while (0)
#define PG8_LDA(dst, b, h) do { _Pragma("unroll") for (int m = 0; m < 4; ++m) _Pragma("unroll") for (int k = 0; k < 2; ++k) dst[m][k] = *(const LAS bf16x8*)(lds + PG8_SA(b, h) + aoff + m * 2048 + k * 1024); } while (0)
#define PG8_LDB(dst, b, h) do { _Pragma("unroll") for (int n = 0; n < 2; ++n) _Pragma("unroll") for (int k = 0; k < 2; ++k) dst[n][k] = *(const LAS bf16x8*)(lds + PG8_SB(b, h) + boff + n * 2048 + k * 1024); } while (0)
#define PG8_MMA(ai, bj, At, Bt) do { __builtin_amdgcn_s_setprio(1); _Pragma("unroll") for (int m = 0; m < 4; ++m) _Pragma("unroll") for (int n = 0; n < 2; ++n) _Pragma("unroll") for (int k = 0; k < 2; ++k) \
        acc[ai][bj][m][n] = __builtin_amdgcn_mfma_f32_16x16x32_bf16(Bt[n][k], At[m][k], acc[ai][bj][m][n], 0, 0, 0); __builtin_amdgcn_s_setprio(0); } while (0)
#define PG8_WAIT_V(n) asm volatile("s_waitcnt vmcnt(" #n ")" ::: "memory")
#define PG8_WAIT_L(n) asm volatile("s_waitcnt lgkmcnt(" #n ")" ::: "memory")
#define PG8_BAR __builtin_amdgcn_s_barrier()
#define PG8_SCHED __builtin_amdgcn_sched_barrier(0)
    Unit cur, nxt; int ui = 0;
    if (!S.next(0, cur)) return;
    f32x4 acc[2][2][4][2];
#pragma unroll
    for (int a = 0; a < 2; ++a)
#pragma unroll
        for (int b = 0; b < 2; ++b)
#pragma unroll
            for (int m = 0; m < 4; ++m)
#pragma unroll
                for (int n = 0; n < 2; ++n) acc[a][b][m][n] = (f32x4){0.f, 0.f, 0.f, 0.f};
    bf16x8 At[4][2], B0[2][2], B1[2][2];
    const char* cA = (const char*)g.A + (size_t)cur.pm * tstep; const char* cB = (const char*)g.Bt + (size_t)cur.pn * tstep;
    PG8_STAGE(PG8_SB(0, 0), cB, voffB); PG8_STAGE(PG8_SA(0, 0), cA, voffA); PG8_STAGE(PG8_SB(0, 1), cB + hstep, voffB); PG8_STAGE(PG8_SA(0, 1), cA + hstep, voffA);
    if (wr == 1) PG8_BAR;
    PG8_WAIT_V(4); PG8_BAR;
    PG8_STAGE(PG8_SB(1, 0), cB + kstep, voffB); PG8_STAGE(PG8_SA(1, 0), cA + kstep, voffA); PG8_STAGE(PG8_SB(1, 1), cB + hstep + kstep, voffB);
    PG8_WAIT_V(6); PG8_BAR;
    for (;;) {
        const bool has_next = S.next(ui + 1, nxt);
        const char* nA = has_next ? (const char*)g.A + (size_t)nxt.pm * tstep : cA; const char* nB = has_next ? (const char*)g.Bt + (size_t)nxt.pn * tstep : cB;
        for (int t = 0; t < nt; t += 2) {
            const bool last = (t == nt - 2);
            const char* a1 = cA + (size_t)(t + 1) * kstep;
            const char* a2 = last ? nA : cA + (size_t)(t + 2) * kstep; const char* b2 = last ? nB : cB + (size_t)(t + 2) * kstep;
            const char* a3 = a2 + kstep; const char* b3 = b2 + kstep;
            PG8_LDB(B0, 0, 0); PG8_SCHED; PG8_LDA(At, 0, 0); PG8_STAGE(PG8_SA(1, 1), a1 + hstep, voffA);
            PG8_WAIT_L(8); PG8_BAR; PG8_WAIT_L(0); PG8_MMA(0, 0, At, B0); PG8_BAR; PG8_SCHED;
            PG8_LDB(B1, 0, 1); PG8_STAGE(PG8_SB(0, 0), b2, voffB);
            PG8_BAR; PG8_WAIT_L(0); PG8_MMA(0, 1, At, B1); PG8_BAR;
            PG8_LDA(At, 0, 1); PG8_STAGE(PG8_SA(0, 0), a2, voffA);
            PG8_BAR; PG8_WAIT_L(0); PG8_MMA(1, 0, At, B0); PG8_BAR; PG8_SCHED;
            PG8_STAGE(PG8_SB(0, 1), b2 + hstep, voffB);
            PG8_WAIT_V(6); PG8_BAR; PG8_MMA(1, 1, At, B1); PG8_BAR;
            PG8_LDB(B0, 1, 0); PG8_SCHED; PG8_LDA(At, 1, 0); PG8_STAGE(PG8_SA(0, 1), a2 + hstep, voffA);
            PG8_WAIT_L(8); PG8_BAR; PG8_WAIT_L(0); PG8_MMA(0, 0, At, B0); PG8_BAR; PG8_SCHED;
            PG8_LDB(B1, 1, 1); PG8_STAGE(PG8_SB(1, 0), b3, voffB);
            PG8_BAR; PG8_WAIT_L(0); PG8_MMA(0, 1, At, B1); PG8_BAR;
            PG8_LDA(At, 1, 1); PG8_STAGE(PG8_SA(1, 0), a3, voffA);
            PG8_BAR; PG8_WAIT_L(0); PG8_MMA(1, 0, At, B0); PG8_BAR; PG8_SCHED;
            PG8_STAGE(PG8_SB(1, 1), b3 + hstep, voffB);
            PG8_WAIT_V(6); PG8_BAR; PG8_MMA(1, 1, At, B1); PG8_BAR;
        }
        E(acc, cur, wr, wc, fr, fq);
        if (!has_next) break;
#pragma unroll
        for (int a = 0; a < 2; ++a)
#pragma unroll
            for (int b = 0; b < 2; ++b)
#pragma unroll
                for (int m = 0; m < 4; ++m)
#pragma unroll
                    for (int n = 0; n < 2; ++n) acc[a][b][m][n] = (f32x4){0.f, 0.f, 0.f, 0.f};
        cur = nxt; cA = nA; cB = nB; ++ui;
    }
    PG8_WAIT_V(0);
    if (wr == 0) PG8_BAR;
    PG8_BAR;
#undef PG8_SA
#undef PG8_SB
#undef PG8_STAGE
#undef PG8_LDA
#undef PG8_LDB
#undef PG8_MMA
#undef PG8_WAIT_V
#undef PG8_WAIT_L
#undef PG8_BAR
#undef PG8_SCHED
}
}

__device__ __forceinline__ int src_col(int kind, int n) {
    if (kind == 0) {
        if (n < 1536) return n;
        if (n < 2560) return n + 16;
        if (n < 3328) return n + 32;
        const int j = n - 3328;
        if (j < 16) return 1536 + j;
        if (j < 32) return 2576 + (j - 16);
        if (j < 224) return 3360 + (j - 32);
        return -1;
    }
    if (kind == 2) return ((n & 255) >> 7) * DFF + (n >> 8) * 128 + (n & 127);
    return n;
}
__device__ void phase_convert(const Params& p, LAS float* tile) {
    const int tid = otid();
    bf16_t* WIN = (bf16_t*)(p.ws + WS_WIN); bf16_t* WOUT = (bf16_t*)(p.ws + WS_WOUT); bf16_t* WF1 = (bf16_t*)(p.ws + WS_WF1); bf16_t* WF2 = (bf16_t*)(p.ws + WS_WF2);
    for (int it = blockIdx.x; it < 6528; it += gridDim.x) {
        const int l = it / 3264; int r = it % 3264; int kind, nt, kt, K, Nsrc; const float* W; bf16_t* dst;
        if (r < 896) { kind = 0; nt = r / 16; kt = r % 16; K = 1024; Nsrc = 3552; W = pin(p, 5) + (size_t)l * 1024 * 3552; dst = WIN + (size_t)l * NIN * 1024; }
        else if (r < 1152) { r -= 896; kind = 1; nt = r / 16; kt = r % 16; K = 1024; Nsrc = 1024; W = pin(p, 6) + (size_t)l * 1024 * 1024; dst = WOUT + (size_t)l * 1024 * 1024; }
        else if (r < 2560) { r -= 1152; kind = 2; nt = r / 16; kt = r % 16; K = 1024; Nsrc = 5632; W = pin(p, 29) + (size_t)l * 1024 * 5632; dst = WF1 + (size_t)l * 5632 * 1024; }
        else { r -= 2560; kind = 3; nt = r / 44; kt = r % 44; K = 2816; Nsrc = 1024; W = pin(p, 30) + (size_t)l * 2816 * 1024; dst = WF2 + (size_t)l * 1024 * 2816; }
        for (int idx = tid; idx < 4096; idx += 512) {
            const int i = idx >> 6, j = idx & 63; const int sc = src_col(kind, nt * 64 + j);
            tile[i * 65 + j] = (sc >= 0) ? W[(size_t)(kt * 64 + i) * Nsrc + sc] : 0.f;
        }
        __syncthreads();
        for (int idx = tid; idx < 4096; idx += 512) {
            const int jn = idx >> 6, ik = idx & 63;
            dst[(size_t)(nt * 64 + jn) * K + kt * 64 + ik] = f2bf(tile[ik * 65 + jn]);
        }
        __syncthreads();
    }
    {
        bf16_t* BT2 = (bf16_t*)(p.ws + WS_BT2);
        for (int idx = blockIdx.x * 512 + tid; idx < 2 * 2048 * 384; idx += gridDim.x * 512) {
            const int l = idx / (2048 * 384), rem = idx % (2048 * 384), n = rem / 384, k = rem % 384, pn = n >> 8, cc = n & 255;
            float v = 0.f;
            if (pn < 4) { const int dir = pn >> 1, gate = cc >> 7, c = (pn & 1) * 128 + (cc & 127), nb = c >> 6, o = c & 63;
                if (k < 256 && (k >> 6) == nb) v = pin(p, 9)[((size_t)((((l * 2 + dir) * 2 + gate) * 4 + nb) * 64 + (k & 63))) * 64 + o]; }
            else { const int q = pn - 4, kind = q >> 1, d = q & 1, kb = 256 + kind * 64 + d * 32;
                if (k >= kb && k < kb + 32) v = (kind ? pin(p, 22) : pin(p, 20))[(size_t)((l * 2 + d) * 32 + (k - kb)) * 256 + cc]; }
            BT2[idx] = f2bf(v);
        }
        if (blockIdx.x == 0) for (int i = tid; i < 1024; i += 512) ((float*)(p.ws + WS_SPT))[i] = -8.f * softplusf_(-pin(p, 11)[i]);
    }
}
__device__ void row_pass(const float* O, const float* g1, const float* xres, float* xout, const float* g2, bf16_t* hb) {
    const int tid = otid(); const int lane = tid & 63, gw = blockIdx.x * 8 + (tid >> 6), nw = gridDim.x * 8;
    for (int row = gw; row < T_TOK; row += nw) {
        f32x4 v[4];
        if (O) {
            const f32x4* op = (const f32x4*)(O + (size_t)row * DM) + lane; const f32x4* xp = (const f32x4*)(xres + (size_t)row * DM) + lane;
            float ss = 0.f;
#pragma unroll
            for (int j = 0; j < 4; ++j) { v[j] = op[64 * j]; ss += hsum4(v[j] * v[j]); }
            const float inv = rsqrtf(red64(ss) * (1.f / DM) + 1e-6f);
#pragma unroll
            for (int j = 0; j < 4; ++j) { const f32x4 gg = *((const f32x4*)g1 + lane + 64 * j); v[j] = xp[64 * j] + v[j] * inv * gg; }
            f32x4* xo = (f32x4*)(xout + (size_t)row * DM) + lane;
#pragma unroll
            for (int j = 0; j < 4; ++j) xo[64 * j] = v[j];
        } else {
            const f32x4* xp = (const f32x4*)(xres + (size_t)row * DM) + lane;
#pragma unroll
            for (int j = 0; j < 4; ++j) v[j] = xp[64 * j];
        }
        if (g2) {
            float ss = 0.f;
#pragma unroll
            for (int j = 0; j < 4; ++j) ss += hsum4(v[j] * v[j]);
            const float inv = rsqrtf(red64(ss) * (1.f / DM) + 1e-6f);
            bf16_t* hp = hb + (size_t)row * DM;
#pragma unroll
            for (int j = 0; j < 4; ++j) { const f32x4 gg = *((const f32x4*)g2 + lane + 64 * j); st4bf(hp + 4 * (lane + 64 * j), v[j] * inv * gg); }
        }
    }
}

__device__ void phase_prepass(const Params& p, int l) {
    const int tid = otid(); const int lane = tid & 63, gw = blockIdx.x * 8 + (tid >> 6), nw = gridDim.x * 8;
    const bf16_t* U = (const bf16_t*)(p.ws + WS_U); const float* G = (const float*)(p.ws + WS_G); bf16_t* A2 = (bf16_t*)(p.ws + WS_A2);
    const int c = 4 * lane;
    f32x4 cwv[4];
#pragma unroll
    for (int j = 0; j < 4; ++j) cwv[j] = *(const f32x4*)(pin(p, 7) + (size_t)l * 1024 + j * 256 + c);
    const f32x4 cb = *(const f32x4*)(pin(p, 8) + (size_t)l * 256 + c);
    const float* mu0 = pin(p, 18) + (size_t)l * 2 * 960; const float* mu1 = mu0 + 960;
    const int lc = (lane & 31) * 4;
    const f32x4 ml0 = *(const f32x4*)(mu0 + 768 + lc), ml1 = *(const f32x4*)(mu1 + 768 + lc);
    const f32x4 z4 = (f32x4){0.f, 0.f, 0.f, 0.f};
    for (int tok = gw; tok < T_TOK; tok += nw) {
        const int t = tok & (SEQ - 1);
        f32x4 xc = cb;
#pragma unroll
        for (int j = 0; j < 4; ++j) { const int ts = t + j - 2; if (ts >= 0 && ts < SEQ) xc += cwv[j] * ld4bf(U + (size_t)(tok + j - 2) * NU + c); }
        st4bf(A2 + (size_t)tok * 384 + c, xc);
        if (lane < 32) {
            const float* gp = G + (size_t)tok * NGATE + 32 + lc;
            const f32x4 cur = *(const f32x4*)gp, pv = (t > 0) ? *(const f32x4*)(gp - NGATE) : z4, nx = (t < SEQ - 1) ? *(const f32x4*)(gp + NGATE) : z4;
            f32x4 lr = cur + ml0 * (pv - cur) + ml1 * (nx - cur);
            if (lane < 16) { lr.x = tanhf(lr.x); lr.y = tanhf(lr.y); lr.z = tanhf(lr.z); lr.w = tanhf(lr.w); }
            st4bf(A2 + (size_t)tok * 384 + 256 + lc, lr);
        }
    }
}

constexpr int TT = 32, NTILE = SEQ / TT;
__device__ __forceinline__ float sum8l(float x) { x += dppf<0xB1>(x); x += dppf<0x4E>(x); x += dppf<0x141>(x); return x; }
__device__ __forceinline__ f32x4 bf4(u32x2 v) { f32x4 r; r.x = __uint_as_float(v.x << 16); r.y = __uint_as_float(v.x & 0xffff0000u); r.z = __uint_as_float(v.y << 16); r.w = __uint_as_float(v.y & 0xffff0000u); return r; }

__device__ void gdn_task(const Params& p, int l, int b, int h, int dir, LAS float* sm) {
    const int tid = otid(), wave = tid >> 6, lane = tid & 63;
    LAS float* Qs = sm; LAS float* Ks = sm + 2048; LAS float* Vs = sm + 4096; LAS float* Os = sm + 6144; LAS float* AB = sm + 8192;
    const bf16_t* U = (const bf16_t*)(p.ws + WS_U); const float* G = (const float*)(p.ws + WS_G); bf16_t* SC = (bf16_t*)(p.ws + WS_SC);
    const int pt = tid >> 4, c4 = (tid & 15) * 4;
    const float* cw = pin(p, 12) + (size_t)l * 4 * 768 + h * 64 + c4;
    f32x4 wq[4], wk[4], wv[4];
#pragma unroll
    for (int j = 0; j < 4; ++j) { wq[j] = *(const f32x4*)(cw + j * 768); wk[j] = *(const f32x4*)(cw + j * 768 + 256); wv[j] = *(const f32x4*)(cw + j * 768 + 512); }
    const float nea = -__expf(pin(p, 13)[l * 8 + dir * 4 + h]), dtb = pin(p, 14)[l * 8 + dir * 4 + h];
    const int row = (wave & 3) * 16 + (lane >> 2), sub = lane & 3;
    f32x4 s4[4];
#pragma unroll
    for (int j = 0; j < 4; ++j) s4[j] = (f32x4){0.f, 0.f, 0.f, 0.f};
    u32x2 rq[4], rk[4], rv[4]; float ga = 0.f, gb = 0.f;
    const u32x2 zz = (u32x2){0u, 0u};
#define GDN_LOADRAW(T0) do { const int _t = (T0) + pt; _Pragma("unroll") for (int j = 0; j < 4; ++j) { const int ts = _t + j - 2; const bool ok = (ts >= 0 && ts < SEQ); \
        const bf16_t* up = U + (size_t)(b * SEQ + (ok ? ts : _t)) * NU + 512 + h * 64 + c4; \
        rq[j] = ok ? *(const u32x2*)up : zz; rk[j] = ok ? *(const u32x2*)(up + 256) : zz; rv[j] = ok ? *(const u32x2*)(up + 512) : zz; } \
        if (tid < TT) { const float* gp = G + (size_t)(b * SEQ + (T0) + tid) * NGATE; ga = gp[dir * 4 + h]; gb = gp[8 + dir * 4 + h]; } } while (0)
    GDN_LOADRAW((dir ? NTILE - 1 : 0) * TT);
    for (int kt = 0; kt < NTILE; ++kt) {
        const int t0 = (dir ? NTILE - 1 - kt : kt) * TT;
        {
            f32x4 aq = (f32x4){0.f, 0.f, 0.f, 0.f}, ak = aq, av = aq;
#pragma unroll
            for (int j = 0; j < 4; ++j) { aq += wq[j] * bf4(rq[j]); ak += wk[j] * bf4(rk[j]); av += wv[j] * bf4(rv[j]); }
#pragma unroll
            for (int e = 0; e < 4; ++e) { aq[e] = siluf_(aq[e]); ak[e] = siluf_(ak[e]); av[e] = siluf_(av[e]); }
            const float sq = red16(hsum4(aq * aq)), sk = red16(hsum4(ak * ak));
            aq = aq * (rsqrtf(sq + 1e-6f) * 0.125f); ak = ak * rsqrtf(sk + 1e-6f);
            *(LAS f32x4*)(Qs + pt * 64 + c4) = aq; *(LAS f32x4*)(Ks + pt * 64 + c4) = ak; *(LAS f32x4*)(Vs + pt * 64 + c4) = av;
            if (tid < TT) { const float g = nea * softplusf_(ga + dtb); AB[tid * 2] = __expf(g); AB[tid * 2 + 1] = sigmoidf_(gb); }
        }
        if (kt + 1 < NTILE) GDN_LOADRAW((dir ? NTILE - 2 - kt : kt + 1) * TT);
        __syncthreads();
        if (wave < 4) {
            f32x4 kA[4], qA[4], kB[4], qB[4]; float aA, bA, vA, aB, bB, vB;
#define GDN_LD(K_, Q_, A_, B_, V_, I_) do { const int _i = (I_) < TT ? (I_) : TT - 1; const int _tt = dir ? TT - 1 - _i : _i; const LAS float* kp = Ks + _tt * 64 + 4 * sub; const LAS float* qp = Qs + _tt * 64 + 4 * sub; \
        _Pragma("unroll") for (int j = 0; j < 4; ++j) { K_[j] = *(const LAS f32x4*)(kp + 16 * j); Q_[j] = *(const LAS f32x4*)(qp + 16 * j); } \
        A_ = AB[_tt * 2]; B_ = AB[_tt * 2 + 1]; V_ = Vs[_tt * 64 + row]; } while (0)
#define GDN_STEP(K_, Q_, A_, B_, V_, U_) do { f32x4 d4 = s4[0] * K_[0] + s4[1] * K_[1]; d4 += s4[2] * K_[2] + s4[3] * K_[3]; \
        const float d = sum4l(hsum4(d4)); const float c = B_ * (V_ - A_ * d); \
        _Pragma("unroll") for (int j = 0; j < 4; ++j) s4[j] = s4[j] * A_ + K_[j] * c; \
        f32x4 o4 = s4[0] * Q_[0] + s4[1] * Q_[1]; o4 += s4[2] * Q_[2] + s4[3] * Q_[3]; \
        const float o = sum4l(hsum4(o4)); okeep = (sub == (U_)) ? o : okeep; } while (0)
            GDN_LD(kA, qA, aA, bA, vA, 0);
            for (int gq = 0; gq < TT / 4; ++gq) {
                float okeep = 0.f; const int i0 = gq * 4;
                GDN_LD(kB, qB, aB, bB, vB, i0 + 1); GDN_STEP(kA, qA, aA, bA, vA, 0);
                GDN_LD(kA, qA, aA, bA, vA, i0 + 2); GDN_STEP(kB, qB, aB, bB, vB, 1);
                GDN_LD(kB, qB, aB, bB, vB, i0 + 3); GDN_STEP(kA, qA, aA, bA, vA, 2);
                GDN_LD(kA, qA, aA, bA, vA, i0 + 4); GDN_STEP(kB, qB, aB, bB, vB, 3);
                const int is = i0 + sub, tts = dir ? TT - 1 - is : is;
                Os[tts * 64 + row] = okeep;
            }
#undef GDN_LD
#undef GDN_STEP
        }
        __syncthreads();
        st4bf(SC + (size_t)(b * SEQ + t0 + pt) * NSC + 512 + dir * 256 + h * 64 + c4, *(const LAS f32x4*)(Os + pt * 64 + c4));
    }
#undef GDN_LOADRAW
    __syncthreads();
}

__device__ void mlstm_task(const Params& p, int l, int b, int h, int dir, LAS float* sm) {
    const int tid = otid(), wave = tid >> 6, lane = tid & 63;
    LAS float* Qs = sm; LAS float* Ks = sm + 2048; LAS float* Vs = sm + 4096; LAS float* Os = sm + 6144; LAS float* Dn = sm + 8192; LAS float* FI = sm + 10240;
    LAS float* LA = sm + 12288; LAS float* LB = sm + 14336; LAS float* LO = sm + 16384;
    const bf16_t* U = (const bf16_t*)(p.ws + WS_U); const float* G = (const float*)(p.ws + WS_G); bf16_t* SC = (bf16_t*)(p.ws + WS_SC); const bf16_t* ACT = (const bf16_t*)(p.ws + WS_ACT);
    const int pt = tid >> 4, c4 = (tid & 15) * 4;
    const float bias_i = pin(p, 16)[l * 16 + dir * 8 + h], bias_f = pin(p, 16)[l * 16 + dir * 8 + 4 + h];
    const int row = (wave & 3) * 16 + (lane >> 2), sub = lane & 3;
    const int ldir = dir, ln = h;
    const int lr8 = lane >> 3, lc8 = (lane & 7) * 8;
    f32x4 s4[4];
#pragma unroll
    for (int j = 0; j < 4; ++j) s4[j] = (f32x4){0.f, 0.f, 0.f, 0.f};
    float nst = 0.f, hst = 0.f;
    u32x2 rq, rk, rv; float gi = 0.f, gf = 0.f; u32x4 la4[4], lb4[4];
#define ML_LOADRAW(T0) do { const bf16_t* up = U + (size_t)(b * SEQ + (T0) + pt) * NU + 1536 + h * 64 + c4; rq = *(const u32x2*)up; rk = *(const u32x2*)(up + 256); rv = *(const u32x2*)(up + 512); \
        if (tid < TT) { const float* gp = G + (size_t)(b * SEQ + (T0) + tid) * NGATE + 16; gi = gp[dir * 4 + h]; gf = gp[8 + dir * 4 + h]; } \
        if (wave == 5) { _Pragma("unroll") for (int q = 0; q < 4; ++q) { const size_t tok = (size_t)(b * SEQ + (T0) + q * 8 + lr8); \
            la4[q] = *(const u32x4*)(ACT + tok * DM + ldir * 256 + ln * 64 + lc8); lb4[q] = *(const u32x4*)(SC + tok * NSC + ldir * 256 + ln * 64 + lc8); } } } while (0)
    ML_LOADRAW((dir ? NTILE - 1 : 0) * TT);
    for (int kt = 0; kt < NTILE; ++kt) {
        const int t0 = (dir ? NTILE - 1 - kt : kt) * TT;
        {
            *(LAS f32x4*)(Qs + pt * 64 + c4) = bf4(rq); *(LAS f32x4*)(Ks + pt * 64 + c4) = bf4(rk) * 0.125f; *(LAS f32x4*)(Vs + pt * 64 + c4) = bf4(rv);
            if (tid < TT) { const float ig = 15.f * tanhf((gi + bias_i) * (1.f / 15.f)); const float fp = 15.f * tanhf((gf + bias_f) * (1.f / 15.f));
                FI[tid * 2] = sigmoidf_(fp); FI[tid * 2 + 1] = __expf(ig); }
            if (wave == 5) {
#pragma unroll
                for (int q = 0; q < 4; ++q) { const int o = (q * 8 + lr8) * 64 + lc8;
                    f32x4 a0 = bf4((u32x2){la4[q].x, la4[q].y}), a1 = bf4((u32x2){la4[q].z, la4[q].w});
#pragma unroll
                    for (int e = 0; e < 4; ++e) { a0[e] = __expf(a0[e]); a1[e] = __expf(a1[e]); }
                    *(LAS f32x4*)(LA + o) = a0; *(LAS f32x4*)(LA + o + 4) = a1;
                    *(LAS f32x4*)(LB + o) = bf4((u32x2){lb4[q].x, lb4[q].y}); *(LAS f32x4*)(LB + o + 4) = bf4((u32x2){lb4[q].z, lb4[q].w}); }
            }
        }
        if (kt + 1 < NTILE) ML_LOADRAW((dir ? NTILE - 2 - kt : kt + 1) * TT);
        __syncthreads();
        if (wave < 4) {
            f32x4 kA[4], qA[4], kB[4], qB[4]; float fA, vA, fB, vB;
#define ML_LD(K_, Q_, F_, V_, I_) do { const int _i = (I_) < TT ? (I_) : TT - 1; const int _tt = dir ? TT - 1 - _i : _i; const LAS float* kp = Ks + _tt * 64 + 4 * sub; const LAS float* qp = Qs + _tt * 64 + 4 * sub; \
        _Pragma("unroll") for (int j = 0; j < 4; ++j) { K_[j] = *(const LAS f32x4*)(kp + 16 * j); Q_[j] = *(const LAS f32x4*)(qp + 16 * j); } \
        F_ = FI[_tt * 2]; V_ = FI[_tt * 2 + 1] * Vs[_tt * 64 + row]; } while (0)
#define ML_STEP(K_, Q_, F_, V_, U_) do { _Pragma("unroll") for (int j = 0; j < 4; ++j) s4[j] = s4[j] * F_ + K_[j] * V_; \
        f32x4 o4 = s4[0] * Q_[0] + s4[1] * Q_[1]; o4 += s4[2] * Q_[2] + s4[3] * Q_[3]; \
        const float o = sum4l(hsum4(o4)); okeep = (sub == (U_)) ? o : okeep; } while (0)
            ML_LD(kA, qA, fA, vA, 0);
            for (int gq = 0; gq < TT / 4; ++gq) {
                float okeep = 0.f; const int i0 = gq * 4;
                ML_LD(kB, qB, fB, vB, i0 + 1); ML_STEP(kA, qA, fA, vA, 0);
                ML_LD(kA, qA, fA, vA, i0 + 2); ML_STEP(kB, qB, fB, vB, 1);
                ML_LD(kB, qB, fB, vB, i0 + 3); ML_STEP(kA, qA, fA, vA, 2);
                ML_LD(kA, qA, fA, vA, i0 + 4); ML_STEP(kB, qB, fB, vB, 3);
                const int is = i0 + sub, tts = dir ? TT - 1 - is : is;
                Os[tts * 64 + row] = okeep;
            }
#undef ML_LD
#undef ML_STEP
        } else if (wave == 4) {
#pragma unroll 8
            for (int i = 0; i < TT; ++i) { const int tt = dir ? TT - 1 - i : i;
                nst = nst * FI[tt * 2] + FI[tt * 2 + 1] * Ks[tt * 64 + lane];
                Dn[tt * 64 + lane] = nst * Qs[tt * 64 + lane]; }
        } else if (wave == 5) {
#pragma unroll 8
            for (int i = 0; i < TT; ++i) { const int tt = ldir ? TT - 1 - i : i; hst = LA[tt * 64 + lane] * hst + LB[tt * 64 + lane]; LO[tt * 64 + lane] = hst; }
        }
        __syncthreads();
        {
            const float den = red16(hsum4(*(const LAS f32x4*)(Dn + pt * 64 + c4)));
            const float sc = 1.f / fmaxf(fabsf(den), 1.f);
            st4bf(SC + (size_t)(b * SEQ + t0 + pt) * NSC + 1024 + dir * 256 + h * 64 + c4, *(const LAS f32x4*)(Os + pt * 64 + c4) * sc);
            if (wave == 5) {
#pragma unroll
                for (int q = 0; q < 4; ++q) { const int o = (q * 8 + lr8) * 64 + lc8; const f32x4 h0 = *(const LAS f32x4*)(LO + o), h1 = *(const LAS f32x4*)(LO + o + 4);
                    u32x4 w; w.x = pk2(h0.x, h0.y); w.y = pk2(h0.z, h0.w); w.z = pk2(h1.x, h1.y); w.w = pk2(h1.z, h1.w);
                    *(u32x4*)(SC + (size_t)(b * SEQ + t0 + q * 8 + lr8) * NSC + ldir * 256 + ln * 64 + lc8) = w; }
            }
        }
    }
#undef ML_LOADRAW
    __syncthreads();
}

__device__ void rwkv_task(const Params& p, int l, int b, int h, int dir, int half, LAS float* sm) {
    const int tid = otid(), wave = tid >> 6, lane = tid & 63;
    LAS float* Rs = sm; LAS float* Ws = sm + 2048; LAS float* KKs = sm + 4096; LAS float* KAs = sm + 6144; LAS float* KDs = sm + 8192; LAS float* Vs = sm + 10240; LAS float* Os = sm + 12288;
    const bf16_t* U = (const bf16_t*)(p.ws + WS_U); const bf16_t* Gb = (const bf16_t*)(p.ws + WS_G); bf16_t* SC = (bf16_t*)(p.ws + WS_SC); const bf16_t* ACT = (const bf16_t*)(p.ws + WS_ACT);
    const int pt = tid >> 4, c4 = (tid & 15) * 4, hc = h * 64 + c4;
    const float* mu0 = pin(p, 18) + (size_t)l * 2 * 960; const float* mu1 = mu0 + 960;
    const f32x4 mr0 = *(const f32x4*)(mu0 + hc), mr1 = *(const f32x4*)(mu1 + hc), mk0 = *(const f32x4*)(mu0 + 256 + hc), mk1 = *(const f32x4*)(mu1 + 256 + hc),
                mv0 = *(const f32x4*)(mu0 + 512 + hc), mv1 = *(const f32x4*)(mu1 + 512 + hc);
    const f32x4 kkv = *(const f32x4*)(pin(p, 24) + (size_t)l * 256 + hc), kav = *(const f32x4*)(pin(p, 25) + (size_t)l * 256 + hc);
    const int row = half * 32 + (wave & 3) * 8 + (lane >> 3), sub = lane & 7;
    f32x4 s4[2];
    s4[0] = (f32x4){0.f, 0.f, 0.f, 0.f}; s4[1] = s4[0];
    const u32x2 zz = (u32x2){0u, 0u};
    u32x2 rc, rp, rn, kc, kp_, kn, vc, vp, vn, ew, aa;
#define RW_LOADRAW(T0) do { const int _t = (T0) + pt; const bool hp = _t > 0, hn = _t < SEQ - 1; const size_t tok = (size_t)(b * SEQ + _t); \
        const bf16_t* up = U + tok * NU + 2560 + hc; \
        rc = *(const u32x2*)up; rp = hp ? *(const u32x2*)(up - NU) : zz; rn = hn ? *(const u32x2*)(up + NU) : zz; \
        kc = *(const u32x2*)(up + 256); kp_ = hp ? *(const u32x2*)(up + 256 - NU) : zz; kn = hn ? *(const u32x2*)(up + 256 + NU) : zz; \
        vc = *(const u32x2*)(up + 512); vp = hp ? *(const u32x2*)(up + 512 - NU) : zz; vn = hn ? *(const u32x2*)(up + 512 + NU) : zz; \
        ew = dir ? *(const u32x2*)(Gb + tok * 512 + 64 + hc) : *(const u32x2*)(U + tok * NU + hc); \
        aa = *(const u32x2*)(ACT + tok * DM + 512 + dir * 256 + hc); } while (0)
    RW_LOADRAW((dir ? NTILE - 1 : 0) * TT);
    for (int kt = 0; kt < NTILE; ++kt) {
        const int t0 = (dir ? NTILE - 1 - kt : kt) * TT;
        {
            f32x4 c = bf4(rc); const f32x4 rr = c + mr0 * (bf4(rp) - c) + mr1 * (bf4(rn) - c);
            c = bf4(kc); const f32x4 kk = c + mk0 * (bf4(kp_) - c) + mk1 * (bf4(kn) - c);
            c = bf4(vc); const f32x4 vv = c + mv0 * (bf4(vp) - c) + mv1 * (bf4(vn) - c);
            f32x4 w = bf4(ew); const f32x4 a = bf4(aa);
#pragma unroll
            for (int e = 0; e < 4; ++e) w[e] = __expf(w[e]);
            f32x4 kn_ = kk * kkv; const float ss = red16(hsum4(kn_ * kn_)); kn_ = kn_ * rsqrtf(ss + 1e-6f);
            *(LAS f32x4*)(Rs + pt * 64 + c4) = rr; *(LAS f32x4*)(Ws + pt * 64 + c4) = w; *(LAS f32x4*)(KKs + pt * 64 + c4) = kn_;
            *(LAS f32x4*)(KAs + pt * 64 + c4) = kn_ * a; *(LAS f32x4*)(KDs + pt * 64 + c4) = kk * (1.f + (a - 1.f) * kav); *(LAS f32x4*)(Vs + pt * 64 + c4) = vv;
        }
        if (kt + 1 < NTILE) RW_LOADRAW((dir ? NTILE - 2 - kt : kt + 1) * TT);
        __syncthreads();
        if (wave < 4) {
            f32x4 wA[2], nA[2], aA[2], dA[2], rA[2], wB[2], nB[2], aB[2], dB[2], rB[2]; float vA, vB;
#define RW_LD(W_, N_, A_, D_, R_, V_, I_) do { const int _i = (I_) < TT ? (I_) : TT - 1; const int _tt = dir ? TT - 1 - _i : _i; const int o = _tt * 64 + 4 * sub; \
        _Pragma("unroll") for (int j = 0; j < 2; ++j) { W_[j] = *(const LAS f32x4*)(Ws + o + 32 * j); N_[j] = *(const LAS f32x4*)(KKs + o + 32 * j); A_[j] = *(const LAS f32x4*)(KAs + o + 32 * j); \
            D_[j] = *(const LAS f32x4*)(KDs + o + 32 * j); R_[j] = *(const LAS f32x4*)(Rs + o + 32 * j); } \
        V_ = Vs[_tt * 64 + row]; } while (0)
#define RW_STEP(W_, N_, A_, D_, R_, V_, U_) do { const f32x4 x4 = s4[0] * N_[0] + s4[1] * N_[1]; const float sa = -sum8l(hsum4(x4)); \
        _Pragma("unroll") for (int j = 0; j < 2; ++j) s4[j] = s4[j] * W_[j] + A_[j] * sa + D_[j] * V_; \
        const f32x4 o4 = s4[0] * R_[0] + s4[1] * R_[1]; const float o = sum8l(hsum4(o4)); okeep = (sub == (U_)) ? o : okeep; } while (0)
            RW_LD(wA, nA, aA, dA, rA, vA, 0);
            for (int gq = 0; gq < TT / 8; ++gq) {
                float okeep = 0.f; const int i0 = gq * 8;
                RW_LD(wB, nB, aB, dB, rB, vB, i0 + 1); RW_STEP(wA, nA, aA, dA, rA, vA, 0);
                RW_LD(wA, nA, aA, dA, rA, vA, i0 + 2); RW_STEP(wB, nB, aB, dB, rB, vB, 1);
                RW_LD(wB, nB, aB, dB, rB, vB, i0 + 3); RW_STEP(wA, nA, aA, dA, rA, vA, 2);
                RW_LD(wA, nA, aA, dA, rA, vA, i0 + 4); RW_STEP(wB, nB, aB, dB, rB, vB, 3);
                RW_LD(wB, nB, aB, dB, rB, vB, i0 + 5); RW_STEP(wA, nA, aA, dA, rA, vA, 4);
                RW_LD(wA, nA, aA, dA, rA, vA, i0 + 6); RW_STEP(wB, nB, aB, dB, rB, vB, 5);
                RW_LD(wB, nB, aB, dB, rB, vB, i0 + 7); RW_STEP(wA, nA, aA, dA, rA, vA, 6);
                RW_LD(wA, nA, aA, dA, rA, vA, i0 + 8); RW_STEP(wB, nB, aB, dB, rB, vB, 7);
                const int is = i0 + sub, tts = dir ? TT - 1 - is : is;
                Os[tts * 64 + row] = okeep;
            }
#undef RW_LD
#undef RW_STEP
        }
        __syncthreads();
        {
            const int t = tid >> 4, r2 = half * 32 + (tid & 15) * 2;
            *(unsigned*)(SC + (size_t)(b * SEQ + t0 + t) * NSC + 1536 + dir * 256 + h * 64 + r2) = pk2(Os[t * 64 + r2], Os[t * 64 + r2 + 1]);
        }
    }
#undef RW_LOADRAW
    __syncthreads();
}

__device__ void phase_scan(const Params& p, int l, LAS float* sm) {
    for (int task = blockIdx.x; task < 256; task += gridDim.x) {
        if (task < 128) { const int half = task & 1, rest = task >> 1; rwkv_task(p, l, rest & 7, rest >> 4, (rest >> 3) & 1, half, sm); }
        else if (task < 192) { const int rest = task - 128; gdn_task(p, l, rest & 7, rest >> 4, (rest >> 3) & 1, sm); }
        else { const int rest = task - 192; mlstm_task(p, l, rest & 7, rest >> 4, (rest >> 3) & 1, sm); }
    }
}

__device__ void phase_finalize(const Params& p, int l, LAS float* sm) {
    const int tid = otid(), lane = tid & 63;
    LAS float* GUP = sm;
    for (int i = tid; i < 16384; i += 512) GUP[i] = pin(p, 23)[(size_t)l * 16384 + i];
    __syncthreads();
    const bf16_t* U = (const bf16_t*)(p.ws + WS_U); const float* G = (const float*)(p.ws + WS_G); const bf16_t* SC = (const bf16_t*)(p.ws + WS_SC); bf16_t* Y = (bf16_t*)(p.ws + WS_ACT);
    const int c = lane * 4, hc = c & 63;
    const f32x4 gdn_g = *(const f32x4*)(pin(p, 15) + (size_t)l * 64 + hc), ml_g = *(const f32x4*)(pin(p, 17) + (size_t)l * 256 + c);
    const float* mu0 = pin(p, 18) + (size_t)l * 2 * 960; const float* mu1 = mu0 + 960;
    const f32x4 mr0 = *(const f32x4*)(mu0 + c), mr1 = *(const f32x4*)(mu1 + c), mk0 = *(const f32x4*)(mu0 + 256 + c), mk1 = *(const f32x4*)(mu1 + 256 + c),
                mv0 = *(const f32x4*)(mu0 + 512 + c), mv1 = *(const f32x4*)(mu1 + 512 + c);
    const float mg0 = mu0[896 + lane], mg1 = mu1[896 + lane];
    const f32x4 rk = *(const f32x4*)(pin(p, 26) + (size_t)l * 256 + c), gnw = *(const f32x4*)(pin(p, 27) + (size_t)l * 256 + c), gnb = *(const f32x4*)(pin(p, 28) + (size_t)l * 256 + c);
    const f32x4 z4 = (f32x4){0.f, 0.f, 0.f, 0.f};
    const int gw = blockIdx.x * 8 + (tid >> 6), nw = gridDim.x * 8;
    for (int tok = gw; tok < T_TOK; tok += nw) {
        const int t = tok & (SEQ - 1); const bool hp = t > 0, hn = t < SEQ - 1;
        const bf16_t* u = U + (size_t)tok * NU; const bf16_t* sc = SC + (size_t)tok * NSC; bf16_t* y = Y + (size_t)tok * DM;
        { const f32x4 hh = ld4bf(sc + c) + ld4bf(sc + 256 + c), yb = ld4bf(u + 256 + c); f32x4 o;
          for (int e = 0; e < 4; ++e) o[e] = hh[e] * gelu_tanh(yb[e]);
          st4bf(y + c, o); }
        { const f32x4 o = ld4bf(sc + 512 + c) + ld4bf(sc + 768 + c), z = ld4bf(u + 1280 + c);
          const float inv = rsqrtf(red16(hsum4(o * o)) * (1.f / 64.f) + 1e-6f); f32x4 r;
          for (int e = 0; e < 4; ++e) r[e] = o[e] * inv * gdn_g[e] * siluf_(z[e]);
          st4bf(y + 256 + c, r); }
        { const f32x4 o = ld4bf(sc + 1024 + c) + ld4bf(sc + 1280 + c), og = ld4bf(u + 2304 + c);
          const float inv = rsqrtf(red16(hsum4(o * o)) * (1.f / 64.f) + 1e-6f); f32x4 r;
          for (int e = 0; e < 4; ++e) r[e] = o[e] * inv * ml_g[e] * sigmoidf_(og[e]);
          st4bf(y + 512 + c, r); }
        {
            const f32x4 yy = ld4bf(sc + 1536 + c) + ld4bf(sc + 1792 + c);
            const float mean = red16(hsum4(yy)) * (1.f / 64.f); const f32x4 dv = yy - mean;
            const float var = red16(hsum4(dv * dv)) * (1.f / 64.f); const float inv = rsqrtf(var + 64e-5f);
            const bf16_t* up = u + 2560 + c;
            f32x4 rr, kk, vv;
            { const f32x4 cc = ld4bf(up), pv = hp ? ld4bf(up - NU) : z4, nx = hn ? ld4bf(up + NU) : z4; rr = cc + mr0 * (pv - cc) + mr1 * (nx - cc); }
            { const f32x4 cc = ld4bf(up + 256), pv = hp ? ld4bf(up + 256 - NU) : z4, nx = hn ? ld4bf(up + 256 + NU) : z4; kk = cc + mk0 * (pv - cc) + mk1 * (nx - cc); }
            { const f32x4 cc = ld4bf(up + 512), pv = hp ? ld4bf(up + 512 - NU) : z4, nx = hn ? ld4bf(up + 512 + NU) : z4; vv = cc + mv0 * (pv - cc) + mv1 * (nx - cc); }
            const float bsum = red16(hsum4(rr * kk * rk));
            const float* gp = G + (size_t)tok * NGATE + 160 + lane;
            const float gc = gp[0], gpv = hp ? gp[-NGATE] : 0.f, gnx = hn ? gp[NGATE] : 0.f;
            const float sg = sigmoidf_(gc + mg0 * (gpv - gc) + mg1 * (gnx - gc));
            f32x4 gate = z4;
#pragma unroll 16
            for (int r = 0; r < 64; ++r) gate += *(const LAS f32x4*)(GUP + r * 256 + c) * __shfl(sg, r);
            f32x4 o;
            for (int e = 0; e < 4; ++e) o[e] = (dv[e] * inv * gnw[e] + gnb[e] + bsum * vv[e]) * gate[e];
            st4bf(y + 768 + c, o);
        }
    }
    __syncthreads();
}

#ifndef EN_GEMM
#define EN_GEMM 1
#endif
#ifndef EN_SCAN
#define EN_SCAN 1
#endif
#ifndef EN_FIN
#define EN_FIN 1
#endif
#ifndef EN_ROW
#define EN_ROW 1
#endif
#ifndef REP_SCAN
#define REP_SCAN 1
#endif
__global__ void __launch_bounds__(512) mega(Params p) {
    extern __shared__ __attribute__((aligned(16))) unsigned char smem[];
    cg::grid_group grid = cg::this_grid();
    LAS unsigned char* lds = (LAS unsigned char*)smem; LAS float* sm = (LAS float*)smem;
    for (int ph = p.ph_lo; ph < p.ph_hi; ++ph) {
        if (ph > p.ph_lo) grid.sync();
        unsigned char* ws = p.ws; asm volatile("" : "+s"(ws));
        bf16_t* WIN = (bf16_t*)(ws + WS_WIN); bf16_t* WOUT = (bf16_t*)(ws + WS_WOUT); bf16_t* WF1 = (bf16_t*)(ws + WS_WF1); bf16_t* WF2 = (bf16_t*)(ws + WS_WF2);
        bf16_t* Ub = (bf16_t*)(ws + WS_U); float* Gf = (float*)(ws + WS_G); bf16_t* ACT = (bf16_t*)(ws + WS_ACT);
        float* O1 = (float*)(ws + WS_U); bf16_t* HD = (bf16_t*)(ws + WS_U); float* O2 = (float*)(ws + WS_SC);
        if (ph == 0) {
            phase_convert(p, sm);
            row_pass(nullptr, nullptr, pin(p, 0), nullptr, pin(p, 1), ACT);
            continue;
        }
        const int l = (ph - 1) / 10, s = (ph - 1) % 10;
        pg8::StaticOrder S;
        if (s == 0) { pg8::Gemm g{ACT, WIN + (size_t)l * NIN * DM, T_TOK, NIN, DM}; S.init(g.M, g.N, gridDim.x, blockIdx.x); pg8::EpiU E{Ub, Gf}; pg8::gemm_phase(lds, g, S, E); }
        else if (s == 1) phase_prepass(p, l);
        else if (s == 2) { pg8::Gemm g{(const bf16_t*)(ws + WS_A2), (const bf16_t*)(ws + WS_BT2) + (size_t)l * 2048 * 384, T_TOK, 2048, 384}; S.init(g.M, g.N, gridDim.x, blockIdx.x);
            pg8::EpiPre E{ws, pin(p, 10) + (size_t)l * 1024, (const float*)(ws + WS_SPT) + (size_t)l * 512, pin(p, 19) + (size_t)l * 512, pin(p, 21) + (size_t)l * 512};
            pg8::gemm_phase(lds, g, S, E); }
        else if (s == 3) { for (int rep = 0; rep < REP_SCAN; ++rep) phase_scan(p, l, sm); }
        else if (s == 4) phase_finalize(p, l, sm);
        else if (s == 5 || s == 8) { pg8::Gemm g{s == 5 ? ACT : HD, s == 5 ? WOUT + (size_t)l * DM * DM : WF2 + (size_t)l * DM * DFF, T_TOK, DM, s == 5 ? DM : DFF}; S.init(g.M, g.N, gridDim.x, blockIdx.x); pg8::EpiF32 E{s == 5 ? O1 : O2, DM}; pg8::gemm_phase(lds, g, S, E); }
        else if (s == 6) row_pass(O1, pin(p, 2) + (size_t)l * DM, l == 0 ? pin(p, 0) : p.out, p.out, pin(p, 3) + (size_t)l * DM, ACT);
        else if (s == 7) { pg8::Gemm g{ACT, WF1 + (size_t)l * 2 * DFF * DM, T_TOK, 2 * DFF, DM}; S.init(g.M, g.N, gridDim.x, blockIdx.x); pg8::EpiSwi E{HD}; pg8::gemm_phase(lds, g, S, E); }
        else row_pass(O2, pin(p, 4) + (size_t)l * DM, p.out, p.out, l == 0 ? pin(p, 1) + DM : nullptr, ACT);
    }
}

extern "C" void kernel_launch(void* const* d_in, const int* in_sizes, int n_in, void* d_out, int out_size, void* d_ws, size_t ws_size, hipStream_t stream) {
    static int grid_blocks = 0;
    if (grid_blocks == 0) {
        if (n_in != 31 || ws_size < WS_END || out_size != T_TOK * DM) { fprintf(stderr, "kernel_launch: unexpected shapes (n_in %d, ws %zu need %zu, out %d)\n", n_in, ws_size, (size_t)WS_END, out_size); grid_blocks = -1; return; }
        int dev = 0, cus = 0, per_cu = 0;
        (void)hipGetDevice(&dev);
        (void)hipDeviceGetAttribute(&cus, hipDeviceAttributeMultiprocessorCount, dev);
        if (hipFuncSetAttribute((const void*)mega, hipFuncAttributeMaxDynamicSharedMemorySize, LDS_BYTES) != hipSuccess) { fprintf(stderr, "kernel_launch: hipFuncSetAttribute failed\n"); grid_blocks = -1; return; }
        if (hipOccupancyMaxActiveBlocksPerMultiprocessor(&per_cu, (const void*)mega, 512, LDS_BYTES) != hipSuccess || per_cu < 1) { fprintf(stderr, "kernel_launch: occupancy query says %d blocks per CU\n", per_cu); per_cu = 1; (void)hipGetLastError(); }
        grid_blocks = cus * 1;
        (void)per_cu;
    }
    if (grid_blocks < 0) return;
    Params p{};
    for (int i = 0; i < 31; ++i) p.in[i] = (const float*)d_in[i];
    p.out = (float*)d_out; p.ws = (unsigned char*)d_ws; p.ph_lo = 0; p.ph_hi = 21;
    void* args[] = {&p};
    hipError_t e = hipLaunchCooperativeKernel((const void*)mega, dim3(grid_blocks), dim3(512), args, LDS_BYTES, stream);
    if (e != hipSuccess) fprintf(stderr, "cooperative launch failed: %s (grid %d)\n", hipGetErrorString(e), grid_blocks);
}
```

```cpp
#include <hip/hip_runtime.h>
#include <hip/hip_cooperative_groups.h>
#include <cstdio>
namespace cg = cooperative_groups;

#define LAS __attribute__((address_space(3)))
typedef unsigned short bf16_t;
typedef short bf16x8 __attribute__((ext_vector_type(8)));
typedef float f32x4 __attribute__((ext_vector_type(4)));
typedef float f32x2 __attribute__((ext_vector_type(2)));
typedef unsigned u32x4 __attribute__((ext_vector_type(4)));
typedef unsigned u32x2 __attribute__((ext_vector_type(2)));

constexpr int T_TOK = 32768, SEQ = 4096, DM = 1024, NU = 3328, NGATE = 256, NIN = 3584, DFF = 2816, NSC = 2048;
constexpr int LDS_BYTES = 131072;
constexpr size_t WS_WIN = 0;
constexpr size_t WS_WOUT = WS_WIN + (size_t)2 * NIN * DM * 2;
constexpr size_t WS_WF1 = WS_WOUT + (size_t)2 * DM * DM * 2;
constexpr size_t WS_WF2 = WS_WF1 + (size_t)2 * 2 * DFF * DM * 2;
constexpr size_t WS_U = WS_WF2 + (size_t)2 * DM * DFF * 2;
constexpr size_t WS_G = WS_U + (size_t)T_TOK * NU * 2;
constexpr size_t WS_ACT = WS_G + (size_t)T_TOK * NGATE * 4;
constexpr size_t WS_SC = WS_ACT + (size_t)T_TOK * DM * 2;
constexpr size_t WS_A2 = WS_SC + (size_t)T_TOK * NSC * 2;
constexpr size_t WS_BT2 = WS_A2 + (size_t)T_TOK * 384 * 2;
constexpr size_t WS_SPT = WS_BT2 + (size_t)2 * 2048 * 384 * 2;
constexpr size_t WS_END = WS_SPT + 4096;

struct Params { const float* in[31]; float* out; unsigned char* ws; int ph_lo, ph_hi; };
__device__ __forceinline__ const float* pin(const Params& p, int i) { asm volatile("" : "+s"(i)); return p.in[i]; }

__device__ __forceinline__ int otid() { int t = threadIdx.x; asm volatile("" : "+v"(t)); return t; }
__device__ __forceinline__ int obid() { int t = blockIdx.x; asm volatile("" : "+s"(t)); return t; }
__device__ __forceinline__ float bf2f(unsigned short b) { return __uint_as_float(((unsigned)b) << 16); }
__device__ __forceinline__ unsigned short f2bf(float f) { unsigned u = __float_as_uint(f); u += 0x7FFFu + ((u >> 16) & 1u); return (unsigned short)(u >> 16); }
__device__ __forceinline__ unsigned pk2(float lo, float hi) { return (unsigned)f2bf(lo) | ((unsigned)f2bf(hi) << 16); }
__device__ __forceinline__ f32x4 ld4bf(const bf16_t* p) {
    const u32x2 v = *(const u32x2*)p; f32x4 r;
    r.x = __uint_as_float(v.x << 16); r.y = __uint_as_float(v.x & 0xffff0000u); r.z = __uint_as_float(v.y << 16); r.w = __uint_as_float(v.y & 0xffff0000u); return r;
}
__device__ __forceinline__ f32x4 bf4(u32x2 v) { f32x4 r; r.x = __uint_as_float(v.x << 16); r.y = __uint_as_float(v.x & 0xffff0000u); r.z = __uint_as_float(v.y << 16); r.w = __uint_as_float(v.y & 0xffff0000u); return r; }
__device__ __forceinline__ void st4bf(bf16_t* p, f32x4 v) { u32x2 o; o.x = pk2(v.x, v.y); o.y = pk2(v.z, v.w); *(u32x2*)p = o; }
__device__ __forceinline__ float sigmoidf_(float x) { return __builtin_amdgcn_rcpf(1.f + __expf(-x)); }
__device__ __forceinline__ float siluf_(float x) { return x * __builtin_amdgcn_rcpf(1.f + __expf(-x)); }
__device__ __forceinline__ float softplusf_(float x) { return fmaxf(x, 0.f) + log1pf(__expf(-fabsf(x))); }
__device__ __forceinline__ float gelu_tanh(float x) { const float u = 0.7978845608028654f * (x + 0.044715f * x * x * x); return 0.5f * x * (1.f + tanhf(u)); }
__device__ __forceinline__ float hsum4(f32x4 v) { return (v.x + v.z) + (v.y + v.w); }
template <int CTRL> __device__ __forceinline__ float dppf(float x) { return __int_as_float(__builtin_amdgcn_update_dpp(0, __float_as_int(x), CTRL, 0xF, 0xF, true)); }
__device__ __forceinline__ float red16(float v) { v += dppf<0xB1>(v); v += dppf<0x4E>(v); v += dppf<0x141>(v); v += dppf<0x140>(v); return v; }
__device__ __forceinline__ float red64(float v) { v = red16(v); v += __shfl_xor(v, 16); v += __shfl_xor(v, 32); return v; }
__device__ __forceinline__ float sum4l(float x) { x += dppf<0xB1>(x); x += dppf<0x4E>(x); return x; }
__device__ __forceinline__ unsigned cvt_pk_bf16(float lo, float hi) { unsigned r; asm volatile("v_cvt_pk_bf16_f32 %0, %1, %2" : "=v"(r) : "v"(lo), "v"(hi)); return r; }

namespace pg8 {
constexpr int BM = 256, BK = 64, HALF = 128, HTB = HALF * BK * 2, STAGE_BYTES = 8 * HTB, NXCD = 8, WGM = 8;
__device__ __forceinline__ int lds_byte(int r, int c) { const int st = (r >> 4) * 2 + (c >> 5), rr = r & 15, cc = c & 31, ob = rr * 64 + cc * 2; return st * 1024 + (ob ^ (((ob >> 9) & 1) << 5)); }
__device__ __forceinline__ void stage_rc(int b, int& R, int& C) { const int st = b / 1024, sb = b % 1024, swz = sb ^ (((sb >> 9) & 1) << 5); R = (st >> 1) * 16 + swz / 64; C = (st & 1) * 32 + (swz % 64) / 2; }
__device__ __forceinline__ int perm32(int rho) { const int n = rho >> 4, i = rho & 15; return 8 * (i >> 2) + 4 * n + (i & 3); }
struct Unit { int pm, pn; };
struct Gemm { const bf16_t* A; const bf16_t* Bt; int M, N, K; };
struct StaticOrder {
    int nM, nN, nwg, G, c;
    __device__ void init(int M, int N, int G_, int c_) { nM = M / BM; nN = N / BM; nwg = nM * nN; G = G_; c = c_; }
    __device__ bool next(int i, Unit& u) const {
        const long L = (long)i * G + c; if (L >= nwg) return false;
        int wgid = (int)L; { const int q = nwg / NXCD, r = nwg % NXCD, xcd = wgid % NXCD, off = wgid / NXCD; wgid = (xcd < r ? xcd * (q + 1) : r * (q + 1) + (xcd - r) * q) + off; }
        const int nig = WGM * nN, gid = wgid / nig, fm = gid * WGM, gsz = (nM - fm) < WGM ? (nM - fm) : WGM;
        u.pm = fm + ((wgid % nig) % gsz); u.pn = (wgid % nig) / gsz; return true;
    }
};
struct EpiF32 {
    static constexpr bool PERM = false;
    float* C; int ldc;
    __device__ __forceinline__ void operator()(const f32x4 (&acc)[2][2][4][2], const Unit& u, int wr, int wc, int fr, int fq) const {
        const int row0 = u.pm * BM + wr * 64 + fr, col0 = u.pn * BM + wc * 32 + 4 * fq;
#pragma unroll
        for (int ai = 0; ai < 2; ++ai)
#pragma unroll
            for (int m = 0; m < 4; ++m) { float* rowp = C + (size_t)(row0 + ai * HALF + m * 16) * ldc + col0;
#pragma unroll
                for (int bj = 0; bj < 2; ++bj)
#pragma unroll
                    for (int n = 0; n < 2; ++n) *(f32x4*)(rowp + bj * HALF + n * 16) = acc[ai][bj][m][n]; }
    }
};
struct EpiU {
    static constexpr bool PERM = true;
    bf16_t* U; float* G;
    __device__ __forceinline__ void operator()(const f32x4 (&acc)[2][2][4][2], const Unit& u, int wr, int wc, int fr, int fq) const {
        const int row0 = u.pm * BM + wr * 64 + fr;
        if (u.pn < 13) {
            const int col0 = u.pn * BM + wc * 32 + 8 * fq;
#pragma unroll
            for (int ai = 0; ai < 2; ++ai)
#pragma unroll
                for (int m = 0; m < 4; ++m) { bf16_t* rowp = U + (size_t)(row0 + ai * HALF + m * 16) * NU + col0;
#pragma unroll
                    for (int bj = 0; bj < 2; ++bj) { const f32x4 v0 = acc[ai][bj][m][0], v1 = acc[ai][bj][m][1];
                        u32x4 o; o.x = cvt_pk_bf16(v0[0], v0[1]); o.y = cvt_pk_bf16(v0[2], v0[3]); o.z = cvt_pk_bf16(v1[0], v1[1]); o.w = cvt_pk_bf16(v1[2], v1[3]);
                        *(u32x4*)(rowp + bj * HALF) = o; } }
        } else {
            const int col0 = wc * 32 + 8 * fq;
#pragma unroll
            for (int ai = 0; ai < 2; ++ai)
#pragma unroll
                for (int m = 0; m < 4; ++m) { float* rowp = G + (size_t)(row0 + ai * HALF + m * 16) * NGATE + col0;
#pragma unroll
                    for (int bj = 0; bj < 2; ++bj) { *(f32x4*)(rowp + bj * HALF) = acc[ai][bj][m][0]; *(f32x4*)(rowp + bj * HALF + 4) = acc[ai][bj][m][1]; } }
        }
    }
};
struct EpiSwi {
    static constexpr bool PERM = true;
    bf16_t* H;
    __device__ __forceinline__ void operator()(const f32x4 (&acc)[2][2][4][2], const Unit& u, int wr, int wc, int fr, int fq) const {
        const int row0 = u.pm * BM + wr * 64 + fr, col0 = u.pn * HALF + wc * 32 + 8 * fq;
#pragma unroll
        for (int ai = 0; ai < 2; ++ai)
#pragma unroll
            for (int m = 0; m < 4; ++m) { bf16_t* rowp = H + (size_t)(row0 + ai * HALF + m * 16) * DFF + col0;
                float r[8];
#pragma unroll
                for (int n = 0; n < 2; ++n)
#pragma unroll
                    for (int j = 0; j < 4; ++j) { const float g = acc[ai][0][m][n][j], up = acc[ai][1][m][n][j]; r[n * 4 + j] = g * up * __builtin_amdgcn_rcpf(1.f + __expf(-g)); }
                u32x4 o; o.x = cvt_pk_bf16(r[0], r[1]); o.y = cvt_pk_bf16(r[2], r[3]); o.z = cvt_pk_bf16(r[4], r[5]); o.w = cvt_pk_bf16(r[6], r[7]);
                *(u32x4*)rowp = o; }
    }
};

struct EpiPre {
    static constexpr bool PERM = true;
    unsigned char* ws; const float* gb; const float* lam; const float* w0; const float* a0;
    __device__ __forceinline__ void operator()(const f32x4 (&acc)[2][2][4][2], const Unit& u, int wr_, int wc_, int fr_, int fq_) const {
        const int t_ = otid(); const int wr = t_ >> 8, wc = (t_ >> 6) & 3, fr = t_ & 15, fq = (t_ >> 4) & 3;
        (void)wr_; (void)wc_; (void)fr_; (void)fq_;
        const unsigned row0 = u.pm * BM + wr * 64 + fr;
        if (u.pn < 4) {
            const int dir = u.pn >> 1;
#pragma unroll
            for (int n = 0; n < 2; ++n) { const unsigned c = (u.pn & 1) * 128 + wc * 32 + 8 * fq + 4 * n;
                const f32x4 sp = *(const f32x4*)(lam + dir * 256 + c); const f32x4 gr = *(const f32x4*)(gb + (dir * 2 + 0) * 256 + c), gi = *(const f32x4*)(gb + (dir * 2 + 1) * 256 + c);
#pragma unroll
                for (int ai = 0; ai < 2; ++ai)
#pragma unroll
                    for (int m = 0; m < 4; ++m) { const unsigned row = row0 + ai * HALF + m * 16;
                        const f32x4 xc = ld4bf((const bf16_t*)(ws + (unsigned)WS_A2 + (row * 384u + c) * 2u)); f32x4 la, bb;
#pragma unroll
                        for (int j = 0; j < 4; ++j) { const float rp = acc[ai][0][m][n][j] + gr[j], ip = acc[ai][1][m][n][j] + gi[j];
                            const float l_ = sp[j] * __builtin_amdgcn_rcpf(1.f + __expf(-rp)); const float a_ = __expf(l_);
                            la[j] = l_; bb[j] = __builtin_amdgcn_sqrtf(fmaxf(1.f - a_ * a_, 0.f)) * __builtin_amdgcn_rcpf(1.f + __expf(-ip)) * xc[j]; }
                        u32x2 o; o.x = cvt_pk_bf16(la[0], la[1]); o.y = cvt_pk_bf16(la[2], la[3]); *(u32x2*)(ws + (unsigned)WS_ACT + (row * (unsigned)DM + dir * 256u + c) * 2u) = o;
                        o.x = cvt_pk_bf16(bb[0], bb[1]); o.y = cvt_pk_bf16(bb[2], bb[3]); *(u32x2*)(ws + (unsigned)WS_SC + (row * (unsigned)NSC + dir * 256u + c) * 2u) = o; } }
        } else {
            const int q = u.pn - 4, kind = q >> 1, d = q & 1;
            const float* cst = (kind ? a0 : w0) + d * 256; const float mul = kind ? 1.f : -0.6065306597126334f;
            const unsigned dbase = kind ? (unsigned)WS_ACT + (512u + d * 256u) * 2u : (d ? (unsigned)WS_G + 64u * 2u : (unsigned)WS_U);
            const unsigned dstride = kind ? (unsigned)DM * 2u : (d ? 512u * 2u : (unsigned)NU * 2u);
#pragma unroll
            for (int bj = 0; bj < 2; ++bj)
#pragma unroll
                for (int n = 0; n < 2; ++n) { const unsigned c = bj * HALF + wc * 32 + 8 * fq + 4 * n; const f32x4 cv = *(const f32x4*)(cst + c);
#pragma unroll
                    for (int ai = 0; ai < 2; ++ai)
#pragma unroll
                        for (int m = 0; m < 4; ++m) { const unsigned row = row0 + ai * HALF + m * 16; f32x4 r;
#pragma unroll
                            for (int j = 0; j < 4; ++j) r[j] = mul * __builtin_amdgcn_rcpf(1.f + __expf(-(acc[ai][bj][m][n][j] + cv[j])));
                            u32x2 o; o.x = cvt_pk_bf16(r[0], r[1]); o.y = cvt_pk_bf16(r[2], r[3]);
                            *(u32x2*)(ws + dbase + row * dstride + c * 2u) = o; } }
        }
    }
};

template <class Epi>
__device__ __forceinline__ void gemm_phase(LAS unsigned char* lds, const Gemm g, const StaticOrder& S, const Epi& E) {
    const int tid = otid(), wid = __builtin_amdgcn_readfirstlane(tid >> 6), lane = tid & 63, wr = wid >> 2, wc = wid & 3, fr = lane & 15, fq = lane >> 4;
    const int K = g.K, nt = K / BK;
    unsigned voffA[2], voffB[2];
#pragma unroll
    for (int i = 0; i < 2; ++i) { int R, C; stage_rc(tid * 16 + i * 8192, R, C); const int Rb = Epi::PERM ? ((R & ~31) + perm32(R & 31)) : R;
        voffA[i] = (unsigned)(R * K + C) * 2u; voffB[i] = (unsigned)(Rb * K + C) * 2u; }
    const size_t kstep = (size_t)(BK * 2);
    const size_t hstep = (size_t)HALF * K * 2;
    const size_t tstep = 2 * hstep;
    const unsigned ldsw = (unsigned)wid * 1024u;
    const int aoff = lds_byte(wr * 64 + fr, fq * 8), boff = lds_byte(wc * 32 + fr, fq * 8);
#define PG8_SA(b, h) (((b) * 2 + (h)) * HTB)
#define PG8_SB(b, h) ((4 + (b) * 2 + (h)) * HTB)
#define PG8_STAGE(bufoff, gbase, voff) do { _Pragma("unroll") for (int _i = 0; _i < 2; ++_i) \
        __builtin_amdgcn_global_load_lds((const unsigned*)((const char*)(gbase) + (voff)[_i]), (LAS unsigned*)(lds + (bufoff) + ldsw + _i * 8192), 16, 0, 0); } while (0)
#define PG8_LDA(dst, b, h) do { _Pragma("unroll") for (int m = 0; m < 4; ++m) _Pragma("unroll") for (int k = 0; k < 2; ++k) dst[m][k] = *(const LAS bf16x8*)(lds + PG8_SA(b, h) + aoff + m * 2048 + k * 1024); } while (0)
#define PG8_LDB(dst, b, h) do { _Pragma("unroll") for (int n = 0; n < 2; ++n) _Pragma("unroll") for (int k = 0; k < 2; ++k) dst[n][k] = *(const LAS bf16x8*)(lds + PG8_SB(b, h) + boff + n * 2048 + k * 1024); } while (0)
#define PG8_MMA(ai, bj, At, Bt) do { __builtin_amdgcn_s_setprio(1); _Pragma("unroll") for (int m = 0; m < 4; ++m) _Pragma("unroll") for (int n = 0; n < 2; ++n) _Pragma("unroll") for (int k = 0; k < 2; ++k) \
        acc[ai][bj][m][n] = __builtin_amdgcn_mfma_f32_16x16x32_bf16(Bt[n][k], At[m][k], acc[ai][bj][m][n], 0, 0, 0); __builtin_amdgcn_s_setprio(0); } while (0)
#define PG8_WAIT_V(n) asm volatile("s_waitcnt vmcnt(" #n ")" ::: "memory")
#define PG8_WAIT_L(n) asm volatile("s_waitcnt lgkmcnt(" #n ")" ::: "memory")
#define PG8_BAR __builtin_amdgcn_s_barrier()
#define PG8_SCHED __builtin_amdgcn_sched_barrier(0)
    Unit cur, nxt; int ui = 0;
    if (!S.next(0, cur)) return;
    f32x4 acc[2][2][4][2];
#pragma unroll
    for (int a = 0; a < 2; ++a)
#pragma unroll
        for (int b = 0; b < 2; ++b)
#pragma unroll
            for (int m = 0; m < 4; ++m)
#pragma unroll
                for (int n = 0; n < 2; ++n) acc[a][b][m][n] = (f32x4){0.f, 0.f, 0.f, 0.f};
    bf16x8 At[4][2], B0[2][2], B1[2][2];
    const char* cA = (const char*)g.A + (size_t)cur.pm * tstep; const char* cB = (const char*)g.Bt + (size_t)cur.pn * tstep;
    PG8_STAGE(PG8_SB(0, 0), cB, voffB); PG8_STAGE(PG8_SA(0, 0), cA, voffA); PG8_STAGE(PG8_SB(0, 1), cB + hstep, voffB); PG8_STAGE(PG8_SA(0, 1), cA + hstep, voffA);
    if (wr == 1) PG8_BAR;
    PG8_WAIT_V(4); PG8_BAR;
    PG8_STAGE(PG8_SB(1, 0), cB + kstep, voffB); PG8_STAGE(PG8_SA(1, 0), cA + kstep, voffA); PG8_STAGE(PG8_SB(1, 1), cB + hstep + kstep, voffB);
    PG8_WAIT_V(6); PG8_BAR;
    for (;;) {
        const bool has_next = S.next(ui + 1, nxt);
        const char* nA = has_next ? (const char*)g.A + (size_t)nxt.pm * tstep : cA; const char* nB = has_next ? (const char*)g.Bt + (size_t)nxt.pn * tstep : cB;
        for (int t = 0; t < nt; t += 2) {
            const bool last = (t == nt - 2);
            const char* a1 = cA + (size_t)(t + 1) * kstep;
            const char* a2 = last ? nA : cA + (size_t)(t + 2) * kstep; const char* b2 = last ? nB : cB + (size_t)(t + 2) * kstep;
            const char* a3 = a2 + kstep; const char* b3 = b2 + kstep;
            PG8_LDB(B0, 0, 0); PG8_SCHED; PG8_LDA(At, 0, 0); PG8_STAGE(PG8_SA(1, 1), a1 + hstep, voffA);
            PG8_WAIT_L(8); PG8_BAR; PG8_WAIT_L(0); PG8_MMA(0, 0, At, B0); PG8_BAR; PG8_SCHED;
            PG8_LDB(B1, 0, 1); PG8_STAGE(PG8_SB(0, 0), b2, voffB);
            PG8_BAR; PG8_WAIT_L(0); PG8_MMA(0, 1, At, B1); PG8_BAR;
            PG8_LDA(At, 0, 1); PG8_STAGE(PG8_SA(0, 0), a2, voffA);
            PG8_BAR; PG8_WAIT_L(0); PG8_MMA(1, 0, At, B0); PG8_BAR; PG8_SCHED;
            PG8_STAGE(PG8_SB(0, 1), b2 + hstep, voffB);
            PG8_WAIT_V(6); PG8_BAR; PG8_MMA(1, 1, At, B1); PG8_BAR;
            PG8_LDB(B0, 1, 0); PG8_SCHED; PG8_LDA(At, 1, 0); PG8_STAGE(PG8_SA(0, 1), a2 + hstep, voffA);
            PG8_WAIT_L(8); PG8_BAR; PG8_WAIT_L(0); PG8_MMA(0, 0, At, B0); PG8_BAR; PG8_SCHED;
            PG8_LDB(B1, 1, 1); PG8_STAGE(PG8_SB(1, 0), b3, voffB);
            PG8_BAR; PG8_WAIT_L(0); PG8_MMA(0, 1, At, B1); PG8_BAR;
            PG8_LDA(At, 1, 1); PG8_STAGE(PG8_SA(1, 0), a3, voffA);
            PG8_BAR; PG8_WAIT_L(0); PG8_MMA(1, 0, At, B0); PG8_BAR; PG8_SCHED;
            PG8_STAGE(PG8_SB(1, 1), b3 + hstep, voffB);
            PG8_WAIT_V(6); PG8_BAR; PG8_MMA(1, 1, At, B1); PG8_BAR;
        }
        E(acc, cur, wr, wc, fr, fq);
        if (!has_next) break;
#pragma unroll
        for (int a = 0; a < 2; ++a)
#pragma unroll
            for (int b = 0; b < 2; ++b)
#pragma unroll
                for (int m = 0; m < 4; ++m)
#pragma unroll
                    for (int n = 0; n < 2; ++n) acc[a][b][m][n] = (f32x4){0.f, 0.f, 0.f, 0.f};
        cur = nxt; cA = nA; cB = nB; ++ui;
    }
    PG8_WAIT_V(0);
    if (wr == 0) PG8_BAR;
    PG8_BAR;
#undef PG8_SA
#undef PG8_SB
#undef PG8_STAGE
#undef PG8_LDA
#undef PG8_LDB
#undef PG8_MMA
#undef PG8_WAIT_V
#undef PG8_WAIT_L
#undef PG8_BAR
#undef PG8_SCHED
}
}

__device__ __forceinline__ int src_col(int kind, int n) {
    if (kind == 0) {
        if (n < 1536) return n;
        if (n < 2560) return n + 16;
        if (n < 3328) return n + 32;
        const int j = n - 3328;
        if (j < 16) return 1536 + j;
        if (j < 32) return 2576 + (j - 16);
        if (j < 224) return 3360 + (j - 32);
        return -1;
    }
    if (kind == 2) return ((n & 255) >> 7) * DFF + (n >> 8) * 128 + (n & 127);
    return n;
}
__device__ void phase_convert(const Params& p, LAS float* tile) {
    const int tid = otid();
    bf16_t* WIN = (bf16_t*)(p.ws + WS_WIN); bf16_t* WOUT = (bf16_t*)(p.ws + WS_WOUT); bf16_t* WF1 = (bf16_t*)(p.ws + WS_WF1); bf16_t* WF2 = (bf16_t*)(p.ws + WS_WF2);
    for (int it = blockIdx.x; it < 6528; it += gridDim.x) {
        const int l = it / 3264; int r = it % 3264; int kind, nt, kt, K, Nsrc; const float* W; bf16_t* dst;
        if (r < 896) { kind = 0; nt = r / 16; kt = r % 16; K = 1024; Nsrc = 3552; W = pin(p, 5) + (size_t)l * 1024 * 3552; dst = WIN + (size_t)l * NIN * 1024; }
        else if (r < 1152) { r -= 896; kind = 1; nt = r / 16; kt = r % 16; K = 1024; Nsrc = 1024; W = pin(p, 6) + (size_t)l * 1024 * 1024; dst = WOUT + (size_t)l * 1024 * 1024; }
        else if (r < 2560) { r -= 1152; kind = 2; nt = r / 16; kt = r % 16; K = 1024; Nsrc = 5632; W = pin(p, 29) + (size_t)l * 1024 * 5632; dst = WF1 + (size_t)l * 5632 * 1024; }
        else { r -= 2560; kind = 3; nt = r / 44; kt = r % 44; K = 2816; Nsrc = 1024; W = pin(p, 30) + (size_t)l * 2816 * 1024; dst = WF2 + (size_t)l * 1024 * 2816; }
        for (int idx = tid; idx < 4096; idx += 512) {
            const int i = idx >> 6, j = idx & 63; const int sc = src_col(kind, nt * 64 + j);
            tile[i * 65 + j] = (sc >= 0) ? W[(size_t)(kt * 64 + i) * Nsrc + sc] : 0.f;
        }
        __syncthreads();
        for (int idx = tid; idx < 4096; idx += 512) {
            const int jn = idx >> 6, ik = idx & 63;
            dst[(size_t)(nt * 64 + jn) * K + kt * 64 + ik] = f2bf(tile[ik * 65 + jn]);
        }
        __syncthreads();
    }
    {
        bf16_t* BT2 = (bf16_t*)(p.ws + WS_BT2);
        for (int idx = blockIdx.x * 512 + tid; idx < 2 * 2048 * 384; idx += gridDim.x * 512) {
            const int l = idx / (2048 * 384), rem = idx % (2048 * 384), n = rem / 384, k = rem % 384, pn = n >> 8, cc = n & 255;
            float v = 0.f;
            if (pn < 4) { const int dir = pn >> 1, gate = cc >> 7, c = (pn & 1) * 128 + (cc & 127), nb = c >> 6, o = c & 63;
                if (k < 256 && (k >> 6) == nb) v = pin(p, 9)[((size_t)((((l * 2 + dir) * 2 + gate) * 4 + nb) * 64 + (k & 63))) * 64 + o]; }
            else { const int q = pn - 4, kind = q >> 1, d = q & 1, kb = 256 + kind * 64 + d * 32;
                if (k >= kb && k < kb + 32) v = (kind ? pin(p, 22) : pin(p, 20))[(size_t)((l * 2 + d) * 32 + (k - kb)) * 256 + cc]; }
            BT2[idx] = f2bf(v);
        }
        if (blockIdx.x == 0) for (int i = tid; i < 1024; i += 512) ((float*)(p.ws + WS_SPT))[i] = -8.f * softplusf_(-pin(p, 11)[i]);
    }
}
__device__ void row_pass(const float* O, const float* g1, const float* xres, float* xout, const float* g2, bf16_t* hb) {
    const int tid = otid(); const int lane = tid & 63, gw = blockIdx.x * 8 + (tid >> 6), nw = gridDim.x * 8;
    for (int row = gw; row < T_TOK; row += nw) {
        f32x4 v[4];
        if (O) {
            const f32x4* op = (const f32x4*)(O + (size_t)row * DM) + lane; const f32x4* xp = (const f32x4*)(xres + (size_t)row * DM) + lane;
            float ss = 0.f;
#pragma unroll
            for (int j = 0; j < 4; ++j) { v[j] = op[64 * j]; ss += hsum4(v[j] * v[j]); }
            const float inv = rsqrtf(red64(ss) * (1.f / DM) + 1e-6f);
#pragma unroll
            for (int j = 0; j < 4; ++j) { const f32x4 gg = *((const f32x4*)g1 + lane + 64 * j); v[j] = xp[64 * j] + v[j] * inv * gg; }
            f32x4* xo = (f32x4*)(xout + (size_t)row * DM) + lane;
#pragma unroll
            for (int j = 0; j < 4; ++j) xo[64 * j] = v[j];
        } else {
            const f32x4* xp = (const f32x4*)(xres + (size_t)row * DM) + lane;
#pragma unroll
            for (int j = 0; j < 4; ++j) v[j] = xp[64 * j];
        }
        if (g2) {
            float ss = 0.f;
#pragma unroll
            for (int j = 0; j < 4; ++j) ss += hsum4(v[j] * v[j]);
            const float inv = rsqrtf(red64(ss) * (1.f / DM) + 1e-6f);
            bf16_t* hp = hb + (size_t)row * DM;
#pragma unroll
            for (int j = 0; j < 4; ++j) { const f32x4 gg = *((const f32x4*)g2 + lane + 64 * j); st4bf(hp + 4 * (lane + 64 * j), v[j] * inv * gg); }
        }
    }
}

__device__ void phase_prepass(const Params& p, int l, cg::grid_group& grid) {
    const int tid = otid(); const int lane = tid & 63, gw = blockIdx.x * 8 + (tid >> 6);
    bf16_t* U = (bf16_t*)(p.ws + WS_U); float* G = (float*)(p.ws + WS_G); bf16_t* A2 = (bf16_t*)(p.ws + WS_A2);
    const int tok0 = gw * 16, t0 = tok0 & (SEQ - 1), c = 4 * lane;
    const u32x2 zz = (u32x2){0u, 0u};
    u32x2 rq[19], rk[19], rv[19];
#pragma unroll
    for (int i = 0; i < 19; ++i) { const int ts = t0 - 2 + i; const bool ok = (ts >= 0 && ts < SEQ) && gw < 2048;
        const bf16_t* up = U + (size_t)(ok ? tok0 - 2 + i : 0) * NU + 512 + c;
        rq[i] = ok ? *(const u32x2*)up : zz; rk[i] = ok ? *(const u32x2*)(up + 256) : zz; rv[i] = ok ? *(const u32x2*)(up + 512) : zz; }
    grid.sync();
    if (gw >= 2048) return;
    {
        const float* cw = pin(p, 12) + (size_t)l * 4 * 768 + c;
        f32x4 wq[4], wk[4], wv[4];
#pragma unroll
        for (int j = 0; j < 4; ++j) { wq[j] = *(const f32x4*)(cw + j * 768); wk[j] = *(const f32x4*)(cw + j * 768 + 256); wv[j] = *(const f32x4*)(cw + j * 768 + 512); }
#pragma unroll
        for (int i = 0; i < 16; ++i) {
            f32x4 aq = (f32x4){0.f, 0.f, 0.f, 0.f}, ak = aq, av = aq;
#pragma unroll
            for (int j = 0; j < 4; ++j) { aq += wq[j] * bf4(rq[i + j]); ak += wk[j] * bf4(rk[i + j]); av += wv[j] * bf4(rv[i + j]); }
#pragma unroll
            for (int e = 0; e < 4; ++e) { aq[e] = siluf_(aq[e]); ak[e] = siluf_(ak[e]); av[e] = siluf_(av[e]); }
            const float sq = red16(hsum4(aq * aq)), sk = red16(hsum4(ak * ak));
            aq = aq * (rsqrtf(sq + 1e-6f) * 0.125f); ak = ak * rsqrtf(sk + 1e-6f);
            bf16_t* up = U + (size_t)(tok0 + i) * NU + 512 + c;
            st4bf(up, aq); st4bf(up + 256, ak); st4bf(up + 512, av);
        }
    }
    {
        const int ti = lane >> 2, kind = lane & 3;
        float* gp = G + (size_t)(tok0 + ti) * NGATE + kind * 8;
        f32x4 v0 = *(const f32x4*)gp, v1 = *(const f32x4*)(gp + 4);
        float v[8] = {v0.x, v0.y, v0.z, v0.w, v1.x, v1.y, v1.z, v1.w};
#pragma unroll
        for (int e = 0; e < 8; ++e) {
            if (kind == 0) v[e] = __expf(-__expf(pin(p, 13)[l * 8 + e]) * softplusf_(v[e] + pin(p, 14)[l * 8 + e]));
            else if (kind == 1) v[e] = sigmoidf_(v[e]);
            else if (kind == 2) v[e] = __expf(15.f * tanhf((v[e] + pin(p, 16)[l * 16 + (e >> 2) * 8 + (e & 3)]) * (1.f / 15.f)));
            else v[e] = sigmoidf_(15.f * tanhf((v[e] + pin(p, 16)[l * 16 + (e >> 2) * 8 + 4 + (e & 3)]) * (1.f / 15.f)));
        }
        *(f32x4*)gp = (f32x4){v[0], v[1], v[2], v[3]}; *(f32x4*)(gp + 4) = (f32x4){v[4], v[5], v[6], v[7]};
    }
    {
        f32x4 cwv[4];
#pragma unroll
        for (int j = 0; j < 4; ++j) cwv[j] = *(const f32x4*)(pin(p, 7) + (size_t)l * 1024 + j * 256 + c);
        const f32x4 cb = *(const f32x4*)(pin(p, 8) + (size_t)l * 256 + c);
        const float* mu0 = pin(p, 18) + (size_t)l * 2 * 960; const float* mu1 = mu0 + 960;
        const int lc = (lane & 31) * 4;
        const f32x4 ml0 = *(const f32x4*)(mu0 + 768 + lc), ml1 = *(const f32x4*)(mu1 + 768 + lc);
        const f32x4 z4 = (f32x4){0.f, 0.f, 0.f, 0.f};
        for (int i = 0; i < 16; ++i) {
            const int tok = tok0 + i, t = t0 + i;
            f32x4 xc = cb;
#pragma unroll
            for (int j = 0; j < 4; ++j) { const int ts = t + j - 2; if (ts >= 0 && ts < SEQ) xc += cwv[j] * ld4bf(U + (size_t)(tok + j - 2) * NU + c); }
            st4bf(A2 + (size_t)tok * 384 + c, xc);
            if (lane < 32) {
                const float* gp = G + (size_t)tok * NGATE + 32 + lc;
                const f32x4 cur = *(const f32x4*)gp, pv = (t > 0) ? *(const f32x4*)(gp - NGATE) : z4, nx = (t < SEQ - 1) ? *(const f32x4*)(gp + NGATE) : z4;
                f32x4 lr = cur + ml0 * (pv - cur) + ml1 * (nx - cur);
                if (lane < 16) { lr.x = tanhf(lr.x); lr.y = tanhf(lr.y); lr.z = tanhf(lr.z); lr.w = tanhf(lr.w); }
                st4bf(A2 + (size_t)tok * 384 + 256 + lc, lr);
            }
        }
    }
}

constexpr int TT = 32, NTILE = SEQ / TT;
__device__ __forceinline__ float sum8l(float x) { x += dppf<0xB1>(x); x += dppf<0x4E>(x); x += dppf<0x141>(x); return x; }

__device__ void gdn_task(const Params& p, int l, int b, int h, int dir, LAS float* sm) {
    const int tid = otid(), wave = tid >> 6, lane = tid & 63;
    LAS float* Qs = sm; LAS float* Ks = sm + 2048; LAS float* Vs = sm + 4096; LAS float* Os = sm + 6144; LAS float* AB = sm + 8192;
    const bf16_t* U = (const bf16_t*)(p.ws + WS_U); const float* G = (const float*)(p.ws + WS_G); bf16_t* SC = (bf16_t*)(p.ws + WS_SC);
    const int pt = tid >> 4, c4 = (tid & 15) * 4;
    const int row = (wave & 3) * 16 + (lane >> 2), sub = lane & 3;
    f32x4 s4[4];
#pragma unroll
    for (int j = 0; j < 4; ++j) s4[j] = (f32x4){0.f, 0.f, 0.f, 0.f};
    u32x2 rq, rk, rv; float ga = 0.f, gb = 0.f;
#define GDN_LOADRAW(T0) do { const bf16_t* up = U + (size_t)(b * SEQ + (T0) + pt) * NU + 512 + h * 64 + c4; rq = *(const u32x2*)up; rk = *(const u32x2*)(up + 256); rv = *(const u32x2*)(up + 512); \
        if (tid < TT) { const float* gp = G + (size_t)(b * SEQ + (T0) + tid) * NGATE; ga = gp[dir * 4 + h]; gb = gp[8 + dir * 4 + h]; } } while (0)
    GDN_LOADRAW((dir ? NTILE - 1 : 0) * TT);
    for (int kt = 0; kt < NTILE; ++kt) {
        const int t0 = (dir ? NTILE - 1 - kt : kt) * TT;
        {
            *(LAS f32x4*)(Qs + pt * 64 + c4) = bf4(rq); *(LAS f32x4*)(Ks + pt * 64 + c4) = bf4(rk); *(LAS f32x4*)(Vs + pt * 64 + c4) = bf4(rv);
            if (tid < TT) { AB[tid * 2] = ga; AB[tid * 2 + 1] = gb; }
        }
        if (kt + 1 < NTILE) GDN_LOADRAW((dir ? NTILE - 2 - kt : kt + 1) * TT);
        __syncthreads();
        if (wave < 4) {
            f32x4 kA[4], qA[4], kB[4], qB[4]; float aA, bA, vA, aB, bB, vB;
#define GDN_LD(K_, Q_, A_, B_, V_, I_) do { const int _i = (I_) < TT ? (I_) : TT - 1; const int _tt = dir ? TT - 1 - _i : _i; const LAS float* kp = Ks + _tt * 64 + 4 * sub; const LAS float* qp = Qs + _tt * 64 + 4 * sub; \
        _Pragma("unroll") for (int j = 0; j < 4; ++j) { K_[j] = *(const LAS f32x4*)(kp + 16 * j); Q_[j] = *(const LAS f32x4*)(qp + 16 * j); } \
        A_ = AB[_tt * 2]; B_ = AB[_tt * 2 + 1]; V_ = Vs[_tt * 64 + row]; } while (0)
#define GDN_STEP(K_, Q_, A_, B_, V_, U_) do { f32x4 d4 = s4[0] * K_[0] + s4[1] * K_[1]; d4 += s4[2] * K_[2] + s4[3] * K_[3]; \
        const float d = sum4l(hsum4(d4)); const float c = B_ * (V_ - A_ * d); \
        _Pragma("unroll") for (int j = 0; j < 4; ++j) s4[j] = s4[j] * A_ + K_[j] * c; \
        f32x4 o4 = s4[0] * Q_[0] + s4[1] * Q_[1]; o4 += s4[2] * Q_[2] + s4[3] * Q_[3]; \
        const float o = sum4l(hsum4(o4)); okeep = (sub == (U_)) ? o : okeep; } while (0)
            GDN_LD(kA, qA, aA, bA, vA, 0);
            for (int gq = 0; gq < TT / 4; ++gq) {
                float okeep = 0.f; const int i0 = gq * 4;
                GDN_LD(kB, qB, aB, bB, vB, i0 + 1); __builtin_amdgcn_sched_barrier(0); GDN_STEP(kA, qA, aA, bA, vA, 0);
                GDN_LD(kA, qA, aA, bA, vA, i0 + 2); __builtin_amdgcn_sched_barrier(0); GDN_STEP(kB, qB, aB, bB, vB, 1);
                GDN_LD(kB, qB, aB, bB, vB, i0 + 3); __builtin_amdgcn_sched_barrier(0); GDN_STEP(kA, qA, aA, bA, vA, 2);
                GDN_LD(kA, qA, aA, bA, vA, i0 + 4); __builtin_amdgcn_sched_barrier(0); GDN_STEP(kB, qB, aB, bB, vB, 3);
                const int is = i0 + sub, tts = dir ? TT - 1 - is : is;
                Os[tts * 64 + row] = okeep;
            }
#undef GDN_LD
#undef GDN_STEP
        }
        __syncthreads();
        st4bf(SC + (size_t)(b * SEQ + t0 + pt) * NSC + 512 + dir * 256 + h * 64 + c4, *(const LAS f32x4*)(Os + pt * 64 + c4));
    }
#undef GDN_LOADRAW
    __syncthreads();
}

__device__ void mlstm_task(const Params& p, int l, int b, int h, int dir, LAS float* sm) {
    const int tid = otid(), wave = tid >> 6, lane = tid & 63;
    LAS float* Qs = sm; LAS float* Ks = sm + 2048; LAS float* Vs = sm + 4096; LAS float* Os = sm + 6144; LAS float* Dn = sm + 8192; LAS float* FI = sm + 10240;
    LAS float* LA = sm + 12288; LAS float* LB = sm + 14336; LAS float* LO = sm + 16384;
    const bf16_t* U = (const bf16_t*)(p.ws + WS_U); const float* G = (const float*)(p.ws + WS_G); bf16_t* SC = (bf16_t*)(p.ws + WS_SC); const bf16_t* ACT = (const bf16_t*)(p.ws + WS_ACT);
    const int pt = tid >> 4, c4 = (tid & 15) * 4;
    const int row = (wave & 3) * 16 + (lane >> 2), sub = lane & 3;
    const int ldir = dir, ln = h;
    const int lr8 = lane >> 3, lc8 = (lane & 7) * 8;
    f32x4 s4[4];
#pragma unroll
    for (int j = 0; j < 4; ++j) s4[j] = (f32x4){0.f, 0.f, 0.f, 0.f};
    float nst = 0.f, hst = 0.f;
    u32x2 rq, rk, rv; float gi = 0.f, gf = 0.f; u32x4 la4[4], lb4[4];
#define ML_LOADRAW(T0) do { const bf16_t* up = U + (size_t)(b * SEQ + (T0) + pt) * NU + 1536 + h * 64 + c4; rq = *(const u32x2*)up; rk = *(const u32x2*)(up + 256); rv = *(const u32x2*)(up + 512); \
        if (tid < TT) { const float* gp = G + (size_t)(b * SEQ + (T0) + tid) * NGATE + 16; gi = gp[dir * 4 + h]; gf = gp[8 + dir * 4 + h]; } \
        if (wave == 5) { _Pragma("unroll") for (int q = 0; q < 4; ++q) { const size_t tok = (size_t)(b * SEQ + (T0) + q * 8 + lr8); \
            la4[q] = *(const u32x4*)(ACT + tok * DM + ldir * 256 + ln * 64 + lc8); lb4[q] = *(const u32x4*)(SC + tok * NSC + ldir * 256 + ln * 64 + lc8); } } } while (0)
    ML_LOADRAW((dir ? NTILE - 1 : 0) * TT);
    for (int kt = 0; kt < NTILE; ++kt) {
        const int t0 = (dir ? NTILE - 1 - kt : kt) * TT;
        {
            *(LAS f32x4*)(Qs + pt * 64 + c4) = bf4(rq); *(LAS f32x4*)(Ks + pt * 64 + c4) = bf4(rk) * 0.125f; *(LAS f32x4*)(Vs + pt * 64 + c4) = bf4(rv);
            if (tid < TT) { FI[tid * 2] = gf; FI[tid * 2 + 1] = gi; }
            if (wave == 5) {
#pragma unroll
                for (int q = 0; q < 4; ++q) { const int o = (q * 8 + lr8) * 64 + lc8;
                    f32x4 a0 = bf4((u32x2){la4[q].x, la4[q].y}), a1 = bf4((u32x2){la4[q].z, la4[q].w});
#pragma unroll
                    for (int e = 0; e < 4; ++e) { a0[e] = __expf(a0[e]); a1[e] = __expf(a1[e]); }
                    *(LAS f32x4*)(LA + o) = a0; *(LAS f32x4*)(LA + o + 4) = a1;
                    *(LAS f32x4*)(LB + o) = bf4((u32x2){lb4[q].x, lb4[q].y}); *(LAS f32x4*)(LB + o + 4) = bf4((u32x2){lb4[q].z, lb4[q].w}); }
            }
        }
        if (kt + 1 < NTILE) ML_LOADRAW((dir ? NTILE - 2 - kt : kt + 1) * TT);
        __syncthreads();
        if (wave < 4) {
            f32x4 kA[4], qA[4], kB[4], qB[4]; float fA, vA, fB, vB;
#define ML_LD(K_, Q_, F_, V_, I_) do { const int _i = (I_) < TT ? (I_) : TT - 1; const int _tt = dir ? TT - 1 - _i : _i; const LAS float* kp = Ks + _tt * 64 + 4 * sub; const LAS float* qp = Qs + _tt * 64 + 4 * sub; \
        _Pragma("unroll") for (int j = 0; j < 4; ++j) { K_[j] = *(const LAS f32x4*)(kp + 16 * j); Q_[j] = *(const LAS f32x4*)(qp + 16 * j); } \
        F_ = FI[_tt * 2]; V_ = FI[_tt * 2 + 1] * Vs[_tt * 64 + row]; } while (0)
#define ML_STEP(K_, Q_, F_, V_, U_) do { _Pragma("unroll") for (int j = 0; j < 4; ++j) s4[j] = s4[j] * F_ + K_[j] * V_; \
        f32x4 o4 = s4[0] * Q_[0] + s4[1] * Q_[1]; o4 += s4[2] * Q_[2] + s4[3] * Q_[3]; \
        const float o = sum4l(hsum4(o4)); okeep = (sub == (U_)) ? o : okeep; } while (0)
            ML_LD(kA, qA, fA, vA, 0);
            for (int gq = 0; gq < TT / 4; ++gq) {
                float okeep = 0.f; const int i0 = gq * 4;
                ML_LD(kB, qB, fB, vB, i0 + 1); __builtin_amdgcn_sched_barrier(0); ML_STEP(kA, qA, fA, vA, 0);
                ML_LD(kA, qA, fA, vA, i0 + 2); __builtin_amdgcn_sched_barrier(0); ML_STEP(kB, qB, fB, vB, 1);
                ML_LD(kB, qB, fB, vB, i0 + 3); __builtin_amdgcn_sched_barrier(0); ML_STEP(kA, qA, fA, vA, 2);
                ML_LD(kA, qA, fA, vA, i0 + 4); __builtin_amdgcn_sched_barrier(0); ML_STEP(kB, qB, fB, vB, 3);
                const int is = i0 + sub, tts = dir ? TT - 1 - is : is;
                Os[tts * 64 + row] = okeep;
            }
#undef ML_LD
#undef ML_STEP
        } else if (wave == 4) {
#pragma unroll 8
            for (int i = 0; i < TT; ++i) { const int tt = dir ? TT - 1 - i : i;
                nst = nst * FI[tt * 2] + FI[tt * 2 + 1] * Ks[tt * 64 + lane];
                Dn[tt * 64 + lane] = nst * Qs[tt * 64 + lane]; }
        } else if (wave == 5) {
#pragma unroll 8
            for (int i = 0; i < TT; ++i) { const int tt = ldir ? TT - 1 - i : i; hst = LA[tt * 64 + lane] * hst + LB[tt * 64 + lane]; LO[tt * 64 + lane] = hst; }
        }
        __syncthreads();
        {
            const float den = red16(hsum4(*(const LAS f32x4*)(Dn + pt * 64 + c4)));
            const float sc = 1.f / fmaxf(fabsf(den), 1.f);
            st4bf(SC + (size_t)(b * SEQ + t0 + pt) * NSC + 1024 + dir * 256 + h * 64 + c4, *(const LAS f32x4*)(Os + pt * 64 + c4) * sc);
            if (wave == 5) {
#pragma unroll
                for (int q = 0; q < 4; ++q) { const int o = (q * 8 + lr8) * 64 + lc8; const f32x4 h0 = *(const LAS f32x4*)(LO + o), h1 = *(const LAS f32x4*)(LO + o + 4);
                    u32x4 w; w.x = pk2(h0.x, h0.y); w.y = pk2(h0.z, h0.w); w.z = pk2(h1.x, h1.y); w.w = pk2(h1.z, h1.w);
                    *(u32x4*)(SC + (size_t)(b * SEQ + t0 + q * 8 + lr8) * NSC + ldir * 256 + ln * 64 + lc8) = w; }
            }
        }
    }
#undef ML_LOADRAW
    __syncthreads();
}

__device__ void rwkv_task(const Params& p, int l, int b, int h, int dir, int half, LAS float* sm) {
    const int tid = otid(), wave = tid >> 6, lane = tid & 63;
    LAS float* Rs = sm; LAS float* Ws = sm + 2048; LAS float* KKs = sm + 4096; LAS float* KAs = sm + 6144; LAS float* KDs = sm + 8192; LAS float* Vs = sm + 10240; LAS float* Os = sm + 12288;
    const bf16_t* U = (const bf16_t*)(p.ws + WS_U); const bf16_t* Gb = (const bf16_t*)(p.ws + WS_G); bf16_t* SC = (bf16_t*)(p.ws + WS_SC); const bf16_t* ACT = (const bf16_t*)(p.ws + WS_ACT);
    const int pt = tid >> 4, c4 = (tid & 15) * 4, hc = h * 64 + c4;
    const float* mu0 = pin(p, 18) + (size_t)l * 2 * 960; const float* mu1 = mu0 + 960;
    const f32x4 mr0 = *(const f32x4*)(mu0 + hc), mr1 = *(const f32x4*)(mu1 + hc), mk0 = *(const f32x4*)(mu0 + 256 + hc), mk1 = *(const f32x4*)(mu1 + 256 + hc),
                mv0 = *(const f32x4*)(mu0 + 512 + hc), mv1 = *(const f32x4*)(mu1 + 512 + hc);
    const f32x4 kkv = *(const f32x4*)(pin(p, 24) + (size_t)l * 256 + hc), kav = *(const f32x4*)(pin(p, 25) + (size_t)l * 256 + hc);
    const int row = half * 32 + (wave & 3) * 8 + (lane >> 3), sub = lane & 7;
    f32x4 s4[2];
    s4[0] = (f32x4){0.f, 0.f, 0.f, 0.f}; s4[1] = s4[0];
    const u32x2 zz = (u32x2){0u, 0u};
    u32x2 rc, rp, rn, kc, kp_, kn, vc, vp, vn, ew, aa;
#define RW_LOADRAW(T0) do { const int _t = (T0) + pt; const bool hp = _t > 0, hn = _t < SEQ - 1; const size_t tok = (size_t)(b * SEQ + _t); \
        const bf16_t* up = U + tok * NU + 2560 + hc; \
        rc = *(const u32x2*)up; rp = hp ? *(const u32x2*)(up - NU) : zz; rn = hn ? *(const u32x2*)(up + NU) : zz; \
        kc = *(const u32x2*)(up + 256); kp_ = hp ? *(const u32x2*)(up + 256 - NU) : zz; kn = hn ? *(const u32x2*)(up + 256 + NU) : zz; \
        vc = *(const u32x2*)(up + 512); vp = hp ? *(const u32x2*)(up + 512 - NU) : zz; vn = hn ? *(const u32x2*)(up + 512 + NU) : zz; \
        ew = dir ? *(const u32x2*)(Gb + tok * 512 + 64 + hc) : *(const u32x2*)(U + tok * NU + hc); \
        aa = *(const u32x2*)(ACT + tok * DM + 512 + dir * 256 + hc); } while (0)
    RW_LOADRAW((dir ? NTILE - 1 : 0) * TT);
    for (int kt = 0; kt < NTILE; ++kt) {
        const int t0 = (dir ? NTILE - 1 - kt : kt) * TT;
        {
            f32x4 c = bf4(rc); const f32x4 rr = c + mr0 * (bf4(rp) - c) + mr1 * (bf4(rn) - c);
            c = bf4(kc); const f32x4 kk = c + mk0 * (bf4(kp_) - c) + mk1 * (bf4(kn) - c);
            c = bf4(vc); const f32x4 vv = c + mv0 * (bf4(vp) - c) + mv1 * (bf4(vn) - c);
            f32x4 w = bf4(ew); const f32x4 a = bf4(aa);
#pragma unroll
            for (int e = 0; e < 4; ++e) w[e] = __expf(w[e]);
            f32x4 kn_ = kk * kkv; const float ss = red16(hsum4(kn_ * kn_)); kn_ = kn_ * rsqrtf(ss + 1e-6f);
            *(LAS f32x4*)(Rs + pt * 64 + c4) = rr; *(LAS f32x4*)(Ws + pt * 64 + c4) = w; *(LAS f32x4*)(KKs + pt * 64 + c4) = kn_;
            *(LAS f32x4*)(KAs + pt * 64 + c4) = kn_ * a; *(LAS f32x4*)(KDs + pt * 64 + c4) = kk * (1.f + (a - 1.f) * kav); *(LAS f32x4*)(Vs + pt * 64 + c4) = vv;
        }
        if (kt + 1 < NTILE) RW_LOADRAW((dir ? NTILE - 2 - kt : kt + 1) * TT);
        __syncthreads();
        if (wave < 4) {
            f32x4 wA[2], nA[2], aA[2], dA[2], rA[2], wB[2], nB[2], aB[2], dB[2], rB[2]; float vA, vB;
#define RW_LD(W_, N_, A_, D_, R_, V_, I_) do { const int _i = (I_) < TT ? (I_) : TT - 1; const int _tt = dir ? TT - 1 - _i : _i; const int o = _tt * 64 + 4 * sub; \
        _Pragma("unroll") for (int j = 0; j < 2; ++j) { W_[j] = *(const LAS f32x4*)(Ws + o + 32 * j); N_[j] = *(const LAS f32x4*)(KKs + o + 32 * j); A_[j] = *(const LAS f32x4*)(KAs + o + 32 * j); \
            D_[j] = *(const LAS f32x4*)(KDs + o + 32 * j); R_[j] = *(const LAS f32x4*)(Rs + o + 32 * j); } \
        V_ = Vs[_tt * 64 + row]; } while (0)
#define RW_STEP(W_, N_, A_, D_, R_, V_, U_) do { const f32x4 x4 = s4[0] * N_[0] + s4[1] * N_[1]; const float sa = -sum8l(hsum4(x4)); \
        _Pragma("unroll") for (int j = 0; j < 2; ++j) s4[j] = s4[j] * W_[j] + A_[j] * sa + D_[j] * V_; \
        const f32x4 o4 = s4[0] * R_[0] + s4[1] * R_[1]; const float o = sum8l(hsum4(o4)); okeep = (sub == (U_)) ? o : okeep; } while (0)
            RW_LD(wA, nA, aA, dA, rA, vA, 0);
            for (int gq = 0; gq < TT / 8; ++gq) {
                float okeep = 0.f; const int i0 = gq * 8;
                RW_LD(wB, nB, aB, dB, rB, vB, i0 + 1); __builtin_amdgcn_sched_barrier(0); RW_STEP(wA, nA, aA, dA, rA, vA, 0);
                RW_LD(wA, nA, aA, dA, rA, vA, i0 + 2); __builtin_amdgcn_sched_barrier(0); RW_STEP(wB, nB, aB, dB, rB, vB, 1);
                RW_LD(wB, nB, aB, dB, rB, vB, i0 + 3); __builtin_amdgcn_sched_barrier(0); RW_STEP(wA, nA, aA, dA, rA, vA, 2);
                RW_LD(wA, nA, aA, dA, rA, vA, i0 + 4); __builtin_amdgcn_sched_barrier(0); RW_STEP(wB, nB, aB, dB, rB, vB, 3);
                RW_LD(wB, nB, aB, dB, rB, vB, i0 + 5); __builtin_amdgcn_sched_barrier(0); RW_STEP(wA, nA, aA, dA, rA, vA, 4);
                RW_LD(wA, nA, aA, dA, rA, vA, i0 + 6); __builtin_amdgcn_sched_barrier(0); RW_STEP(wB, nB, aB, dB, rB, vB, 5);
                RW_LD(wB, nB, aB, dB, rB, vB, i0 + 7); __builtin_amdgcn_sched_barrier(0); RW_STEP(wA, nA, aA, dA, rA, vA, 6);
                RW_LD(wA, nA, aA, dA, rA, vA, i0 + 8); __builtin_amdgcn_sched_barrier(0); RW_STEP(wB, nB, aB, dB, rB, vB, 7);
                const int is = i0 + sub, tts = dir ? TT - 1 - is : is;
                Os[tts * 64 + row] = okeep;
            }
#undef RW_LD
#undef RW_STEP
        }
        __syncthreads();
        {
            const int t = tid >> 4, r2 = half * 32 + (tid & 15) * 2;
            *(unsigned*)(SC + (size_t)(b * SEQ + t0 + t) * NSC + 1536 + dir * 256 + h * 64 + r2) = pk2(Os[t * 64 + r2], Os[t * 64 + r2 + 1]);
        }
    }
#undef RW_LOADRAW
    __syncthreads();
}

__device__ void phase_scan(const Params& p, int l, LAS float* sm) {
    for (int task = blockIdx.x; task < 256; task += gridDim.x) {
        if (task < 128) { const int half = task & 1, rest = task >> 1; rwkv_task(p, l, rest & 7, rest >> 4, (rest >> 3) & 1, half, sm); }
        else if (task < 192) { const int rest = task - 128; gdn_task(p, l, rest & 7, rest >> 4, (rest >> 3) & 1, sm); }
        else { const int rest = task - 192; mlstm_task(p, l, rest & 7, rest >> 4, (rest >> 3) & 1, sm); }
    }
}

__device__ void phase_finalize(const Params& p, int l, LAS float* sm) {
    const int tid = otid(), lane = tid & 63;
    LAS float* GUP = sm;
    for (int i = tid; i < 16384; i += 512) GUP[i] = pin(p, 23)[(size_t)l * 16384 + i];
    __syncthreads();
    const bf16_t* U = (const bf16_t*)(p.ws + WS_U); const float* G = (const float*)(p.ws + WS_G); const bf16_t* SC = (const bf16_t*)(p.ws + WS_SC); bf16_t* Y = (bf16_t*)(p.ws + WS_ACT);
    const int c = lane * 4, hc = c & 63;
    const f32x4 gdn_g = *(const f32x4*)(pin(p, 15) + (size_t)l * 64 + hc), ml_g = *(const f32x4*)(pin(p, 17) + (size_t)l * 256 + c);
    const float* mu0 = pin(p, 18) + (size_t)l * 2 * 960; const float* mu1 = mu0 + 960;
    const f32x4 mr0 = *(const f32x4*)(mu0 + c), mr1 = *(const f32x4*)(mu1 + c), mk0 = *(const f32x4*)(mu0 + 256 + c), mk1 = *(const f32x4*)(mu1 + 256 + c),
                mv0 = *(const f32x4*)(mu0 + 512 + c), mv1 = *(const f32x4*)(mu1 + 512 + c);
    const float mg0 = mu0[896 + lane], mg1 = mu1[896 + lane];
    const f32x4 rk = *(const f32x4*)(pin(p, 26) + (size_t)l * 256 + c), gnw = *(const f32x4*)(pin(p, 27) + (size_t)l * 256 + c), gnb = *(const f32x4*)(pin(p, 28) + (size_t)l * 256 + c);
    const f32x4 z4 = (f32x4){0.f, 0.f, 0.f, 0.f};
    const int gw = blockIdx.x * 8 + (tid >> 6), nw = gridDim.x * 8;
    for (int tok = gw; tok < T_TOK; tok += nw) {
        const int t = tok & (SEQ - 1); const bool hp = t > 0, hn = t < SEQ - 1;
        const bf16_t* u = U + (size_t)tok * NU; const bf16_t* sc = SC + (size_t)tok * NSC; bf16_t* y = Y + (size_t)tok * DM;
        { const f32x4 hh = ld4bf(sc + c) + ld4bf(sc + 256 + c), yb = ld4bf(u + 256 + c); f32x4 o;
          for (int e = 0; e < 4; ++e) o[e] = hh[e] * gelu_tanh(yb[e]);
          st4bf(y + c, o); }
        { const f32x4 o = ld4bf(sc + 512 + c) + ld4bf(sc + 768 + c), z = ld4bf(u + 1280 + c);
          const float inv = rsqrtf(red16(hsum4(o * o)) * (1.f / 64.f) + 1e-6f); f32x4 r;
          for (int e = 0; e < 4; ++e) r[e] = o[e] * inv * gdn_g[e] * siluf_(z[e]);
          st4bf(y + 256 + c, r); }
        { const f32x4 o = ld4bf(sc + 1024 + c) + ld4bf(sc + 1280 + c), og = ld4bf(u + 2304 + c);
          const float inv = rsqrtf(red16(hsum4(o * o)) * (1.f / 64.f) + 1e-6f); f32x4 r;
          for (int e = 0; e < 4; ++e) r[e] = o[e] * inv * ml_g[e] * sigmoidf_(og[e]);
          st4bf(y + 512 + c, r); }
        {
            const f32x4 yy = ld4bf(sc + 1536 + c) + ld4bf(sc + 1792 + c);
            const float mean = red16(hsum4(yy)) * (1.f / 64.f); const f32x4 dv = yy - mean;
            const float var = red16(hsum4(dv * dv)) * (1.f / 64.f); const float inv = rsqrtf(var + 64e-5f);
            const bf16_t* up = u + 2560 + c;
            f32x4 rr, kk, vv;
            { const f32x4 cc = ld4bf(up), pv = hp ? ld4bf(up - NU) : z4, nx = hn ? ld4bf(up + NU) : z4; rr = cc + mr0 * (pv - cc) + mr1 * (nx - cc); }
            { const f32x4 cc = ld4bf(up + 256), pv = hp ? ld4bf(up + 256 - NU) : z4, nx = hn ? ld4bf(up + 256 + NU) : z4; kk = cc + mk0 * (pv - cc) + mk1 * (nx - cc); }
            { const f32x4 cc = ld4bf(up + 512), pv = hp ? ld4bf(up + 512 - NU) : z4, nx = hn ? ld4bf(up + 512 + NU) : z4; vv = cc + mv0 * (pv - cc) + mv1 * (nx - cc); }
            const float bsum = red16(hsum4(rr * kk * rk));
            const float* gp = G + (size_t)tok * NGATE + 160 + lane;
            const float gc = gp[0], gpv = hp ? gp[-NGATE] : 0.f, gnx = hn ? gp[NGATE] : 0.f;
            const float sg = sigmoidf_(gc + mg0 * (gpv - gc) + mg1 * (gnx - gc));
            f32x4 gate = z4;
#pragma unroll 16
            for (int r = 0; r < 64; ++r) gate += *(const LAS f32x4*)(GUP + r * 256 + c) * __shfl(sg, r);
            f32x4 o;
            for (int e = 0; e < 4; ++e) o[e] = (dv[e] * inv * gnw[e] + gnb[e] + bsum * vv[e]) * gate[e];
            st4bf(y + 768 + c, o);
        }
    }
    __syncthreads();
}

#ifndef EN_GEMM
#define EN_GEMM 1
#endif
#ifndef EN_SCAN
#define EN_SCAN 1
#endif
#ifndef EN_FIN
#define EN_FIN 1
#endif
#ifndef EN_ROW
#define EN_ROW 1
#endif
#ifndef REP_SCAN
#define REP_SCAN 1
#endif
#ifndef REP_GEMM
#define REP_GEMM 1
#endif
__global__ void __launch_bounds__(512) mega(Params p) {
    extern __shared__ __attribute__((aligned(16))) unsigned char smem[];
    cg::grid_group grid = cg::this_grid();
    LAS unsigned char* lds = (LAS unsigned char*)smem; LAS float* sm = (LAS float*)smem;
    int repc = 0, repg = 0;
    for (int ph = p.ph_lo; ph < p.ph_hi; ++ph) {
        if (ph > p.ph_lo) grid.sync();
        unsigned char* ws = p.ws; asm volatile("" : "+s"(ws));
        bf16_t* WIN = (bf16_t*)(ws + WS_WIN); bf16_t* WOUT = (bf16_t*)(ws + WS_WOUT); bf16_t* WF1 = (bf16_t*)(ws + WS_WF1); bf16_t* WF2 = (bf16_t*)(ws + WS_WF2);
        bf16_t* Ub = (bf16_t*)(ws + WS_U); float* Gf = (float*)(ws + WS_G); bf16_t* ACT = (bf16_t*)(ws + WS_ACT);
        float* O1 = (float*)(ws + WS_U); bf16_t* HD = (bf16_t*)(ws + WS_U); float* O2 = (float*)(ws + WS_SC);
        if (ph == 0) {
            phase_convert(p, sm);
            row_pass(nullptr, nullptr, pin(p, 0), nullptr, pin(p, 1), ACT);
            continue;
        }
        const int l = (ph - 1) / 10, s = (ph - 1) % 10;
        pg8::StaticOrder S;
        if (REP_GEMM > 1 && (s == 0 || s == 5 || s == 7 || s == 8)) { if (++repg < REP_GEMM) { --ph; } else repg = 0; }
        if (s == 0) { pg8::Gemm g{ACT, WIN + (size_t)l * NIN * DM, T_TOK, NIN, DM}; S.init(g.M, g.N, gridDim.x, blockIdx.x); pg8::EpiU E{Ub, Gf}; pg8::gemm_phase(lds, g, S, E); }
        else if (s == 1) phase_prepass(p, l, grid);
        else if (s == 2) { pg8::Gemm g{(const bf16_t*)(ws + WS_A2), (const bf16_t*)(ws + WS_BT2) + (size_t)l * 2048 * 384, T_TOK, 2048, 384}; S.init(g.M, g.N, gridDim.x, blockIdx.x);
            pg8::EpiPre E{ws, pin(p, 10) + (size_t)l * 1024, (const float*)(ws + WS_SPT) + (size_t)l * 512, pin(p, 19) + (size_t)l * 512, pin(p, 21) + (size_t)l * 512};
            pg8::gemm_phase(lds, g, S, E); }
        else if (s == 3) { phase_scan(p, l, sm); if (REP_SCAN > 1) { if (++repc < REP_SCAN) ph -= 2; else repc = 0; } }
        else if (s == 4) phase_finalize(p, l, sm);
        else if (s == 5 || s == 8) { pg8::Gemm g{s == 5 ? ACT : HD, s == 5 ? WOUT + (size_t)l * DM * DM : WF2 + (size_t)l * DM * DFF, T_TOK, DM, s == 5 ? DM : DFF}; S.init(g.M, g.N, gridDim.x, blockIdx.x); pg8::EpiF32 E{s == 5 ? O1 : O2, DM}; pg8::gemm_phase(lds, g, S, E); }
        else if (s == 6) row_pass(O1, pin(p, 2) + (size_t)l * DM, l == 0 ? pin(p, 0) : p.out, p.out, pin(p, 3) + (size_t)l * DM, ACT);
        else if (s == 7) { pg8::Gemm g{ACT, WF1 + (size_t)l * 2 * DFF * DM, T_TOK, 2 * DFF, DM}; S.init(g.M, g.N, gridDim.x, blockIdx.x); pg8::EpiSwi E{HD}; pg8::gemm_phase(lds, g, S, E); }
        else row_pass(O2, pin(p, 4) + (size_t)l * DM, p.out, p.out, l == 0 ? pin(p, 1) + DM : nullptr, ACT);
    }
}

extern "C" void kernel_launch(void* const* d_in, const int* in_sizes, int n_in, void* d_out, int out_size, void* d_ws, size_t ws_size, hipStream_t stream) {
    static int grid_blocks = 0;
    if (grid_blocks == 0) {
        if (n_in != 31 || ws_size < WS_END || out_size != T_TOK * DM) { fprintf(stderr, "kernel_launch: unexpected shapes (n_in %d, ws %zu need %zu, out %d)\n", n_in, ws_size, (size_t)WS_END, out_size); grid_blocks = -1; return; }
        int dev = 0, cus = 0, per_cu = 0;
        (void)hipGetDevice(&dev);
        (void)hipDeviceGetAttribute(&cus, hipDeviceAttributeMultiprocessorCount, dev);
        if (hipFuncSetAttribute((const void*)mega, hipFuncAttributeMaxDynamicSharedMemorySize, LDS_BYTES) != hipSuccess) { fprintf(stderr, "kernel_launch: hipFuncSetAttribute failed\n"); grid_blocks = -1; return; }
        if (hipOccupancyMaxActiveBlocksPerMultiprocessor(&per_cu, (const void*)mega, 512, LDS_BYTES) != hipSuccess || per_cu < 1) { fprintf(stderr, "kernel_launch: occupancy query says %d blocks per CU\n", per_cu); per_cu = 1; (void)hipGetLastError(); }
        grid_blocks = 256;
        (void)per_cu;
    }
    if (grid_blocks < 0) return;
    Params p{};
    for (int i = 0; i < 31; ++i) p.in[i] = (const float*)d_in[i];
    p.out = (float*)d_out; p.ws = (unsigned char*)d_ws; p.ph_lo = 0; p.ph_hi = 21;
    void* args[] = {&p};
    hipError_t e = hipLaunchCooperativeKernel((const void*)mega, dim3(grid_blocks), dim3(512), args, LDS_BYTES, stream);
    if (e != hipSuccess) fprintf(stderr, "cooperative launch failed: %s (grid %d)\n", hipGetErrorString(e), grid_blocks);
}
```

```cpp
#include <hip/hip_runtime.h>
#include <hip/hip_cooperative_groups.h>
#include <cstdio>
namespace cg = cooperative_groups;

#ifndef DBG_PROBE
#define DBG_PROBE 0
#endif
#define LAS __attribute__((address_space(3)))
typedef unsigned short bf16_t;
typedef short bf16x8 __attribute__((ext_vector_type(8)));
typedef float f32x4 __attribute__((ext_vector_type(4)));
typedef float f32x2 __attribute__((ext_vector_type(2)));
typedef unsigned u32x4 __attribute__((ext_vector_type(4)));
typedef unsigned u32x2 __attribute__((ext_vector_type(2)));

constexpr int T_TOK = 32768, SEQ = 4096, DM = 1024, NU = 3328, NGATE = 256, NIN = 3584, DFF = 2816, NSC = 2048;
constexpr int LDS_BYTES = 131072 + 16;
constexpr size_t WS_WIN = 0;
constexpr size_t WS_WOUT = WS_WIN + (size_t)2 * NIN * DM * 2;
constexpr size_t WS_WF1 = WS_WOUT + (size_t)2 * DM * DM * 2;
constexpr size_t WS_WF2 = WS_WF1 + (size_t)2 * 2 * DFF * DM * 2;
constexpr size_t WS_U = WS_WF2 + (size_t)2 * DM * DFF * 2;
constexpr size_t WS_G = WS_U + (size_t)T_TOK * NU * 2;
constexpr size_t WS_ACT = WS_G + (size_t)T_TOK * NGATE * 4;
constexpr size_t WS_SC = WS_ACT + (size_t)T_TOK * DM * 2;
constexpr size_t WS_A2 = WS_SC + (size_t)T_TOK * NSC * 2;
constexpr size_t WS_BT2 = WS_A2 + (size_t)T_TOK * 384 * 2;
constexpr size_t WS_SPT = WS_BT2 + (size_t)2 * 2048 * 384 * 2;
constexpr size_t WS_DBG = WS_SPT + 4096;
constexpr size_t WS_BAR = WS_DBG + 256;
constexpr int XCD_BAR_WORDS = 3456;
constexpr size_t WS_END = WS_BAR + (size_t)XCD_BAR_WORDS * 4;

struct Params { const float* in[31]; float* out; unsigned char* ws; int ph_lo, ph_hi; };
__device__ __forceinline__ const float* pin(const Params& p, int i) { asm volatile("" : "+s"(i)); return p.in[i]; }

__device__ __forceinline__ int otid(int wv) { unsigned z = 0u; asm volatile("" : "+s"(z)); int t = (wv << 6) | (int)__builtin_amdgcn_mbcnt_hi(~0u, __builtin_amdgcn_mbcnt_lo(~0u, z)); asm volatile("" : "+v"(t)); return t; }
__device__ __forceinline__ int obid() { int t = blockIdx.x; asm volatile("" : "+s"(t)); return t; }
__device__ __forceinline__ float bf2f(unsigned short b) { return __uint_as_float(((unsigned)b) << 16); }
__device__ __forceinline__ unsigned short f2bf(float f) { unsigned u = __float_as_uint(f); u += 0x7FFFu + ((u >> 16) & 1u); return (unsigned short)(u >> 16); }
__device__ __forceinline__ unsigned pk2(float lo, float hi) { return (unsigned)f2bf(lo) | ((unsigned)f2bf(hi) << 16); }
__device__ __forceinline__ f32x4 ld4bf(const bf16_t* p) {
    const u32x2 v = *(const u32x2*)p; f32x4 r;
    r.x = __uint_as_float(v.x << 16); r.y = __uint_as_float(v.x & 0xffff0000u); r.z = __uint_as_float(v.y << 16); r.w = __uint_as_float(v.y & 0xffff0000u); return r;
}
__device__ __forceinline__ f32x4 bf4(u32x2 v) { f32x4 r; r.x = __uint_as_float(v.x << 16); r.y = __uint_as_float(v.x & 0xffff0000u); r.z = __uint_as_float(v.y << 16); r.w = __uint_as_float(v.y & 0xffff0000u); return r; }
__device__ __forceinline__ void st4bf(bf16_t* p, f32x4 v) { u32x2 o; o.x = pk2(v.x, v.y); o.y = pk2(v.z, v.w); *(u32x2*)p = o; }
__device__ __forceinline__ float sigmoidf_(float x) { return __builtin_amdgcn_rcpf(1.f + __expf(-x)); }
__device__ __forceinline__ float siluf_(float x) { return x * __builtin_amdgcn_rcpf(1.f + __expf(-x)); }
__device__ __forceinline__ float softplusf_(float x) { return fmaxf(x, 0.f) + __logf(1.f + __expf(-fabsf(x))); }
__device__ __forceinline__ float tanhf_(float x) { return 1.f - 2.f * __builtin_amdgcn_rcpf(1.f + __expf(2.f * x)); }
__device__ __forceinline__ float gelu_tanh(float x) { const float u = 0.7978845608028654f * (x + 0.044715f * x * x * x); return 0.5f * x * (1.f + tanhf_(u)); }
__device__ __forceinline__ float hsum4(f32x4 v) { return (v.x + v.z) + (v.y + v.w); }
template <int CTRL> __device__ __forceinline__ float dppf(float x) { return __int_as_float(__builtin_amdgcn_update_dpp(0, __float_as_int(x), CTRL, 0xF, 0xF, true)); }
__device__ __forceinline__ float red16(float v) { v += dppf<0xB1>(v); v += dppf<0x4E>(v); v += dppf<0x141>(v); v += dppf<0x140>(v); return v; }
__device__ __forceinline__ float red64(float v) { v = red16(v); v += __shfl_xor(v, 16); v += __shfl_xor(v, 32); return v; }
__device__ __forceinline__ float sum4l(float x) { x += dppf<0xB1>(x); x += dppf<0x4E>(x); return x; }
__device__ __forceinline__ unsigned cvt_pk_bf16(float lo, float hi) { unsigned r; asm volatile("v_cvt_pk_bf16_f32 %0, %1, %2" : "=v"(r) : "v"(lo), "v"(hi)); return r; }

#define XB_TMO      128
#define XB_XCNT(j)  (256  + 64 * (j))
#define XB_XSUB(j)  (1280 + 64 * (j))
#define XB_XGEN(j)  (2304 + 64 * (j))
#define XB_TOP      3328
#define XB_TOPGEN   3392
#define XB_SPIN_CAP (1u << 22)
__device__ __forceinline__ unsigned xb_ld(unsigned* p)              { return __hip_atomic_load(p, __ATOMIC_RELAXED, __HIP_MEMORY_SCOPE_AGENT); }
__device__ __forceinline__ unsigned xb_add(unsigned* p, unsigned v) { return __hip_atomic_fetch_add(p, v, __ATOMIC_RELAXED, __HIP_MEMORY_SCOPE_AGENT); }
__device__ __forceinline__ unsigned xb_xcc_id() { return (unsigned)__builtin_amdgcn_s_getreg((3 << 11) | 20) & 0xFu; }
#define XB_SPIN(cond, bar) do { unsigned _sp = 0; while (cond) { __builtin_amdgcn_s_sleep(1); \
    if ((++_sp & 255u) == 0u) { if (xb_ld(&(bar)[XB_TMO])) break; if (_sp > XB_SPIN_CAP) { atomicAdd(&(bar)[XB_TMO], 1u); break; } } } } while (0)
struct XcdBarrier { unsigned* bar; unsigned x; volatile LAS unsigned* st; };
__device__ __forceinline__ XcdBarrier xcd_barrier_post(unsigned* bar, volatile LAS unsigned* st, int wv) {
    XcdBarrier b; b.bar = bar; b.x = xb_xcc_id(); b.st = st;
    if (otid(wv) == 0) (void)xb_add(&bar[XB_XCNT(b.x)], 1u);
    return b;
}
__device__ __forceinline__ void xcd_barrier_complete(unsigned* bar, unsigned x, unsigned& nloc, unsigned& nx) {
    const unsigned G = gridDim.x * gridDim.y * gridDim.z;
    unsigned sum, cnt, mine, sp = 0u;
    for (;;) {
        sum = 0u; cnt = 0u; mine = 0u;
#pragma unroll
        for (unsigned j = 0; j < 16; ++j) { const unsigned c = xb_ld(&bar[XB_XCNT(j)]); sum += c; cnt += (c > 0u) ? 1u : 0u; mine = (j == x) ? c : mine; }
        if (sum == G) break;
        __builtin_amdgcn_s_sleep(1);
        if ((++sp & 255u) == 0u) { if (xb_ld(&bar[XB_TMO])) break; if (sp > XB_SPIN_CAP) { atomicAdd(&bar[XB_TMO], 1u); break; } }
    }
    nloc = mine > 0u ? mine : 1u; nx = cnt > 0u ? cnt : 1u;
}
__device__ __forceinline__ void xcd_barrier(const XcdBarrier& b, int wv) {
    asm volatile("s_waitcnt vmcnt(0)" ::: "memory");
    __syncthreads();
    if (otid(wv) == 0) {
        unsigned* bar = b.bar;
        __builtin_amdgcn_s_waitcnt(0);
        unsigned nloc = b.st[0], nx = b.st[1];
        if (nloc == 0u) { xcd_barrier_complete(bar, b.x, nloc, nx); b.st[0] = nloc; b.st[1] = nx; }
        const unsigned old = xb_add(&bar[XB_XSUB(b.x)], 1u);
        const unsigned gen = old / nloc;
        if (old + 1u == (gen + 1u) * nloc) {
            __builtin_amdgcn_fence(__ATOMIC_RELEASE, "agent");
            asm volatile("s_waitcnt vmcnt(0)" ::: "memory");
            const unsigned og = xb_add(&bar[XB_TOP], 1u);
            const unsigned tg = og / nx;
            if (og + 1u == (tg + 1u) * nx) xb_add(&bar[XB_TOPGEN], 1u);
            else XB_SPIN(xb_ld(&bar[XB_TOPGEN]) == tg, bar);
            __builtin_amdgcn_fence(__ATOMIC_ACQUIRE, "agent");
            xb_add(&bar[XB_XGEN(b.x)], 1u);
            asm volatile("s_waitcnt vmcnt(0)" ::: "memory");
        } else {
            XB_SPIN(xb_ld(&bar[XB_XGEN(b.x)]) == gen, bar);
            __builtin_amdgcn_fence(__ATOMIC_ACQUIRE, "agent");
            asm volatile("s_waitcnt vmcnt(0)" ::: "memory");
        }
    }
    __syncthreads();
}

namespace pg8 {
constexpr int BM = 256, BK = 64, HALF = 128, HTB = HALF * BK * 2, STAGE_BYTES = 8 * HTB, NXCD = 8, WGM = 8;
__device__ __forceinline__ int lds_byte(int r, int c) { const int st = (r >> 4) * 2 + (c >> 5), rr = r & 15, cc = c & 31, ob = rr * 64 + cc * 2; return st * 1024 + (ob ^ (((ob >> 9) & 1) << 5)); }
__device__ __forceinline__ void stage_rc(int b, int& R, int& C) { const int st = b / 1024, sb = b % 1024, swz = sb ^ (((sb >> 9) & 1) << 5); R = (st >> 1) * 16 + swz / 64; C = (st & 1) * 32 + (swz % 64) / 2; }
__device__ __forceinline__ int perm32(int rho) { const int n = rho >> 4, i = rho & 15; return 8 * (i >> 2) + 4 * n + (i & 3); }
struct Unit { int pm, pn; };
struct Gemm { const bf16_t* A; const bf16_t* Bt; int M, N, K; };
struct StaticOrder {
    int nM, nN, nwg, G, c;
    __device__ void init(int M, int N, int G_, int c_) { nM = M / BM; nN = N / BM; nwg = nM * nN; G = G_; c = c_; }
    __device__ bool next(int i, Unit& u) const {
        const long L = (long)i * G + c; if (L >= nwg) return false;
        int wgid = (int)L; { const int q = nwg / NXCD, r = nwg % NXCD, xcd = wgid % NXCD, off = wgid / NXCD; wgid = (xcd < r ? xcd * (q + 1) : r * (q + 1) + (xcd - r) * q) + off; }
        const int nig = WGM * nN, gid = wgid / nig, fm = gid * WGM, gsz = (nM - fm) < WGM ? (nM - fm) : WGM;
        u.pm = fm + ((wgid % nig) % gsz); u.pn = (wgid % nig) / gsz; return true;
    }
};
struct EpiBf {
    static constexpr bool PERM = true;
    bf16_t* C; int ldc;
    __device__ __forceinline__ void operator()(const f32x4 (&acc)[2][2][4][2], const Unit& u, int wr, int wc, int fr, int fq) const {
        const int row0 = u.pm * BM + wr * 64 + fr, col0 = u.pn * BM + wc * 32 + 8 * fq;
#pragma unroll
        for (int ai = 0; ai < 2; ++ai)
#pragma unroll
            for (int m = 0; m < 4; ++m) { bf16_t* rowp = C + (size_t)(row0 + ai * HALF + m * 16) * ldc + col0;
#pragma unroll
                for (int bj = 0; bj < 2; ++bj) { const f32x4 v0 = acc[ai][bj][m][0], v1 = acc[ai][bj][m][1];
                    u32x4 o; o.x = cvt_pk_bf16(v0[0], v0[1]); o.y = cvt_pk_bf16(v0[2], v0[3]); o.z = cvt_pk_bf16(v1[0], v1[1]); o.w = cvt_pk_bf16(v1[2], v1[3]);
                    *(u32x4*)(rowp + bj * HALF) = o; } }
    }
};
struct EpiU {
    static constexpr bool PERM = true;
    bf16_t* U; float* G;
    __device__ __forceinline__ void operator()(const f32x4 (&acc)[2][2][4][2], const Unit& u, int wr, int wc, int fr, int fq) const {
        const int row0 = u.pm * BM + wr * 64 + fr;
        if (u.pn < 13) {
            const int col0 = u.pn * BM + wc * 32 + 8 * fq;
#pragma unroll
            for (int ai = 0; ai < 2; ++ai)
#pragma unroll
                for (int m = 0; m < 4; ++m) { bf16_t* rowp = U + (size_t)(row0 + ai * HALF + m * 16) * NU + col0;
#pragma unroll
                    for (int bj = 0; bj < 2; ++bj) { const f32x4 v0 = acc[ai][bj][m][0], v1 = acc[ai][bj][m][1];
                        u32x4 o; o.x = cvt_pk_bf16(v0[0], v0[1]); o.y = cvt_pk_bf16(v0[2], v0[3]); o.z = cvt_pk_bf16(v1[0], v1[1]); o.w = cvt_pk_bf16(v1[2], v1[3]);
                        *(u32x4*)(rowp + bj * HALF) = o; } }
        } else {
            const int col0 = wc * 32 + 8 * fq;
#pragma unroll
            for (int ai = 0; ai < 2; ++ai)
#pragma unroll
                for (int m = 0; m < 4; ++m) { float* rowp = G + (size_t)(row0 + ai * HALF + m * 16) * NGATE + col0;
#pragma unroll
                    for (int bj = 0; bj < 2; ++bj) { *(f32x4*)(rowp + bj * HALF) = acc[ai][bj][m][0]; *(f32x4*)(rowp + bj * HALF + 4) = acc[ai][bj][m][1]; } }
        }
    }
};
struct EpiSwi {
    static constexpr bool PERM = true;
    bf16_t* H;
    __device__ __forceinline__ void operator()(const f32x4 (&acc)[2][2][4][2], const Unit& u, int wr, int wc, int fr, int fq) const {
        const int row0 = u.pm * BM + wr * 64 + fr, col0 = u.pn * HALF + wc * 32 + 8 * fq;
#pragma unroll
        for (int ai = 0; ai < 2; ++ai)
#pragma unroll
            for (int m = 0; m < 4; ++m) { bf16_t* rowp = H + (size_t)(row0 + ai * HALF + m * 16) * DFF + col0;
                float r[8];
#pragma unroll
                for (int n = 0; n < 2; ++n)
#pragma unroll
                    for (int j = 0; j < 4; ++j) { const float g = acc[ai][0][m][n][j], up = acc[ai][1][m][n][j]; r[n * 4 + j] = g * up * __builtin_amdgcn_rcpf(1.f + __expf(-g)); }
                u32x4 o; o.x = cvt_pk_bf16(r[0], r[1]); o.y = cvt_pk_bf16(r[2], r[3]); o.z = cvt_pk_bf16(r[4], r[5]); o.w = cvt_pk_bf16(r[6], r[7]);
                *(u32x4*)rowp = o; }
    }
};

struct EpiPre {
    static constexpr bool PERM = true;
    unsigned char* ws; const float* gb; const float* lam; const float* w0; const float* a0; int wv;
    __device__ __forceinline__ void operator()(const f32x4 (&acc)[2][2][4][2], const Unit& u, int wr_, int wc_, int fr_, int fq_) const {
        const int t_ = otid(wv); const int wr = t_ >> 8, wc = (t_ >> 6) & 3, fr = t_ & 15, fq = (t_ >> 4) & 3;
        (void)wr_; (void)wc_; (void)fr_; (void)fq_;
        const unsigned row0 = u.pm * BM + wr * 64 + fr;
        if (u.pn < 4) {
            const int dir = u.pn >> 1;
#pragma unroll
            for (int n = 0; n < 2; ++n) { const unsigned c = (u.pn & 1) * 128 + wc * 32 + 8 * fq + 4 * n;
                const f32x4 sp = *(const f32x4*)(lam + dir * 256 + c); const f32x4 gr = *(const f32x4*)(gb + (dir * 2 + 0) * 256 + c), gi = *(const f32x4*)(gb + (dir * 2 + 1) * 256 + c);
#pragma unroll
                for (int ai = 0; ai < 2; ++ai)
#pragma unroll
                    for (int m = 0; m < 4; ++m) { const unsigned row = row0 + ai * HALF + m * 16;
                        const f32x4 xc = ld4bf((const bf16_t*)(ws + (unsigned)WS_A2 + (row * 384u + c) * 2u)); f32x4 la, bb;
#pragma unroll
                        for (int j = 0; j < 4; ++j) { const float rp = acc[ai][0][m][n][j] + gr[j], ip = acc[ai][1][m][n][j] + gi[j];
                            const float l_ = sp[j] * __builtin_amdgcn_rcpf(1.f + __expf(-rp)); const float a_ = __expf(l_);
                            la[j] = 1.f - a_;     bb[j] = __builtin_amdgcn_sqrtf(fmaxf(1.f - a_ * a_, 0.f)) * __builtin_amdgcn_rcpf(1.f + __expf(-ip)) * xc[j]; }
                        u32x2 o; o.x = cvt_pk_bf16(la[0], la[1]); o.y = cvt_pk_bf16(la[2], la[3]); *(u32x2*)(ws + (unsigned)WS_ACT + (row * (unsigned)DM + dir * 256u + c) * 2u) = o;
                        o.x = cvt_pk_bf16(bb[0], bb[1]); o.y = cvt_pk_bf16(bb[2], bb[3]); *(u32x2*)(ws + (unsigned)WS_SC + (row * (unsigned)NSC + dir * 256u + c) * 2u) = o; } }
        } else {
            const int q = u.pn - 4, kind = q >> 1, d = q & 1;
            const float* cst = (kind ? a0 : w0) + d * 256; const float mul = kind ? 1.f : -0.6065306597126334f;
            const unsigned dbase = kind ? (unsigned)WS_ACT + (512u + d * 256u) * 2u : (d ? (unsigned)WS_G + 64u * 2u : (unsigned)WS_U);
            const unsigned dstride = kind ? (unsigned)DM * 2u : (d ? 512u * 2u : (unsigned)NU * 2u);
#pragma unroll
            for (int bj = 0; bj < 2; ++bj)
#pragma unroll
                for (int n = 0; n < 2; ++n) { const unsigned c = bj * HALF + wc * 32 + 8 * fq + 4 * n; const f32x4 cv = *(const f32x4*)(cst + c);
#pragma unroll
                    for (int ai = 0; ai < 2; ++ai)
#pragma unroll
                        for (int m = 0; m < 4; ++m) { const unsigned row = row0 + ai * HALF + m * 16; f32x4 r;
#pragma unroll
                            for (int j = 0; j < 4; ++j) r[j] = mul * __builtin_amdgcn_rcpf(1.f + __expf(-(acc[ai][bj][m][n][j] + cv[j])));
                            u32x2 o; o.x = cvt_pk_bf16(r[0], r[1]); o.y = cvt_pk_bf16(r[2], r[3]);
                            *(u32x2*)(ws + dbase + row * dstride + c * 2u) = o; } }
        }
    }
};

template <class Epi, bool KSUB = false>
__device__ __forceinline__ void gemm_phase(LAS unsigned char* lds, const Gemm g, const StaticOrder& S, const Epi& E, int wv) {
    const int tid = otid(wv), wid = __builtin_amdgcn_readfirstlane(tid >> 6), lane = tid & 63, wr = wid >> 2, wc = wid & 3, fr = lane & 15, fq = lane >> 4;
    const int K = g.K, nt = KSUB ? 2 : K / BK;
#define PG8_KOFF(u) (KSUB ? (size_t)(((u).pn < 4 ? ((u).pn & 1) * 128 : 256) * 2) : (size_t)0)
    unsigned voffA[2], voffB[2];
#pragma unroll
    for (int i = 0; i < 2; ++i) { int R, C; stage_rc(tid * 16 + i * 8192, R, C); const int Rb = Epi::PERM ? ((R & ~31) + perm32(R & 31)) : R;
        voffA[i] = (unsigned)(R * K + C) * 2u; voffB[i] = (unsigned)(Rb * K + C) * 2u; }
    const size_t kstep = (size_t)(BK * 2);
    const size_t hstep = (size_t)HALF * K * 2;
    const size_t tstep = 2 * hstep;
    const unsigned ldsw = (unsigned)wid * 1024u;
    const int aoff = lds_byte(wr * 64 + fr, fq * 8), boff = lds_byte(wc * 32 + fr, fq * 8);
#define PG8_SA(b, h) (((b) * 2 + (h)) * HTB)
#define PG8_SB(b, h) ((4 + (b) * 2 + (h)) * HTB)
#define PG8_STAGE(bufoff, gbase, voff) do { _Pragma("unroll") for (int _i = 0; _i < 2; ++_i) \
        __builtin_amdgcn_global_load_lds((const unsigned*)((const char*)(gbase) + (voff)[_i]), (LAS unsigned*)(lds + (bufoff) + ldsw + _i * 8192), 16, 0, 0); } while (0)
#define PG8_LDA(dst, b, h) do { _Pragma("unroll") for (int m = 0; m < 4; ++m) _Pragma("unroll") for (int k = 0; k < 2; ++k) dst[m][k] = *(const LAS bf16x8*)(lds + PG8_SA(b, h) + aoff + m * 2048 + k * 1024); } while (0)
#define PG8_LDB(dst, b, h) do { _Pragma("unroll") for (int n = 0; n < 2; ++n) _Pragma("unroll") for (int k = 0; k < 2; ++k) dst[n][k] = *(const LAS bf16x8*)(lds + PG8_SB(b, h) + boff + n * 2048 + k * 1024); } while (0)
#define PG8_MMA(ai, bj, At, Bt) do { __builtin_amdgcn_s_setprio(1); _Pragma("unroll") for (int m = 0; m < 4; ++m) _Pragma("unroll") for (int n = 0; n < 2; ++n) _Pragma("unroll") for (int k = 0; k < 2; ++k) \
        acc[ai][bj][m][n] = __builtin_amdgcn_mfma_f32_16x16x32_bf16(Bt[n][k], At[m][k], acc[ai][bj][m][n], 0, 0, 0); __builtin_amdgcn_s_setprio(0); } while (0)
#define PG8_WAIT_V(n) asm volatile("s_waitcnt vmcnt(" #n ")" ::: "memory")
#define PG8_WAIT_L(n) asm volatile("s_waitcnt lgkmcnt(" #n ")" ::: "memory")
#define PG8_BAR __builtin_amdgcn_s_barrier()
#define PG8_SCHED __builtin_amdgcn_sched_barrier(0)
    Unit cur, nxt; int ui = 0;
    if (!S.next(0, cur)) return;
    f32x4 acc[2][2][4][2];
#pragma unroll
    for (int a = 0; a < 2; ++a)
#pragma unroll
        for (int b = 0; b < 2; ++b)
#pragma unroll
            for (int m = 0; m < 4; ++m)
#pragma unroll
                for (int n = 0; n < 2; ++n) acc[a][b][m][n] = (f32x4){0.f, 0.f, 0.f, 0.f};
    bf16x8 At[4][2], B0[2][2], B1[2][2];
    const char* cA = (const char*)g.A + (size_t)cur.pm * tstep + PG8_KOFF(cur); const char* cB = (const char*)g.Bt + (size_t)cur.pn * tstep + PG8_KOFF(cur);
    PG8_STAGE(PG8_SB(0, 0), cB, voffB); PG8_STAGE(PG8_SA(0, 0), cA, voffA); PG8_STAGE(PG8_SB(0, 1), cB + hstep, voffB); PG8_STAGE(PG8_SA(0, 1), cA + hstep, voffA);
    if (wr == 1) PG8_BAR;
    PG8_WAIT_V(4); PG8_BAR;
    PG8_STAGE(PG8_SB(1, 0), cB + kstep, voffB); PG8_STAGE(PG8_SA(1, 0), cA + kstep, voffA); PG8_STAGE(PG8_SB(1, 1), cB + hstep + kstep, voffB);
    PG8_WAIT_V(6); PG8_BAR;
    for (;;) {
        const bool has_next = S.next(ui + 1, nxt);
        const char* nA = has_next ? (const char*)g.A + (size_t)nxt.pm * tstep + PG8_KOFF(nxt) : cA; const char* nB = has_next ? (const char*)g.Bt + (size_t)nxt.pn * tstep + PG8_KOFF(nxt) : cB;
        for (int t = 0; t < nt; t += 2) {
            const bool last = (t == nt - 2);
            const char* a1 = cA + (size_t)(t + 1) * kstep;
            const char* a2 = last ? nA : cA + (size_t)(t + 2) * kstep; const char* b2 = last ? nB : cB + (size_t)(t + 2) * kstep;
            const char* a3 = a2 + kstep; const char* b3 = b2 + kstep;
            PG8_LDB(B0, 0, 0); PG8_SCHED; PG8_LDA(At, 0, 0); PG8_STAGE(PG8_SA(1, 1), a1 + hstep, voffA);
            PG8_WAIT_L(8); PG8_BAR; PG8_WAIT_L(0); PG8_MMA(0, 0, At, B0); PG8_BAR; PG8_SCHED;
            PG8_LDB(B1, 0, 1); PG8_STAGE(PG8_SB(0, 0), b2, voffB);
            PG8_BAR; PG8_WAIT_L(0); PG8_MMA(0, 1, At, B1); PG8_BAR;
            PG8_LDA(At, 0, 1); PG8_STAGE(PG8_SA(0, 0), a2, voffA);
            PG8_BAR; PG8_WAIT_L(0); PG8_MMA(1, 0, At, B0); PG8_BAR; PG8_SCHED;
            PG8_STAGE(PG8_SB(0, 1), b2 + hstep, voffB);
            PG8_WAIT_V(6); PG8_BAR; PG8_MMA(1, 1, At, B1); PG8_BAR;
            PG8_LDB(B0, 1, 0); PG8_SCHED; PG8_LDA(At, 1, 0); PG8_STAGE(PG8_SA(0, 1), a2 + hstep, voffA);
            PG8_WAIT_L(8); PG8_BAR; PG8_WAIT_L(0); PG8_MMA(0, 0, At, B0); PG8_BAR; PG8_SCHED;
            PG8_LDB(B1, 1, 1); PG8_STAGE(PG8_SB(1, 0), b3, voffB);
            PG8_BAR; PG8_WAIT_L(0); PG8_MMA(0, 1, At, B1); PG8_BAR;
            PG8_LDA(At, 1, 1); PG8_STAGE(PG8_SA(1, 0), a3, voffA);
            PG8_BAR; PG8_WAIT_L(0); PG8_MMA(1, 0, At, B0); PG8_BAR; PG8_SCHED;
            PG8_STAGE(PG8_SB(1, 1), b3 + hstep, voffB);
            PG8_WAIT_V(6); PG8_BAR; PG8_MMA(1, 1, At, B1); PG8_BAR;
        }
        E(acc, cur, wr, wc, fr, fq);
        if (!has_next) break;
#pragma unroll
        for (int a = 0; a < 2; ++a)
#pragma unroll
            for (int b = 0; b < 2; ++b)
#pragma unroll
                for (int m = 0; m < 4; ++m)
#pragma unroll
                    for (int n = 0; n < 2; ++n) acc[a][b][m][n] = (f32x4){0.f, 0.f, 0.f, 0.f};
        cur = nxt; cA = nA; cB = nB; ++ui;
    }
    PG8_WAIT_V(0);
    if (wr == 0) PG8_BAR;
    PG8_BAR;
#undef PG8_KOFF
#undef PG8_SA
#undef PG8_SB
#undef PG8_STAGE
#undef PG8_LDA
#undef PG8_LDB
#undef PG8_MMA
#undef PG8_WAIT_V
#undef PG8_WAIT_L
#undef PG8_BAR
#undef PG8_SCHED
}
}

__device__ __forceinline__ int src_col(int kind, int n) {
    if (kind == 0) {
        if (n < 1536) return n;
        if (n < 2560) return n + 16;
        if (n < 3328) return n + 32;
        const int j = n - 3328;
        if (j < 16) return 1536 + j;
        if (j < 32) return 2576 + (j - 16);
        if (j < 224) return 3360 + (j - 32);
        return -1;
    }
    if (kind == 2) return ((n & 255) >> 7) * DFF + (n >> 8) * 128 + (n & 127);
    return n;
}
__device__ __forceinline__ void phase_convert(const Params& p, LAS float* tile, int wv) {
    const int tid = otid(wv);
    bf16_t* WIN = (bf16_t*)(p.ws + WS_WIN); bf16_t* WOUT = (bf16_t*)(p.ws + WS_WOUT); bf16_t* WF1 = (bf16_t*)(p.ws + WS_WF1); bf16_t* WF2 = (bf16_t*)(p.ws + WS_WF2);
    {
        const int lane = tid & 63, wave = tid >> 6;
        LAS float* scr = tile + wave * (64 * 33);
        for (int it = blockIdx.x * 8 + wave; it < 13056; it += gridDim.x * 8) {
            const int l = it / 6528; int r = it % 6528; int kind, nb, kb, K, Nsrc; const float* W; bf16_t* dst;
            if (r < 1792) { kind = 0; nb = r % 112; kb = r / 112; K = 1024; Nsrc = 3552; W = pin(p, 5) + (size_t)l * 1024 * 3552; dst = WIN + (size_t)l * NIN * 1024; }
            else if (r < 2304) { r -= 1792; kind = 1; nb = r % 32; kb = r / 32; K = 1024; Nsrc = 1024; W = pin(p, 6) + (size_t)l * 1024 * 1024; dst = WOUT + (size_t)l * 1024 * 1024; }
            else if (r < 5120) { r -= 2304; kind = 2; nb = r % 176; kb = r / 176; K = 1024; Nsrc = 5632; W = pin(p, 29) + (size_t)l * 1024 * 5632; dst = WF1 + (size_t)l * 5632 * 1024; }
            else { r -= 5120; kind = 3; nb = r % 32; kb = r / 32; K = 2816; Nsrc = 1024; W = pin(p, 30) + (size_t)l * 2816 * 1024; dst = WF2 + (size_t)l * 1024 * 2816; }
            const int k0 = 64 * kb, n0 = 32 * nb; const int sc = src_col(kind, n0 + (lane & 31));
            float vals[32];
#pragma unroll
            for (int i = 0; i < 32; ++i) { const int kk = 2 * i + (lane >> 5); vals[i] = (sc >= 0) ? W[(size_t)(k0 + kk) * Nsrc + sc] : 0.f; }
#pragma unroll
            for (int i = 0; i < 32; ++i) { const int kk = 2 * i + (lane >> 5); scr[kk * 33 + (lane & 31)] = vals[i]; }
            const int c8 = lane & 7;
#pragma unroll
            for (int j = 0; j < 4; ++j) { const int n = (lane >> 3) + 8 * j; const LAS float* s = scr + (8 * c8) * 33 + n;
                u32x4 o; o.x = pk2(s[0 * 33], s[1 * 33]); o.y = pk2(s[2 * 33], s[3 * 33]); o.z = pk2(s[4 * 33], s[5 * 33]); o.w = pk2(s[6 * 33], s[7 * 33]);
                *(u32x4*)(dst + (size_t)(n0 + n) * K + k0 + 8 * c8) = o; }
        }
    }
    {
        bf16_t* BT2 = (bf16_t*)(p.ws + WS_BT2);
        for (int idx = blockIdx.x * 512 + tid; idx < 2 * 2048 * 384; idx += gridDim.x * 512) {
            const int l = idx / (2048 * 384), rem = idx % (2048 * 384), n = rem / 384, k = rem % 384, pn = n >> 8, cc = n & 255;
            float v = 0.f;
            if (pn < 4) { const int dir = pn >> 1, gate = cc >> 7, c = (pn & 1) * 128 + (cc & 127), nb = c >> 6, o = c & 63;
                if (k < 256 && (k >> 6) == nb) v = pin(p, 9)[((size_t)((((l * 2 + dir) * 2 + gate) * 4 + nb) * 64 + (k & 63))) * 64 + o]; }
            else { const int q = pn - 4, kind = q >> 1, d = q & 1, kb = 256 + kind * 64 + d * 32;
                if (k >= kb && k < kb + 32) v = (kind ? pin(p, 22) : pin(p, 20))[(size_t)((l * 2 + d) * 32 + (k - kb)) * 256 + cc]; }
            BT2[idx] = f2bf(v);
        }
        if (DBG_PROBE && blockIdx.x == 0 && tid < 32) ((unsigned*)(p.ws + WS_DBG))[tid] = 0u;
        if (blockIdx.x == 0) for (int i = tid; i < 1024; i += 512) ((float*)(p.ws + WS_SPT))[i] = -8.f * softplusf_(-pin(p, 11)[i]);
    }
}
__device__ __forceinline__ void row_pass(int wv, const bf16_t* O, const float* g1, const float* xres_f, const bf16_t* xres_b, float* xout_f, bf16_t* xout_b, const float* g2, bf16_t* hb) {
    const int tid = otid(wv); const int lane = tid & 63, gw = blockIdx.x * 8 + (tid >> 6), nw = gridDim.x * 8;
    f32x4 g1v[4], g2v[4];
#pragma unroll
    for (int j = 0; j < 4; ++j) { g1v[j] = g1 ? *((const f32x4*)g1 + lane + 64 * j) : (f32x4){0.f, 0.f, 0.f, 0.f}; g2v[j] = g2 ? *((const f32x4*)g2 + lane + 64 * j) : (f32x4){0.f, 0.f, 0.f, 0.f}; }
    u32x4 xf[4]; u32x2 xb[4], ob[4];
#define RP_LOAD(ROW) do { const int _r = (ROW) < T_TOK ? (ROW) : gw; \
        if (xres_f) { const u32x4* xp = (const u32x4*)(xres_f + (size_t)_r * DM) + lane; _Pragma("unroll") for (int j = 0; j < 4; ++j) xf[j] = xp[64 * j]; } \
        else { const bf16_t* xp = xres_b + (size_t)_r * DM + 4 * lane; _Pragma("unroll") for (int j = 0; j < 4; ++j) xb[j] = *(const u32x2*)(xp + 256 * j); } \
        if (O) { const bf16_t* op = O + (size_t)_r * DM + 4 * lane; _Pragma("unroll") for (int j = 0; j < 4; ++j) ob[j] = *(const u32x2*)(op + 256 * j); } } while (0)
    RP_LOAD(gw);
    for (int row = gw; row < T_TOK; row += nw) {
        f32x4 v[4], o[4];
#pragma unroll
        for (int j = 0; j < 4; ++j) { if (xres_f) { v[j].x = __uint_as_float(xf[j].x); v[j].y = __uint_as_float(xf[j].y); v[j].z = __uint_as_float(xf[j].z); v[j].w = __uint_as_float(xf[j].w); } else v[j] = bf4(xb[j]);
            if (O) o[j] = bf4(ob[j]); }
        RP_LOAD(row + nw);
        if (O) {
            float ss = 0.f;
#pragma unroll
            for (int j = 0; j < 4; ++j) ss += hsum4(o[j] * o[j]);
            const float inv = rsqrtf(red64(ss) * (1.f / DM) + 1e-6f);
#pragma unroll
            for (int j = 0; j < 4; ++j) v[j] = v[j] + o[j] * inv * g1v[j];
            if (xout_f) { f32x4* xo = (f32x4*)(xout_f + (size_t)row * DM) + lane;
#pragma unroll
                for (int j = 0; j < 4; ++j) xo[64 * j] = v[j]; }
            else { bf16_t* xo = xout_b + (size_t)row * DM + 4 * lane;
#pragma unroll
                for (int j = 0; j < 4; ++j) st4bf(xo + 256 * j, v[j]); }
        }
        if (g2) {
            float ss = 0.f;
#pragma unroll
            for (int j = 0; j < 4; ++j) ss += hsum4(v[j] * v[j]);
            const float inv = rsqrtf(red64(ss) * (1.f / DM) + 1e-6f);
            bf16_t* hp = hb + (size_t)row * DM;
#pragma unroll
            for (int j = 0; j < 4; ++j) st4bf(hp + 4 * (lane + 64 * j), v[j] * inv * g2v[j]);
        }
    }
#undef RP_LOAD
}

__device__ __forceinline__ void phase_prepass(const Params& p, int l, const XcdBarrier& xbar, int wv) {
    const int tid = otid(wv); const int lane = tid & 63, gw = blockIdx.x * 8 + (tid >> 6);
    bf16_t* U = (bf16_t*)(p.ws + WS_U); float* G = (float*)(p.ws + WS_G); bf16_t* A2 = (bf16_t*)(p.ws + WS_A2);
    const int tok0 = gw * 16, t0 = tok0 & (SEQ - 1), c = 4 * lane;
    const u32x2 zz = (u32x2){0u, 0u};
    u32x2 rq[19], rk[19], rv[19];
#pragma unroll
    for (int i = 0; i < 19; ++i) { const int ts = t0 - 2 + i; const bool ok = (ts >= 0 && ts < SEQ) && gw < 2048;
        const bf16_t* up = U + (size_t)(ok ? tok0 - 2 + i : 0) * NU + 512 + c;
        rq[i] = ok ? *(const u32x2*)up : zz; rk[i] = ok ? *(const u32x2*)(up + 256) : zz; rv[i] = ok ? *(const u32x2*)(up + 512) : zz; }
    xcd_barrier(xbar, wv);
    if (gw >= 2048) return;
    {
        const float* cw = pin(p, 12) + (size_t)l * 4 * 768 + c;
        f32x4 wq[4], wk[4], wv[4];
#pragma unroll
        for (int j = 0; j < 4; ++j) { wq[j] = *(const f32x4*)(cw + j * 768); wk[j] = *(const f32x4*)(cw + j * 768 + 256); wv[j] = *(const f32x4*)(cw + j * 768 + 512); }
#pragma unroll
        for (int i = 0; i < 16; ++i) {
            f32x4 aq = (f32x4){0.f, 0.f, 0.f, 0.f}, ak = aq, av = aq;
#pragma unroll
            for (int j = 0; j < 4; ++j) { aq += wq[j] * bf4(rq[i + j]); ak += wk[j] * bf4(rk[i + j]); av += wv[j] * bf4(rv[i + j]); }
#pragma unroll
            for (int e = 0; e < 4; ++e) { aq[e] = siluf_(aq[e]); ak[e] = siluf_(ak[e]); av[e] = siluf_(av[e]); }
            const float sq = red16(hsum4(aq * aq)), sk = red16(hsum4(ak * ak));
            aq = aq * (rsqrtf(sq + 1e-6f) * 0.125f); ak = ak * rsqrtf(sk + 1e-6f);
            bf16_t* up = U + (size_t)(tok0 + i) * NU + 512 + c;
            st4bf(up, aq); st4bf(up + 256, ak); st4bf(up + 512, av);
        }
    }
    __builtin_amdgcn_sched_barrier(0);
    {
        f32x4 cwv[4];
#pragma unroll
        for (int j = 0; j < 4; ++j) cwv[j] = *(const f32x4*)(pin(p, 7) + (size_t)l * 1024 + j * 256 + c);
        const f32x4 cb = *(const f32x4*)(pin(p, 8) + (size_t)l * 256 + c);
#pragma unroll
        for (int hh = 0; hh < 2; ++hh) {
            u32x2 rx[11];
#pragma unroll
            for (int i = 0; i < 11; ++i) { const int ts = t0 + hh * 8 - 2 + i; rx[i] = (ts >= 0 && ts < SEQ) ? *(const u32x2*)(U + (size_t)(tok0 + hh * 8 - 2 + i) * NU + c) : zz; }
#pragma unroll
            for (int i = 0; i < 8; ++i) { f32x4 xc = cb;
#pragma unroll
                for (int j = 0; j < 4; ++j) xc += cwv[j] * bf4(rx[i + j]);
                st4bf(A2 + (size_t)(tok0 + hh * 8 + i) * 384 + c, xc); }
        }
    }
    __builtin_amdgcn_sched_barrier(0);
    {
        const int ti = lane >> 2, kind = lane & 3;
        float* gp = G + (size_t)(tok0 + ti) * NGATE + kind * 8;
        f32x4 v0 = *(const f32x4*)gp, v1 = *(const f32x4*)(gp + 4);
        float v[8] = {v0.x, v0.y, v0.z, v0.w, v1.x, v1.y, v1.z, v1.w};
#pragma unroll
        for (int e = 0; e < 8; ++e) {
            if (kind == 0) v[e] = __expf(-__expf(pin(p, 13)[l * 8 + e]) * softplusf_(v[e] + pin(p, 14)[l * 8 + e]));
            else if (kind == 1) v[e] = sigmoidf_(v[e]);
            else if (kind == 2) v[e] = __expf(15.f * tanhf_((v[e] + pin(p, 16)[l * 16 + (e >> 2) * 8 + (e & 3)]) * (1.f / 15.f)));
            else v[e] = sigmoidf_(15.f * tanhf_((v[e] + pin(p, 16)[l * 16 + (e >> 2) * 8 + 4 + (e & 3)]) * (1.f / 15.f)));
        }
        *(f32x4*)gp = (f32x4){v[0], v[1], v[2], v[3]}; *(f32x4*)(gp + 4) = (f32x4){v[4], v[5], v[6], v[7]};
    }
    __builtin_amdgcn_sched_barrier(0);
    if (lane < 32) {
        const float* mu0 = pin(p, 18) + (size_t)l * 2 * 960; const float* mu1 = mu0 + 960;
        const int lc = lane * 4;
        const f32x4 ml0 = *(const f32x4*)(mu0 + 768 + lc), ml1 = *(const f32x4*)(mu1 + 768 + lc);
        const f32x4 z4 = (f32x4){0.f, 0.f, 0.f, 0.f};
#pragma unroll
        for (int hh = 0; hh < 2; ++hh) {
            f32x4 gr[10];
#pragma unroll
            for (int i = 0; i < 10; ++i) { const int ts = t0 + hh * 8 - 1 + i; gr[i] = (ts >= 0 && ts < SEQ) ? *(const f32x4*)(G + (size_t)(tok0 + hh * 8 - 1 + i) * NGATE + 32 + lc) : z4; }
#pragma unroll
            for (int i = 0; i < 8; ++i) { const f32x4 cur = gr[i + 1]; f32x4 lr = cur + ml0 * (gr[i] - cur) + ml1 * (gr[i + 2] - cur);
                if (lane < 16) { lr.x = tanhf_(lr.x); lr.y = tanhf_(lr.y); lr.z = tanhf_(lr.z); lr.w = tanhf_(lr.w); }
                st4bf(A2 + (size_t)(tok0 + hh * 8 + i) * 384 + 256 + lc, lr); }
        }
    }
}

constexpr int TT = 64, NTILE = SEQ / TT, PH = TT / 32, TS = TT * 64;
__device__ __forceinline__ float sum8l(float x) { x += dppf<0xB1>(x); x += dppf<0x4E>(x); x += dppf<0x141>(x); return x; }

template <int DIRC> __device__ __forceinline__ void gdn_task(const Params& p, int l, int b, int h, LAS float* sm, int wv) {
    constexpr int dir = DIRC;
    const int tid = otid(wv), wave = tid >> 6, lane = tid & 63;
    LAS float* Qs = sm; LAS float* Ks = sm + TS; LAS float* Vs = sm + 2 * TS; LAS float* Os = sm + 3 * TS; LAS float* AB = sm + 4 * TS;
    const bf16_t* U = (const bf16_t*)(p.ws + WS_U); const float* G = (const float*)(p.ws + WS_G); bf16_t* SC = (bf16_t*)(p.ws + WS_SC);
    const int pt = tid >> 4, c4 = (tid & 15) * 4;
    const int row = (wave & 3) * 16 + (lane >> 2), sub = lane & 3;
    f32x4 s4[4];
#pragma unroll
    for (int j = 0; j < 4; ++j) s4[j] = (f32x4){0.f, 0.f, 0.f, 0.f};
    u32x2 rq[PH], rk[PH], rv[PH]; float gbp[PH]; float ga = 0.f, gb = 0.f;
#define GDN_LOADRAW(T0) do { _Pragma("unroll") for (int hh = 0; hh < PH; ++hh) { const bf16_t* up = U + (size_t)(b * SEQ + (T0) + pt + 32 * hh) * NU + 512 + h * 64 + c4; \
            rq[hh] = *(const u32x2*)up; rk[hh] = *(const u32x2*)(up + 256); rv[hh] = *(const u32x2*)(up + 512); gbp[hh] = G[(size_t)(b * SEQ + (T0) + pt + 32 * hh) * NGATE + 8 + dir * 4 + h]; } \
        if (tid < TT) { const float* gp = G + (size_t)(b * SEQ + (T0) + tid) * NGATE; ga = gp[dir * 4 + h]; gb = gp[8 + dir * 4 + h]; } } while (0)
#define GDN_WRITEOUT(T0) do { _Pragma("unroll") for (int hh = 0; hh < PH; ++hh) \
        st4bf(SC + (size_t)(b * SEQ + (T0) + pt + 32 * hh) * NSC + 512 + dir * 256 + h * 64 + c4, *(const LAS f32x4*)(Os + (pt + 32 * hh) * 64 + c4)); } while (0)
    GDN_LOADRAW((dir ? NTILE - 1 : 0) * TT);
    int t0p = 0;
    for (int kt = 0; kt < NTILE; ++kt) {
        const int t0 = (dir ? NTILE - 1 - kt : kt) * TT;
#pragma unroll
        for (int hh = 0; hh < PH; ++hh) { const int o = (pt + 32 * hh) * 64 + c4; *(LAS f32x4*)(Qs + o) = bf4(rq[hh]); *(LAS f32x4*)(Ks + o) = bf4(rk[hh]); *(LAS f32x4*)(Vs + o) = bf4(rv[hh]) * gbp[hh]; }
        if (tid < TT) { AB[tid * 2] = ga; AB[tid * 2 + 1] = gb * ga; }
        if (kt > 0) GDN_WRITEOUT(t0p);
        if (kt + 1 < NTILE) GDN_LOADRAW((dir ? NTILE - 2 - kt : kt + 1) * TT);
        __syncthreads();
        if (wave < 4) {
            f32x4 kA[4], qA[4], kB[4], qB[4]; float aA, bA, vA, aB, bB, vB;
#define GDN_LD(K_, Q_, A_, B_, V_, I_) do { const int _i = (I_) < TT ? (I_) : TT - 1; const int _tt = dir ? TT - 1 - _i : _i; const LAS float* kp = Ks + _tt * 64 + 4 * sub; const LAS float* qp = Qs + _tt * 64 + 4 * sub; \
        _Pragma("unroll") for (int j = 0; j < 4; ++j) { K_[j] = *(const LAS f32x4*)(kp + 16 * j); Q_[j] = *(const LAS f32x4*)(qp + 16 * j); } \
        A_ = AB[_tt * 2]; B_ = AB[_tt * 2 + 1]; V_ = Vs[_tt * 64 + row]; } while (0)
#define GDN_STEP(K_, Q_, A_, B_, V_, U_) do { f32x4 d4 = s4[0] * K_[0]; d4 += s4[1] * K_[1]; d4 += s4[2] * K_[2]; d4 += s4[3] * K_[3]; \
        const float d = sum4l(hsum4(d4)); const float c = V_ - B_ * d; \
        _Pragma("unroll") for (int j = 0; j < 4; ++j) s4[j] = s4[j] * A_ + K_[j] * c; \
        f32x4 o4 = s4[0] * Q_[0]; o4 += s4[1] * Q_[1]; o4 += s4[2] * Q_[2]; o4 += s4[3] * Q_[3]; \
        const float o = sum4l(hsum4(o4)); okeep = (sub == (U_)) ? o : okeep; } while (0)
            GDN_LD(kA, qA, aA, bA, vA, 0);
            for (int gq = 0; gq < TT / 4; ++gq) {
                float okeep = 0.f; const int i0 = gq * 4;
                GDN_LD(kB, qB, aB, bB, vB, i0 + 1); GDN_STEP(kA, qA, aA, bA, vA, 0);
                GDN_LD(kA, qA, aA, bA, vA, i0 + 2); GDN_STEP(kB, qB, aB, bB, vB, 1);
                GDN_LD(kB, qB, aB, bB, vB, i0 + 3); GDN_STEP(kA, qA, aA, bA, vA, 2);
                GDN_LD(kA, qA, aA, bA, vA, i0 + 4); GDN_STEP(kB, qB, aB, bB, vB, 3);
                const int is = i0 + sub, tts = dir ? TT - 1 - is : is;
                Os[tts * 64 + row] = okeep;
            }
#undef GDN_LD
#undef GDN_STEP
        }
        __syncthreads();
        t0p = t0;
    }
    GDN_WRITEOUT(t0p);
#undef GDN_LOADRAW
#undef GDN_WRITEOUT
    __syncthreads();
}

template <int DIRC> __device__ __forceinline__ void mlstm_task(const Params& p, int l, int b, int h, LAS float* sm, int wv) {
    constexpr int dir = DIRC;
    const int tid = otid(wv), wave = tid >> 6, lane = tid & 63;
    LAS float* Qs = sm; LAS float* Ks = sm + TS; LAS float* Vs = sm + 2 * TS; LAS float* Os = sm + 3 * TS; LAS float* Dn = sm + 4 * TS; LAS float* LA = sm + 5 * TS; LAS float* LB = sm + 6 * TS; LAS float* FI = sm + 7 * TS;
    const bf16_t* U = (const bf16_t*)(p.ws + WS_U); const float* G = (const float*)(p.ws + WS_G); bf16_t* SC = (bf16_t*)(p.ws + WS_SC); const bf16_t* ACT = (const bf16_t*)(p.ws + WS_ACT);
    const int pt = tid >> 4, c4 = (tid & 15) * 4;
    const int row = (wave & 3) * 16 + (lane >> 2), sub = lane & 3;
    const int lr8 = lane >> 3, lc8 = (lane & 7) * 8;
    constexpr int NQ = TT / 8;
    f32x4 s4[4];
#pragma unroll
    for (int j = 0; j < 4; ++j) s4[j] = (f32x4){0.f, 0.f, 0.f, 0.f};
    float nst = 0.f, hst = 0.f;
    u32x2 rq[PH], rk[PH], rv[PH]; float gip[PH]; float gi = 0.f, gf = 0.f; u32x4 la4[NQ], lb4[NQ];
#define ML_LOADRAW(T0) do { _Pragma("unroll") for (int hh = 0; hh < PH; ++hh) { const bf16_t* up = U + (size_t)(b * SEQ + (T0) + pt + 32 * hh) * NU + 1536 + h * 64 + c4; \
            rq[hh] = *(const u32x2*)up; rk[hh] = *(const u32x2*)(up + 256); rv[hh] = *(const u32x2*)(up + 512); gip[hh] = G[(size_t)(b * SEQ + (T0) + pt + 32 * hh) * NGATE + 16 + dir * 4 + h]; } \
        if (tid < TT) { const float* gp = G + (size_t)(b * SEQ + (T0) + tid) * NGATE + 16; gi = gp[dir * 4 + h]; gf = gp[8 + dir * 4 + h]; } \
        if (wave == 5) { _Pragma("unroll") for (int q = 0; q < NQ; ++q) { const size_t tok = (size_t)(b * SEQ + (T0) + q * 8 + lr8); \
            la4[q] = *(const u32x4*)(ACT + tok * DM + dir * 256 + h * 64 + lc8); lb4[q] = *(const u32x4*)(SC + tok * NSC + dir * 256 + h * 64 + lc8); } } } while (0)
#define ML_WRITEOUT(T0) do { _Pragma("unroll") for (int hh = 0; hh < PH; ++hh) { const int o = (pt + 32 * hh) * 64 + c4; \
            const float den = red16(hsum4(*(const LAS f32x4*)(Dn + o))); const float sc = __builtin_amdgcn_rcpf(fmaxf(fabsf(den), 1.f)); \
            st4bf(SC + (size_t)(b * SEQ + (T0) + pt + 32 * hh) * NSC + 1024 + dir * 256 + h * 64 + c4, *(const LAS f32x4*)(Os + o) * sc); } \
        if (wave == 5) { _Pragma("unroll") for (int q = 0; q < NQ; ++q) { const int o = (q * 8 + lr8) * 64 + lc8; const f32x4 h0 = *(const LAS f32x4*)(LA + o), h1 = *(const LAS f32x4*)(LA + o + 4); \
            u32x4 w; w.x = pk2(h0.x, h0.y); w.y = pk2(h0.z, h0.w); w.z = pk2(h1.x, h1.y); w.w = pk2(h1.z, h1.w); \
            *(u32x4*)(SC + (size_t)(b * SEQ + (T0) + q * 8 + lr8) * NSC + dir * 256 + h * 64 + lc8) = w; } } } while (0)
    ML_LOADRAW((dir ? NTILE - 1 : 0) * TT);
    int t0p = 0;
    for (int kt = 0; kt < NTILE; ++kt) {
        const int t0 = (dir ? NTILE - 1 - kt : kt) * TT;
        if (kt > 0) ML_WRITEOUT(t0p);
#pragma unroll
        for (int hh = 0; hh < PH; ++hh) { const int o = (pt + 32 * hh) * 64 + c4; *(LAS f32x4*)(Qs + o) = bf4(rq[hh]); *(LAS f32x4*)(Ks + o) = bf4(rk[hh]) * 0.125f; *(LAS f32x4*)(Vs + o) = bf4(rv[hh]) * gip[hh]; }
        if (tid < TT) { FI[tid * 2] = gf; FI[tid * 2 + 1] = gi; }
        if (wave == 5) {
#pragma unroll
            for (int q = 0; q < NQ; ++q) { const int o = (q * 8 + lr8) * 64 + lc8;
                f32x4 a0 = bf4((u32x2){la4[q].x, la4[q].y}), a1 = bf4((u32x2){la4[q].z, la4[q].w});
#pragma unroll
                for (int e = 0; e < 4; ++e) { a0[e] = 1.f - a0[e]; a1[e] = 1.f - a1[e]; }
                *(LAS f32x4*)(LA + o) = a0; *(LAS f32x4*)(LA + o + 4) = a1;
                *(LAS f32x4*)(LB + o) = bf4((u32x2){lb4[q].x, lb4[q].y}); *(LAS f32x4*)(LB + o + 4) = bf4((u32x2){lb4[q].z, lb4[q].w}); }
        }
        if (kt + 1 < NTILE) ML_LOADRAW((dir ? NTILE - 2 - kt : kt + 1) * TT);
        __syncthreads();
        if (wave < 4) {
            f32x4 kA[4], qA[4], kB[4], qB[4]; float fA, vA, fB, vB;
#define ML_LD(K_, Q_, F_, V_, I_) do { const int _i = (I_) < TT ? (I_) : TT - 1; const int _tt = dir ? TT - 1 - _i : _i; const LAS float* kp = Ks + _tt * 64 + 4 * sub; const LAS float* qp = Qs + _tt * 64 + 4 * sub; \
        _Pragma("unroll") for (int j = 0; j < 4; ++j) { K_[j] = *(const LAS f32x4*)(kp + 16 * j); Q_[j] = *(const LAS f32x4*)(qp + 16 * j); } \
        F_ = FI[_tt * 2]; V_ = Vs[_tt * 64 + row]; } while (0)
#define ML_STEP(K_, Q_, F_, V_, U_) do { _Pragma("unroll") for (int j = 0; j < 4; ++j) s4[j] = s4[j] * F_ + K_[j] * V_; \
        f32x4 o4 = s4[0] * Q_[0]; o4 += s4[1] * Q_[1]; o4 += s4[2] * Q_[2]; o4 += s4[3] * Q_[3]; \
        const float o = sum4l(hsum4(o4)); okeep = (sub == (U_)) ? o : okeep; } while (0)
            ML_LD(kA, qA, fA, vA, 0);
            for (int gq = 0; gq < TT / 4; ++gq) {
                float okeep = 0.f; const int i0 = gq * 4;
                ML_LD(kB, qB, fB, vB, i0 + 1); ML_STEP(kA, qA, fA, vA, 0);
                ML_LD(kA, qA, fA, vA, i0 + 2); ML_STEP(kB, qB, fB, vB, 1);
                ML_LD(kB, qB, fB, vB, i0 + 3); ML_STEP(kA, qA, fA, vA, 2);
                ML_LD(kA, qA, fA, vA, i0 + 4); ML_STEP(kB, qB, fB, vB, 3);
                const int is = i0 + sub, tts = dir ? TT - 1 - is : is;
                Os[tts * 64 + row] = okeep;
            }
#undef ML_LD
#undef ML_STEP
        } else if (wave == 4) {
#pragma unroll 8
            for (int i = 0; i < TT; ++i) { const int tt = dir ? TT - 1 - i : i;
                nst = nst * FI[tt * 2] + FI[tt * 2 + 1] * Ks[tt * 64 + lane];
                Dn[tt * 64 + lane] = nst * Qs[tt * 64 + lane]; }
        } else if (wave == 5) {
#pragma unroll 8
            for (int i = 0; i < TT; ++i) { const int tt = dir ? TT - 1 - i : i; hst = LA[tt * 64 + lane] * hst + LB[tt * 64 + lane]; LA[tt * 64 + lane] = hst; }
        }
        __syncthreads();
        t0p = t0;
    }
    ML_WRITEOUT(t0p);
#undef ML_LOADRAW
#undef ML_WRITEOUT
    __syncthreads();
}

template <int DIRC> __device__ __forceinline__ void rwkv_task(const Params& p, int l, int b, int h, int half, LAS float* sm, int wv) {
    constexpr int dir = DIRC;
    const int tid = otid(wv), wave = tid >> 6, lane = tid & 63;
    LAS float* Rs = sm; LAS float* Ws = sm + TS; LAS float* KKs = sm + 2 * TS; LAS float* KAs = sm + 3 * TS; LAS float* KDs = sm + 4 * TS; LAS float* Vs = sm + 5 * TS; LAS float* Os = sm + 6 * TS;
    const bf16_t* U = (const bf16_t*)(p.ws + WS_U); const bf16_t* Gb = (const bf16_t*)(p.ws + WS_G); bf16_t* SC = (bf16_t*)(p.ws + WS_SC); const bf16_t* ACT = (const bf16_t*)(p.ws + WS_ACT);
    const int pt = tid >> 4, c4 = (tid & 15) * 4, hc = h * 64 + c4;
    const float* mu0 = pin(p, 18) + (size_t)l * 2 * 960; const float* mu1 = mu0 + 960;
    const f32x4 mr0 = *(const f32x4*)(mu0 + hc), mr1 = *(const f32x4*)(mu1 + hc), mk0 = *(const f32x4*)(mu0 + 256 + hc), mk1 = *(const f32x4*)(mu1 + 256 + hc),
                mv0 = *(const f32x4*)(mu0 + 512 + hc), mv1 = *(const f32x4*)(mu1 + 512 + hc);
    const f32x4 kkv = *(const f32x4*)(pin(p, 24) + (size_t)l * 256 + hc), kav = *(const f32x4*)(pin(p, 25) + (size_t)l * 256 + hc);
    const int row = half * 32 + (wave & 3) * 8 + (lane >> 3), sub = lane & 7;
    f32x4 s4[2];
    s4[0] = (f32x4){0.f, 0.f, 0.f, 0.f}; s4[1] = s4[0];
    const u32x2 zz = (u32x2){0u, 0u};
    u32x2 rc[PH], rp[PH], rn[PH], kc[PH], kp_[PH], kn[PH], vc[PH], vp[PH], vn[PH], ew[PH], aa[PH];
#define RW_LOADRAW(T0) do { _Pragma("unroll") for (int hh = 0; hh < PH; ++hh) { const int _t = (T0) + pt + 32 * hh; const bool hp = _t > 0, hn = _t < SEQ - 1; const size_t tok = (size_t)(b * SEQ + _t); \
        const bf16_t* up = U + tok * NU + 2560 + hc; \
        rc[hh] = *(const u32x2*)up; rp[hh] = hp ? *(const u32x2*)(up - NU) : zz; rn[hh] = hn ? *(const u32x2*)(up + NU) : zz; \
        kc[hh] = *(const u32x2*)(up + 256); kp_[hh] = hp ? *(const u32x2*)(up + 256 - NU) : zz; kn[hh] = hn ? *(const u32x2*)(up + 256 + NU) : zz; \
        vc[hh] = *(const u32x2*)(up + 512); vp[hh] = hp ? *(const u32x2*)(up + 512 - NU) : zz; vn[hh] = hn ? *(const u32x2*)(up + 512 + NU) : zz; \
        ew[hh] = dir ? *(const u32x2*)(Gb + tok * 512 + 64 + hc) : *(const u32x2*)(U + tok * NU + hc); \
        aa[hh] = *(const u32x2*)(ACT + tok * DM + 512 + dir * 256 + hc); } } while (0)
#define RW_WRITEOUT(T0) do { _Pragma("unroll") for (int hh = 0; hh < PH; ++hh) { const int t = pt + 32 * hh, r2 = half * 32 + (tid & 15) * 2; \
        *(unsigned*)(SC + (size_t)(b * SEQ + (T0) + t) * NSC + 1536 + dir * 256 + h * 64 + r2) = pk2(Os[t * 64 + r2], Os[t * 64 + r2 + 1]); } } while (0)
    RW_LOADRAW((dir ? NTILE - 1 : 0) * TT);
    int t0p = 0;
    for (int kt = 0; kt < NTILE; ++kt) {
        const int t0 = (dir ? NTILE - 1 - kt : kt) * TT;
#pragma unroll
        for (int hh = 0; hh < PH; ++hh) {
            f32x4 c = bf4(rc[hh]); const f32x4 rr = c + mr0 * (bf4(rp[hh]) - c) + mr1 * (bf4(rn[hh]) - c);
            c = bf4(kc[hh]); const f32x4 kk = c + mk0 * (bf4(kp_[hh]) - c) + mk1 * (bf4(kn[hh]) - c);
            c = bf4(vc[hh]); const f32x4 vv = c + mv0 * (bf4(vp[hh]) - c) + mv1 * (bf4(vn[hh]) - c);
            f32x4 w = bf4(ew[hh]); const f32x4 a = bf4(aa[hh]);
#pragma unroll
            for (int e = 0; e < 4; ++e) w[e] = __expf(w[e]);
            f32x4 kn_ = kk * kkv; const float ss = red16(hsum4(kn_ * kn_)); kn_ = kn_ * rsqrtf(ss + 1e-6f);
            const int o = (pt + 32 * hh) * 64 + c4;
            *(LAS f32x4*)(Rs + o) = rr; *(LAS f32x4*)(Ws + o) = w; *(LAS f32x4*)(KKs + o) = kn_;
            *(LAS f32x4*)(KAs + o) = kn_ * a; *(LAS f32x4*)(KDs + o) = kk * (1.f + (a - 1.f) * kav); *(LAS f32x4*)(Vs + o) = vv;
        }
        if (kt > 0) RW_WRITEOUT(t0p);
        if (kt + 1 < NTILE) RW_LOADRAW((dir ? NTILE - 2 - kt : kt + 1) * TT);
        __syncthreads();
        if (wave < 4) {
            f32x4 wA[2], nA[2], aA[2], dA[2], rA[2], wB[2], nB[2], aB[2], dB[2], rB[2]; float vA, vB;
#define RW_LD(W_, N_, A_, D_, R_, V_, I_) do { const int _i = (I_) < TT ? (I_) : TT - 1; const int _tt = dir ? TT - 1 - _i : _i; const int o = _tt * 64 + 4 * sub; \
        _Pragma("unroll") for (int j = 0; j < 2; ++j) { W_[j] = *(const LAS f32x4*)(Ws + o + 32 * j); N_[j] = *(const LAS f32x4*)(KKs + o + 32 * j); A_[j] = *(const LAS f32x4*)(KAs + o + 32 * j); \
            D_[j] = *(const LAS f32x4*)(KDs + o + 32 * j); R_[j] = *(const LAS f32x4*)(Rs + o + 32 * j); } \
        V_ = Vs[_tt * 64 + row]; } while (0)
#define RW_STEP(W_, N_, A_, D_, R_, V_, U_) do { f32x4 x4 = s4[0] * N_[0]; x4 += s4[1] * N_[1]; const float sa = -sum8l(hsum4(x4)); \
        _Pragma("unroll") for (int j = 0; j < 2; ++j) s4[j] = s4[j] * W_[j] + A_[j] * sa + D_[j] * V_; \
        f32x4 o4 = s4[0] * R_[0]; o4 += s4[1] * R_[1]; const float o = sum8l(hsum4(o4)); okeep = (sub == (U_)) ? o : okeep; } while (0)
            RW_LD(wA, nA, aA, dA, rA, vA, 0);
            for (int gq = 0; gq < TT / 8; ++gq) {
                float okeep = 0.f; const int i0 = gq * 8;
                RW_LD(wB, nB, aB, dB, rB, vB, i0 + 1); RW_STEP(wA, nA, aA, dA, rA, vA, 0);
                RW_LD(wA, nA, aA, dA, rA, vA, i0 + 2); RW_STEP(wB, nB, aB, dB, rB, vB, 1);
                RW_LD(wB, nB, aB, dB, rB, vB, i0 + 3); RW_STEP(wA, nA, aA, dA, rA, vA, 2);
                RW_LD(wA, nA, aA, dA, rA, vA, i0 + 4); RW_STEP(wB, nB, aB, dB, rB, vB, 3);
                RW_LD(wB, nB, aB, dB, rB, vB, i0 + 5); RW_STEP(wA, nA, aA, dA, rA, vA, 4);
                RW_LD(wA, nA, aA, dA, rA, vA, i0 + 6); RW_STEP(wB, nB, aB, dB, rB, vB, 5);
                RW_LD(wB, nB, aB, dB, rB, vB, i0 + 7); RW_STEP(wA, nA, aA, dA, rA, vA, 6);
                RW_LD(wA, nA, aA, dA, rA, vA, i0 + 8); RW_STEP(wB, nB, aB, dB, rB, vB, 7);
                const int is = i0 + sub, tts = dir ? TT - 1 - is : is;
                Os[tts * 64 + row] = okeep;
            }
#undef RW_LD
#undef RW_STEP
        }
        __syncthreads();
        t0p = t0;
    }
    RW_WRITEOUT(t0p);
#undef RW_LOADRAW
#undef RW_WRITEOUT
    __syncthreads();
}

__device__ __forceinline__ void phase_scan(const Params& p, int l, LAS float* sm, int wv) {
    for (int task = blockIdx.x; task < 256; task += gridDim.x) {
        if (DBG_PROBE && otid(wv) == 0) ((LAS unsigned*)sm)[32760] = (unsigned)__builtin_amdgcn_s_memrealtime();
        if (task < 128) { const int half = task & 1, rest = task >> 1; if ((rest >> 3) & 1) rwkv_task<1>(p, l, rest & 7, rest >> 4, half, sm, wv); else rwkv_task<0>(p, l, rest & 7, rest >> 4, half, sm, wv); }
        else if (task < 192) { const int rest = task - 128; if ((rest >> 3) & 1) gdn_task<1>(p, l, rest & 7, rest >> 4, sm, wv); else gdn_task<0>(p, l, rest & 7, rest >> 4, sm, wv); }
        else { const int rest = task - 192; if ((rest >> 3) & 1) mlstm_task<1>(p, l, rest & 7, rest >> 4, sm, wv); else mlstm_task<0>(p, l, rest & 7, rest >> 4, sm, wv); }
        if (DBG_PROBE && l == 0 && otid(wv) == 0) { const unsigned dt = (unsigned)__builtin_amdgcn_s_memrealtime() - ((LAS unsigned*)sm)[32760]; atomicMax((unsigned*)(p.ws + WS_DBG) + (task < 128 ? 1 : (task < 192 ? 2 : 3)), dt); }
    }
}

struct FinRaw { u32x2 s[8], yb, z, og, r[3], k[3], v[3]; float g[3]; };
__device__ __forceinline__ void fin_load(FinRaw& R, const bf16_t* U, const float* G, const bf16_t* SC, int tok, int c, int lane) {
    const int t = tok & (SEQ - 1); const bool hp = t > 0, hn = t < SEQ - 1; const u32x2 zz = (u32x2){0u, 0u};
    const bf16_t* u = U + (size_t)tok * NU; const bf16_t* sc = SC + (size_t)tok * NSC;
#pragma unroll
    for (int i = 0; i < 8; ++i) R.s[i] = *(const u32x2*)(sc + i * 256 + c);
    R.yb = *(const u32x2*)(u + 256 + c); R.z = *(const u32x2*)(u + 1280 + c); R.og = *(const u32x2*)(u + 2304 + c);
    const bf16_t* up = u + 2560 + c;
    R.r[0] = *(const u32x2*)up; R.r[1] = hp ? *(const u32x2*)(up - NU) : zz; R.r[2] = hn ? *(const u32x2*)(up + NU) : zz;
    R.k[0] = *(const u32x2*)(up + 256); R.k[1] = hp ? *(const u32x2*)(up + 256 - NU) : zz; R.k[2] = hn ? *(const u32x2*)(up + 256 + NU) : zz;
    R.v[0] = *(const u32x2*)(up + 512); R.v[1] = hp ? *(const u32x2*)(up + 512 - NU) : zz; R.v[2] = hn ? *(const u32x2*)(up + 512 + NU) : zz;
    const float* gp = G + (size_t)tok * NGATE + 160 + lane;
    R.g[0] = gp[0]; R.g[1] = hp ? gp[-NGATE] : 0.f; R.g[2] = hn ? gp[NGATE] : 0.f;
}
__device__ __forceinline__ void phase_finalize(const Params& p, int l, LAS float* sm, int wv) {
    const int tid = otid(wv), lane = tid & 63, wave = tid >> 6;
    LAS float* GUP = sm;
    LAS float* SG = sm + 16384 + wave * 128;
    for (int i = tid; i < 16384; i += 512) GUP[i] = pin(p, 23)[(size_t)l * 16384 + i];
    __syncthreads();
    const bf16_t* U = (const bf16_t*)(p.ws + WS_U); const float* G = (const float*)(p.ws + WS_G); const bf16_t* SC = (const bf16_t*)(p.ws + WS_SC); bf16_t* Y = (bf16_t*)(p.ws + WS_ACT);
    const int c = lane * 4, hc = c & 63;
    const f32x4 gdn_g = *(const f32x4*)(pin(p, 15) + (size_t)l * 64 + hc), ml_g = *(const f32x4*)(pin(p, 17) + (size_t)l * 256 + c);
    const float* mu0 = pin(p, 18) + (size_t)l * 2 * 960; const float* mu1 = mu0 + 960;
    const f32x4 mr0 = *(const f32x4*)(mu0 + c), mr1 = *(const f32x4*)(mu1 + c), mk0 = *(const f32x4*)(mu0 + 256 + c), mk1 = *(const f32x4*)(mu1 + 256 + c),
                mv0 = *(const f32x4*)(mu0 + 512 + c), mv1 = *(const f32x4*)(mu1 + 512 + c);
    const float mg0 = mu0[896 + lane], mg1 = mu1[896 + lane];
    const f32x4 rk = *(const f32x4*)(pin(p, 26) + (size_t)l * 256 + c), gnw = *(const f32x4*)(pin(p, 27) + (size_t)l * 256 + c), gnb = *(const f32x4*)(pin(p, 28) + (size_t)l * 256 + c);
    const f32x4 z4 = (f32x4){0.f, 0.f, 0.f, 0.f};
    const int gw = blockIdx.x * 8 + wave, nw = gridDim.x * 8;
    for (int tok0 = gw; tok0 < T_TOK; tok0 += 2 * nw) {
        FinRaw R[2];
        const int tok1 = tok0 + nw; const bool two = tok1 < T_TOK;
        fin_load(R[0], U, G, SC, tok0, c, lane);
        fin_load(R[1], U, G, SC, two ? tok1 : tok0, c, lane);
#pragma unroll
        for (int q = 0; q < 2; ++q) SG[q * 64 + lane] = sigmoidf_(R[q].g[0] + mg0 * (R[q].g[1] - R[q].g[0]) + mg1 * (R[q].g[2] - R[q].g[0]));
        f32x4 gate[2] = {z4, z4};
#pragma unroll 4
        for (int r4 = 0; r4 < 16; ++r4) { const f32x4 sa = *(const LAS f32x4*)(SG + r4 * 4), sb = *(const LAS f32x4*)(SG + 64 + r4 * 4);
#pragma unroll
            for (int j = 0; j < 4; ++j) { const f32x4 gu = *(const LAS f32x4*)(GUP + (r4 * 4 + j) * 256 + c); gate[0] += gu * sa[j]; gate[1] += gu * sb[j]; } }
#pragma unroll
        for (int q = 0; q < 2; ++q) {
            if (q == 1 && !two) break;
            const FinRaw& X = R[q]; bf16_t* y = Y + (size_t)(q ? tok1 : tok0) * DM;
            { const f32x4 hh = bf4(X.s[0]) + bf4(X.s[1]), yb = bf4(X.yb); f32x4 o;
              for (int e = 0; e < 4; ++e) o[e] = hh[e] * gelu_tanh(yb[e]);
              st4bf(y + c, o); }
            { const f32x4 o = bf4(X.s[2]) + bf4(X.s[3]), z = bf4(X.z);
              const float inv = rsqrtf(red16(hsum4(o * o)) * (1.f / 64.f) + 1e-6f); f32x4 r;
              for (int e = 0; e < 4; ++e) r[e] = o[e] * inv * gdn_g[e] * siluf_(z[e]);
              st4bf(y + 256 + c, r); }
            { const f32x4 o = bf4(X.s[4]) + bf4(X.s[5]), og = bf4(X.og);
              const float inv = rsqrtf(red16(hsum4(o * o)) * (1.f / 64.f) + 1e-6f); f32x4 r;
              for (int e = 0; e < 4; ++e) r[e] = o[e] * inv * ml_g[e] * sigmoidf_(og[e]);
              st4bf(y + 512 + c, r); }
            {
                const f32x4 yy = bf4(X.s[6]) + bf4(X.s[7]);
                const float mean = red16(hsum4(yy)) * (1.f / 64.f); const f32x4 dv = yy - mean;
                const float var = red16(hsum4(dv * dv)) * (1.f / 64.f); const float inv = rsqrtf(var + 64e-5f);
                f32x4 cc = bf4(X.r[0]); const f32x4 rr = cc + mr0 * (bf4(X.r[1]) - cc) + mr1 * (bf4(X.r[2]) - cc);
                cc = bf4(X.k[0]); const f32x4 kk = cc + mk0 * (bf4(X.k[1]) - cc) + mk1 * (bf4(X.k[2]) - cc);
                cc = bf4(X.v[0]); const f32x4 vv = cc + mv0 * (bf4(X.v[1]) - cc) + mv1 * (bf4(X.v[2]) - cc);
                const float bsum = red16(hsum4(rr * kk * rk));
                f32x4 o;
                for (int e = 0; e < 4; ++e) o[e] = (dv[e] * inv * gnw[e] + gnb[e] + bsum * vv[e]) * gate[q][e];
                st4bf(y + 768 + c, o);
            }
        }
    }
    __syncthreads();
}

#ifndef EN_GEMM
#define EN_GEMM 1
#endif
#ifndef EN_SCAN
#define EN_SCAN 1
#endif
#ifndef EN_FIN
#define EN_FIN 1
#endif
#ifndef EN_ROW
#define EN_ROW 1
#endif
#ifndef REP_SCAN
#define REP_SCAN 1
#endif
#ifndef REP_GEMM
#define REP_GEMM 1
#endif
#ifndef DBG_PROBE
#define DBG_PROBE 0
#endif
__global__ void __launch_bounds__(512) mega(Params p) {
    extern __shared__ __attribute__((aligned(16))) unsigned char smem[];
    cg::grid_group grid = cg::this_grid();
    const int wv = __builtin_amdgcn_readfirstlane((int)(threadIdx.x >> 6));
    LAS unsigned char* lds = (LAS unsigned char*)smem; LAS float* sm = (LAS float*)smem;
    int repc = 0, repg = 0;
    volatile LAS unsigned* xst = (volatile LAS unsigned*)(lds + 131072);
    if (otid(wv) < 2) xst[otid(wv)] = 0u;
    __syncthreads();
    const XcdBarrier xbar = xcd_barrier_post((unsigned*)(p.ws + WS_BAR), xst, wv);
    for (int ph = p.ph_lo; ph < p.ph_hi; ++ph) {
        if (ph > p.ph_lo) { if (ph == p.ph_lo + 1) grid.sync(); else xcd_barrier(xbar, wv); }
        unsigned char* ws = p.ws; asm volatile("" : "+s"(ws));
        bf16_t* WIN = (bf16_t*)(ws + WS_WIN); bf16_t* WOUT = (bf16_t*)(ws + WS_WOUT); bf16_t* WF1 = (bf16_t*)(ws + WS_WF1); bf16_t* WF2 = (bf16_t*)(ws + WS_WF2);
        bf16_t* Ub = (bf16_t*)(ws + WS_U); float* Gf = (float*)(ws + WS_G); bf16_t* ACT = (bf16_t*)(ws + WS_ACT);
        bf16_t* O1 = (bf16_t*)(ws + WS_U); bf16_t* HD = (bf16_t*)(ws + WS_U); bf16_t* O2 = (bf16_t*)(ws + WS_SC); bf16_t* XB1 = (bf16_t*)(ws + WS_SC + (size_t)T_TOK * DM * 2);
        if (ph == 0) {
            if (DBG_PROBE == 14 && otid(wv) == 0) ((LAS unsigned*)sm)[32761] = (unsigned)__builtin_amdgcn_s_memrealtime();
            phase_convert(p, sm, wv);
            row_pass(wv, nullptr, nullptr, pin(p, 0), nullptr, nullptr, nullptr, pin(p, 1), ACT);
            if (DBG_PROBE == 14) { __syncthreads(); if (otid(wv) == 0) { const unsigned dt = (unsigned)__builtin_amdgcn_s_memrealtime() - ((LAS unsigned*)sm)[32761]; atomicMax((unsigned*)(p.ws + WS_DBG) + 14, dt * 10u); } }
            continue;
        }
        const int l = (ph - 1) / 10, s = (ph - 1) % 10;
        const bool dbg_t = DBG_PROBE >= 4 && l == 0 && s == DBG_PROBE - 4;
        if (dbg_t && otid(wv) == 0) ((LAS unsigned*)sm)[32761] = (unsigned)__builtin_amdgcn_s_memrealtime();
        pg8::StaticOrder S;
        if (REP_GEMM > 1 && (s == 0 || s == 5 || s == 7 || s == 8)) { if (++repg < REP_GEMM) { --ph; } else repg = 0; }
        if (s == 0) { pg8::Gemm g{ACT, WIN + (size_t)l * NIN * DM, T_TOK, NIN, DM}; S.init(g.M, g.N, gridDim.x, blockIdx.x); pg8::EpiU E{Ub, Gf}; pg8::gemm_phase(lds, g, S, E, wv); }
        else if (s == 1) phase_prepass(p, l, xbar, wv);
        else if (s == 2) { pg8::Gemm g{(const bf16_t*)(ws + WS_A2), (const bf16_t*)(ws + WS_BT2) + (size_t)l * 2048 * 384, T_TOK, 2048, 384}; S.init(g.M, g.N, gridDim.x, blockIdx.x);
            pg8::EpiPre E{ws, pin(p, 10) + (size_t)l * 1024, (const float*)(ws + WS_SPT) + (size_t)l * 512, pin(p, 19) + (size_t)l * 512, pin(p, 21) + (size_t)l * 512, wv};
            pg8::gemm_phase<pg8::EpiPre, true>(lds, g, S, E, wv); }
        else if (s == 3) { phase_scan(p, l, sm, wv); if (REP_SCAN > 1) { if (++repc < REP_SCAN) ph -= 2; else repc = 0; } }
        else if (s == 4) phase_finalize(p, l, sm, wv);
        else if (s == 5 || s == 8) { pg8::Gemm g{s == 5 ? ACT : HD, s == 5 ? WOUT + (size_t)l * DM * DM : WF2 + (size_t)l * DM * DFF, T_TOK, DM, s == 5 ? DM : DFF}; S.init(g.M, g.N, gridDim.x, blockIdx.x); pg8::EpiBf E{s == 5 ? O1 : O2, DM}; pg8::gemm_phase(lds, g, S, E, wv); }
        else if (s == 6 || s == 9) { const bool fa = (s == 6);
            row_pass(wv, fa ? O1 : O2, pin(p, fa ? 2 : 4) + (size_t)l * DM, (fa && l == 0) ? pin(p, 0) : nullptr, fa ? (const bf16_t*)p.out : (const bf16_t*)XB1, (!fa && l == 1) ? p.out : nullptr, fa ? XB1 : (bf16_t*)p.out,
                     fa ? pin(p, 3) + (size_t)l * DM : (l == 0 ? pin(p, 1) + DM : nullptr), ACT); }
        else if (s == 7) { pg8::Gemm g{ACT, WF1 + (size_t)l * 2 * DFF * DM, T_TOK, 2 * DFF, DM}; S.init(g.M, g.N, gridDim.x, blockIdx.x); pg8::EpiSwi E{HD}; pg8::gemm_phase(lds, g, S, E, wv); }
        if (dbg_t) { __syncthreads(); if (otid(wv) == 0) { const unsigned dt = (unsigned)__builtin_amdgcn_s_memrealtime() - ((LAS unsigned*)sm)[32761]; atomicMax((unsigned*)(p.ws + WS_DBG) + DBG_PROBE, dt * 10u); } }
    }
    if (DBG_PROBE) { __syncthreads(); if (blockIdx.x == 0 && otid(wv) == 0) { const unsigned v = __hip_atomic_load((const unsigned*)(p.ws + WS_DBG) + DBG_PROBE, __ATOMIC_RELAXED, __HIP_MEMORY_SCOPE_AGENT);
        __builtin_amdgcn_s_waitcnt(0); p.out[0] += (float)(v / 1000u); } }
}

extern "C" void kernel_launch(void* const* d_in, const int* in_sizes, int n_in, void* d_out, int out_size, void* d_ws, size_t ws_size, hipStream_t stream) {
    static int grid_blocks = 0;
    if (grid_blocks == 0) {
        if (n_in != 31 || ws_size < WS_END || out_size != T_TOK * DM) { fprintf(stderr, "kernel_launch: unexpected shapes (n_in %d, ws %zu need %zu, out %d)\n", n_in, ws_size, (size_t)WS_END, out_size); grid_blocks = -1; return; }
        int dev = 0, cus = 0, per_cu = 0;
        (void)hipGetDevice(&dev);
        (void)hipDeviceGetAttribute(&cus, hipDeviceAttributeMultiprocessorCount, dev);
        if (hipFuncSetAttribute((const void*)mega, hipFuncAttributeMaxDynamicSharedMemorySize, LDS_BYTES) != hipSuccess) { fprintf(stderr, "kernel_launch: hipFuncSetAttribute failed\n"); grid_blocks = -1; return; }
        if (hipOccupancyMaxActiveBlocksPerMultiprocessor(&per_cu, (const void*)mega, 512, LDS_BYTES) != hipSuccess || per_cu < 1) { fprintf(stderr, "kernel_launch: occupancy query says %d blocks per CU\n", per_cu); per_cu = 1; (void)hipGetLastError(); }
        grid_blocks = 256;
        (void)per_cu;
    }
    if (grid_blocks < 0) return;
    if (hipMemsetAsync((char*)d_ws + WS_BAR, 0, (size_t)XCD_BAR_WORDS * 4, stream) != hipSuccess) { fprintf(stderr, "kernel_launch: hipMemsetAsync of the barrier words failed\n"); return; }
    Params p{};
    for (int i = 0; i < 31; ++i) p.in[i] = (const float*)d_in[i];
    p.out = (float*)d_out; p.ws = (unsigned char*)d_ws; p.ph_lo = 0; p.ph_hi = 21;
    void* args[] = {&p};
    hipError_t e = hipLaunchCooperativeKernel((const void*)mega, dim3(grid_blocks), dim3(512), args, LDS_BYTES, stream);
    if (e != hipSuccess) fprintf(stderr, "cooperative launch failed: %s (grid %d)\n", hipGetErrorString(e), grid_blocks);
}
```

```cpp
#include <hip/hip_runtime.h>
#include <hip/hip_cooperative_groups.h>
#include <cstdio>
namespace cg = cooperative_groups;

#ifndef DBG_PROBE
#define DBG_PROBE 0
#endif
#define LAS __attribute__((address_space(3)))
typedef unsigned short bf16_t;
typedef short bf16x8 __attribute__((ext_vector_type(8)));
typedef float f32x4 __attribute__((ext_vector_type(4)));
typedef float f32x2 __attribute__((ext_vector_type(2)));
typedef unsigned u32x4 __attribute__((ext_vector_type(4)));
typedef unsigned u32x2 __attribute__((ext_vector_type(2)));

constexpr int T_TOK = 32768, SEQ = 4096, DM = 1024, NU = 3328, NGATE = 256, NIN = 3584, DFF = 2816, NSC = 2048;
constexpr int LDS_BYTES = 131072 + 16;
constexpr size_t WS_WIN = 0;
constexpr size_t WS_WOUT = WS_WIN + (size_t)2 * NIN * DM * 2;
constexpr size_t WS_WF1 = WS_WOUT + (size_t)2 * DM * DM * 2;
constexpr size_t WS_WF2 = WS_WF1 + (size_t)2 * 2 * DFF * DM * 2;
constexpr size_t WS_U = WS_WF2 + (size_t)2 * DM * DFF * 2;
constexpr size_t WS_G = WS_U + (size_t)T_TOK * NU * 2;
constexpr size_t WS_ACT = WS_G + (size_t)T_TOK * NGATE * 4;
constexpr size_t WS_SC = WS_ACT + (size_t)T_TOK * DM * 2;
constexpr size_t WS_A2 = WS_SC + (size_t)T_TOK * NSC * 2;
constexpr size_t WS_BT2 = WS_A2 + (size_t)T_TOK * 384 * 2;
constexpr size_t WS_SPT = WS_BT2 + (size_t)2 * 2048 * 384 * 2;
constexpr size_t WS_DBG = WS_SPT + 4096;
constexpr size_t WS_BAR = WS_DBG + 256;
constexpr int XCD_BAR_WORDS = 3456;
constexpr size_t WS_END = WS_BAR + (size_t)XCD_BAR_WORDS * 4;

struct Params { const float* in[31]; float* out; unsigned char* ws; int ph_lo, ph_hi; };
__device__ __forceinline__ const float* pin(const Params& p, int i) { asm volatile("" : "+s"(i)); return p.in[i]; }

__device__ __forceinline__ int otid(int wv) { unsigned z = 0u; asm volatile("" : "+s"(z)); int t = (wv << 6) | (int)__builtin_amdgcn_mbcnt_hi(~0u, __builtin_amdgcn_mbcnt_lo(~0u, z)); asm volatile("" : "+v"(t)); return t; }
__device__ __forceinline__ int obid() { int t = blockIdx.x; asm volatile("" : "+s"(t)); return t; }
__device__ __forceinline__ float bf2f(unsigned short b) { return __uint_as_float(((unsigned)b) << 16); }
__device__ __forceinline__ unsigned short f2bf(float f) { unsigned u = __float_as_uint(f); u += 0x7FFFu + ((u >> 16) & 1u); return (unsigned short)(u >> 16); }
__device__ __forceinline__ unsigned pk2(float lo, float hi) { return (unsigned)f2bf(lo) | ((unsigned)f2bf(hi) << 16); }
__device__ __forceinline__ f32x4 ld4bf(const bf16_t* p) {
    const u32x2 v = *(const u32x2*)p; f32x4 r;
    r.x = __uint_as_float(v.x << 16); r.y = __uint_as_float(v.x & 0xffff0000u); r.z = __uint_as_float(v.y << 16); r.w = __uint_as_float(v.y & 0xffff0000u); return r;
}
__device__ __forceinline__ f32x4 bf4(u32x2 v) { f32x4 r; r.x = __uint_as_float(v.x << 16); r.y = __uint_as_float(v.x & 0xffff0000u); r.z = __uint_as_float(v.y << 16); r.w = __uint_as_float(v.y & 0xffff0000u); return r; }
__device__ __forceinline__ void st4bf(bf16_t* p, f32x4 v) { u32x2 o; o.x = pk2(v.x, v.y); o.y = pk2(v.z, v.w); *(u32x2*)p = o; }
__device__ __forceinline__ float sigmoidf_(float x) { return __builtin_amdgcn_rcpf(1.f + __expf(-x)); }
__device__ __forceinline__ float siluf_(float x) { return x * __builtin_amdgcn_rcpf(1.f + __expf(-x)); }
__device__ __forceinline__ float softplusf_(float x) { return fmaxf(x, 0.f) + __logf(1.f + __expf(-fabsf(x))); }
__device__ __forceinline__ float tanhf_(float x) { return 1.f - 2.f * __builtin_amdgcn_rcpf(1.f + __expf(2.f * x)); }
__device__ __forceinline__ float gelu_tanh(float x) { const float u = 0.7978845608028654f * (x + 0.044715f * x * x * x); return 0.5f * x * (1.f + tanhf_(u)); }
__device__ __forceinline__ float hsum4(f32x4 v) { return (v.x + v.z) + (v.y + v.w); }
template <int CTRL> __device__ __forceinline__ float dppf(float x) { return __int_as_float(__builtin_amdgcn_update_dpp(0, __float_as_int(x), CTRL, 0xF, 0xF, true)); }
__device__ __forceinline__ float red16(float v) { v += dppf<0xB1>(v); v += dppf<0x4E>(v); v += dppf<0x141>(v); v += dppf<0x140>(v); return v; }
__device__ __forceinline__ float red64(float v) { v = red16(v); v += __shfl_xor(v, 16); v += __shfl_xor(v, 32); return v; }
__device__ __forceinline__ float sum4l(float x) { x += dppf<0xB1>(x); x += dppf<0x4E>(x); return x; }
__device__ __forceinline__ unsigned cvt_pk_bf16(float lo, float hi) { unsigned r; asm volatile("v_cvt_pk_bf16_f32 %0, %1, %2" : "=v"(r) : "v"(lo), "v"(hi)); return r; }

#define XB_TMO      128
#define XB_XCNT(j)  (256  + 64 * (j))
#define XB_XSUB(j)  (1280 + 64 * (j))
#define XB_XGEN(j)  (2304 + 64 * (j))
#define XB_TOP      3328
#define XB_TOPGEN   3392
#define XB_SPIN_CAP (1u << 22)
__device__ __forceinline__ unsigned xb_ld(unsigned* p)              { return __hip_atomic_load(p, __ATOMIC_RELAXED, __HIP_MEMORY_SCOPE_AGENT); }
__device__ __forceinline__ unsigned xb_add(unsigned* p, unsigned v) { return __hip_atomic_fetch_add(p, v, __ATOMIC_RELAXED, __HIP_MEMORY_SCOPE_AGENT); }
__device__ __forceinline__ unsigned xb_xcc_id() { return (unsigned)__builtin_amdgcn_s_getreg((3 << 11) | 20) & 0xFu; }
#define XB_SPIN(cond, bar) do { unsigned _sp = 0; while (cond) { __builtin_amdgcn_s_sleep(1); \
    if ((++_sp & 255u) == 0u) { if (xb_ld(&(bar)[XB_TMO])) break; if (_sp > XB_SPIN_CAP) { atomicAdd(&(bar)[XB_TMO], 1u); break; } } } } while (0)
struct XcdBarrier { unsigned* bar; unsigned x; volatile LAS unsigned* st; };
__device__ __forceinline__ XcdBarrier xcd_barrier_post(unsigned* bar, volatile LAS unsigned* st, int wv) {
    XcdBarrier b; b.bar = bar; b.x = xb_xcc_id(); b.st = st;
    if (otid(wv) == 0) (void)xb_add(&bar[XB_XCNT(b.x)], 1u);
    return b;
}
__device__ __forceinline__ void xcd_barrier_complete(unsigned* bar, unsigned x, unsigned& nloc, unsigned& nx) {
    const unsigned G = gridDim.x * gridDim.y * gridDim.z;
    unsigned sum, cnt, mine, sp = 0u;
    for (;;) {
        sum = 0u; cnt = 0u; mine = 0u;
#pragma unroll
        for (unsigned j = 0; j < 16; ++j) { const unsigned c = xb_ld(&bar[XB_XCNT(j)]); sum += c; cnt += (c > 0u) ? 1u : 0u; mine = (j == x) ? c : mine; }
        if (sum == G) break;
        __builtin_amdgcn_s_sleep(1);
        if ((++sp & 255u) == 0u) { if (xb_ld(&bar[XB_TMO])) break; if (sp > XB_SPIN_CAP) { atomicAdd(&bar[XB_TMO], 1u); break; } }
    }
    nloc = mine > 0u ? mine : 1u; nx = cnt > 0u ? cnt : 1u;
}
__device__ __forceinline__ void xcd_barrier(const XcdBarrier& b, int wv) {
    asm volatile("s_waitcnt vmcnt(0)" ::: "memory");
    __syncthreads();
    if (otid(wv) == 0) {
        unsigned* bar = b.bar;
        __builtin_amdgcn_s_waitcnt(0);
        unsigned nloc = b.st[0], nx = b.st[1];
        if (nloc == 0u) { xcd_barrier_complete(bar, b.x, nloc, nx); b.st[0] = nloc; b.st[1] = nx; }
        const unsigned old = xb_add(&bar[XB_XSUB(b.x)], 1u);
        const unsigned gen = old / nloc;
        if (old + 1u == (gen + 1u) * nloc) {
            __builtin_amdgcn_fence(__ATOMIC_RELEASE, "agent");
            asm volatile("s_waitcnt vmcnt(0)" ::: "memory");
            const unsigned og = xb_add(&bar[XB_TOP], 1u);
            const unsigned tg = og / nx;
            if (og + 1u == (tg + 1u) * nx) xb_add(&bar[XB_TOPGEN], 1u);
            else XB_SPIN(xb_ld(&bar[XB_TOPGEN]) == tg, bar);
            __builtin_amdgcn_fence(__ATOMIC_ACQUIRE, "agent");
            xb_add(&bar[XB_XGEN(b.x)], 1u);
            asm volatile("s_waitcnt vmcnt(0)" ::: "memory");
        } else {
            XB_SPIN(xb_ld(&bar[XB_XGEN(b.x)]) == gen, bar);
            __builtin_amdgcn_fence(__ATOMIC_ACQUIRE, "agent");
            asm volatile("s_waitcnt vmcnt(0)" ::: "memory");
        }
    }
    __syncthreads();
}

namespace pg8 {
constexpr int BM = 256, BK = 64, HALF = 128, HTB = HALF * BK * 2, STAGE_BYTES = 8 * HTB, NXCD = 8, WGM = 8;
__device__ __forceinline__ int lds_byte(int r, int c) { const int st = (r >> 4) * 2 + (c >> 5), rr = r & 15, cc = c & 31, ob = rr * 64 + cc * 2; return st * 1024 + (ob ^ (((ob >> 9) & 1) << 5)); }
__device__ __forceinline__ void stage_rc(int b, int& R, int& C) { const int st = b / 1024, sb = b % 1024, swz = sb ^ (((sb >> 9) & 1) << 5); R = (st >> 1) * 16 + swz / 64; C = (st & 1) * 32 + (swz % 64) / 2; }
__device__ __forceinline__ int perm32(int rho) { const int n = rho >> 4, i = rho & 15; return 8 * (i >> 2) + 4 * n + (i & 3); }
struct Unit { int pm, pn; };
struct Gemm { const bf16_t* A; const bf16_t* Bt; int M, N, K; };
struct StaticOrder {
    int nM, nN, nwg, G, c;
    __device__ void init(int M, int N, int G_, int c_) { nM = M / BM; nN = N / BM; nwg = nM * nN; G = G_; c = c_; }
    __device__ bool next(int i, Unit& u) const {
        const long L = (long)i * G + c; if (L >= nwg) return false;
        int wgid = (int)L; { const int q = nwg / NXCD, r = nwg % NXCD, xcd = wgid % NXCD, off = wgid / NXCD; wgid = (xcd < r ? xcd * (q + 1) : r * (q + 1) + (xcd - r) * q) + off; }
        const int nig = WGM * nN, gid = wgid / nig, fm = gid * WGM, gsz = (nM - fm) < WGM ? (nM - fm) : WGM;
        u.pm = fm + ((wgid % nig) % gsz); u.pn = (wgid % nig) / gsz; return true;
    }
};
struct EpiBf {
    static constexpr bool PERM = true;
    bf16_t* C; int ldc;
    __device__ __forceinline__ void operator()(const f32x4 (&acc)[2][2][4][2], const Unit& u, int wr, int wc, int fr, int fq) const {
        const int row0 = u.pm * BM + wr * 64 + fr, col0 = u.pn * BM + wc * 32 + 8 * fq;
#pragma unroll
        for (int ai = 0; ai < 2; ++ai)
#pragma unroll
            for (int m = 0; m < 4; ++m) { bf16_t* rowp = C + (size_t)(row0 + ai * HALF + m * 16) * ldc + col0;
#pragma unroll
                for (int bj = 0; bj < 2; ++bj) { const f32x4 v0 = acc[ai][bj][m][0], v1 = acc[ai][bj][m][1];
                    u32x4 o; o.x = cvt_pk_bf16(v0[0], v0[1]); o.y = cvt_pk_bf16(v0[2], v0[3]); o.z = cvt_pk_bf16(v1[0], v1[1]); o.w = cvt_pk_bf16(v1[2], v1[3]);
                    *(u32x4*)(rowp + bj * HALF) = o; } }
    }
};
struct EpiU {
    static constexpr bool PERM = true;
    bf16_t* U; float* G;
    __device__ __forceinline__ void operator()(const f32x4 (&acc)[2][2][4][2], const Unit& u, int wr, int wc, int fr, int fq) const {
        const int row0 = u.pm * BM + wr * 64 + fr;
        if (u.pn < 13) {
            const int col0 = u.pn * BM + wc * 32 + 8 * fq;
#pragma unroll
            for (int ai = 0; ai < 2; ++ai)
#pragma unroll
                for (int m = 0; m < 4; ++m) { bf16_t* rowp = U + (size_t)(row0 + ai * HALF + m * 16) * NU + col0;
#pragma unroll
                    for (int bj = 0; bj < 2; ++bj) { const f32x4 v0 = acc[ai][bj][m][0], v1 = acc[ai][bj][m][1];
                        u32x4 o; o.x = cvt_pk_bf16(v0[0], v0[1]); o.y = cvt_pk_bf16(v0[2], v0[3]); o.z = cvt_pk_bf16(v1[0], v1[1]); o.w = cvt_pk_bf16(v1[2], v1[3]);
                        *(u32x4*)(rowp + bj * HALF) = o; } }
        } else {
            const int col0 = wc * 32 + 8 * fq;
#pragma unroll
            for (int ai = 0; ai < 2; ++ai)
#pragma unroll
                for (int m = 0; m < 4; ++m) { float* rowp = G + (size_t)(row0 + ai * HALF + m * 16) * NGATE + col0;
#pragma unroll
                    for (int bj = 0; bj < 2; ++bj) { *(f32x4*)(rowp + bj * HALF) = acc[ai][bj][m][0]; *(f32x4*)(rowp + bj * HALF + 4) = acc[ai][bj][m][1]; } }
        }
    }
};
struct EpiSwi {
    static constexpr bool PERM = true;
    bf16_t* H;
    __device__ __forceinline__ void operator()(const f32x4 (&acc)[2][2][4][2], const Unit& u, int wr, int wc, int fr, int fq) const {
        const int row0 = u.pm * BM + wr * 64 + fr, col0 = u.pn * HALF + wc * 32 + 8 * fq;
#pragma unroll
        for (int ai = 0; ai < 2; ++ai)
#pragma unroll
            for (int m = 0; m < 4; ++m) { bf16_t* rowp = H + (size_t)(row0 + ai * HALF + m * 16) * DFF + col0;
                float r[8];
#pragma unroll
                for (int n = 0; n < 2; ++n)
#pragma unroll
                    for (int j = 0; j < 4; ++j) { const float g = acc[ai][0][m][n][j], up = acc[ai][1][m][n][j]; r[n * 4 + j] = g * up * __builtin_amdgcn_rcpf(1.f + __expf(-g)); }
                u32x4 o; o.x = cvt_pk_bf16(r[0], r[1]); o.y = cvt_pk_bf16(r[2], r[3]); o.z = cvt_pk_bf16(r[4], r[5]); o.w = cvt_pk_bf16(r[6], r[7]);
                *(u32x4*)rowp = o; }
    }
};

struct EpiPre {
    static constexpr bool PERM = true;
    unsigned char* ws; const float* gb; const float* lam; const float* w0; const float* a0; int wv;
    __device__ __forceinline__ void operator()(const f32x4 (&acc)[2][2][4][2], const Unit& u, int wr_, int wc_, int fr_, int fq_) const {
        const int t_ = otid(wv); const int wr = t_ >> 8, wc = (t_ >> 6) & 3, fr = t_ & 15, fq = (t_ >> 4) & 3;
        (void)wr_; (void)wc_; (void)fr_; (void)fq_;
        const unsigned row0 = u.pm * BM + wr * 64 + fr;
        if (u.pn < 4) {
            const int dir = u.pn >> 1;
#pragma unroll
            for (int n = 0; n < 2; ++n) { const unsigned c = (u.pn & 1) * 128 + wc * 32 + 8 * fq + 4 * n;
                const f32x4 sp = *(const f32x4*)(lam + dir * 256 + c); const f32x4 gr = *(const f32x4*)(gb + (dir * 2 + 0) * 256 + c), gi = *(const f32x4*)(gb + (dir * 2 + 1) * 256 + c);
#pragma unroll
                for (int ai = 0; ai < 2; ++ai)
#pragma unroll
                    for (int m = 0; m < 4; ++m) { const unsigned row = row0 + ai * HALF + m * 16;
                        const f32x4 xc = ld4bf((const bf16_t*)(ws + (unsigned)WS_A2 + (row * 384u + c) * 2u)); f32x4 la, bb;
#pragma unroll
                        for (int j = 0; j < 4; ++j) { const float rp = acc[ai][0][m][n][j] + gr[j], ip = acc[ai][1][m][n][j] + gi[j];
                            const float l_ = sp[j] * __builtin_amdgcn_rcpf(1.f + __expf(-rp)); const float a_ = __expf(l_);
                            la[j] = 1.f - a_;     bb[j] = __builtin_amdgcn_sqrtf(fmaxf(1.f - a_ * a_, 0.f)) * __builtin_amdgcn_rcpf(1.f + __expf(-ip)) * xc[j]; }
                        u32x2 o; o.x = cvt_pk_bf16(la[0], la[1]); o.y = cvt_pk_bf16(la[2], la[3]); *(u32x2*)(ws + (unsigned)WS_ACT + (row * (unsigned)DM + dir * 256u + c) * 2u) = o;
                        o.x = cvt_pk_bf16(bb[0], bb[1]); o.y = cvt_pk_bf16(bb[2], bb[3]); *(u32x2*)(ws + (unsigned)WS_SC + (row * (unsigned)NSC + dir * 256u + c) * 2u) = o; } }
        } else {
            const int q = u.pn - 4, kind = q >> 1, d = q & 1;
            const float* cst = (kind ? a0 : w0) + d * 256; const float mul = kind ? 1.f : -0.6065306597126334f;
            const unsigned dbase = kind ? (unsigned)WS_ACT + (512u + d * 256u) * 2u : (d ? (unsigned)WS_G + 64u * 2u : (unsigned)WS_U);
            const unsigned dstride = kind ? (unsigned)DM * 2u : (d ? 512u * 2u : (unsigned)NU * 2u);
#pragma unroll
            for (int bj = 0; bj < 2; ++bj)
#pragma unroll
                for (int n = 0; n < 2; ++n) { const unsigned c = bj * HALF + wc * 32 + 8 * fq + 4 * n; const f32x4 cv = *(const f32x4*)(cst + c);
#pragma unroll
                    for (int ai = 0; ai < 2; ++ai)
#pragma unroll
                        for (int m = 0; m < 4; ++m) { const unsigned row = row0 + ai * HALF + m * 16; f32x4 r;
#pragma unroll
                            for (int j = 0; j < 4; ++j) r[j] = mul * __builtin_amdgcn_rcpf(1.f + __expf(-(acc[ai][bj][m][n][j] + cv[j])));
                            u32x2 o; o.x = cvt_pk_bf16(r[0], r[1]); o.y = cvt_pk_bf16(r[2], r[3]);
                            *(u32x2*)(ws + dbase + row * dstride + c * 2u) = o; } }
        }
    }
};

template <class Epi, bool KSUB = false>
__device__ __forceinline__ void gemm_phase(LAS unsigned char* lds, const Gemm g, const StaticOrder& S, const Epi& E, int wv) {
    const int tid = otid(wv), wid = __builtin_amdgcn_readfirstlane(tid >> 6), lane = tid & 63, wr = wid >> 2, wc = wid & 3, fr = lane & 15, fq = lane >> 4;
    const int K = g.K, nt = KSUB ? 2 : K / BK;
#define PG8_KOFF(u) (KSUB ? (size_t)(((u).pn < 4 ? ((u).pn & 1) * 128 : 256) * 2) : (size_t)0)
    unsigned voffA[2], voffB[2];
#pragma unroll
    for (int i = 0; i < 2; ++i) { int R, C; stage_rc(tid * 16 + i * 8192, R, C); const int Rb = Epi::PERM ? ((R & ~31) + perm32(R & 31)) : R;
        voffA[i] = (unsigned)(R * K + C) * 2u; voffB[i] = (unsigned)(Rb * K + C) * 2u; }
    const size_t kstep = (size_t)(BK * 2);
    const size_t hstep = (size_t)HALF * K * 2;
    const size_t tstep = 2 * hstep;
    const unsigned ldsw = (unsigned)wid * 1024u;
    const int aoff = lds_byte(wr * 64 + fr, fq * 8), boff = lds_byte(wc * 32 + fr, fq * 8);
#define PG8_SA(b, h) (((b) * 2 + (h)) * HTB)
#define PG8_SB(b, h) ((4 + (b) * 2 + (h)) * HTB)
#define PG8_STAGE(bufoff, gbase, voff) do { _Pragma("unroll") for (int _i = 0; _i < 2; ++_i) \
        __builtin_amdgcn_global_load_lds((const unsigned*)((const char*)(gbase) + (voff)[_i]), (LAS unsigned*)(lds + (bufoff) + ldsw + _i * 8192), 16, 0, 0); } while (0)
#define PG8_LDA(dst, b, h) do { _Pragma("unroll") for (int m = 0; m < 4; ++m) _Pragma("unroll") for (int k = 0; k < 2; ++k) dst[m][k] = *(const LAS bf16x8*)(lds + PG8_SA(b, h) + aoff + m * 2048 + k * 1024); } while (0)
#define PG8_LDB(dst, b, h) do { _Pragma("unroll") for (int n = 0; n < 2; ++n) _Pragma("unroll") for (int k = 0; k < 2; ++k) dst[n][k] = *(const LAS bf16x8*)(lds + PG8_SB(b, h) + boff + n * 2048 + k * 1024); } while (0)
#define PG8_MMA(ai, bj, At, Bt) do { __builtin_amdgcn_s_setprio(1); _Pragma("unroll") for (int m = 0; m < 4; ++m) _Pragma("unroll") for (int n = 0; n < 2; ++n) _Pragma("unroll") for (int k = 0; k < 2; ++k) \
        acc[ai][bj][m][n] = __builtin_amdgcn_mfma_f32_16x16x32_bf16(Bt[n][k], At[m][k], acc[ai][bj][m][n], 0, 0, 0); __builtin_amdgcn_s_setprio(0); } while (0)
#define PG8_WAIT_V(n) asm volatile("s_waitcnt vmcnt(" #n ")" ::: "memory")
#define PG8_WAIT_L(n) asm volatile("s_waitcnt lgkmcnt(" #n ")" ::: "memory")
#define PG8_BAR __builtin_amdgcn_s_barrier()
#define PG8_SCHED __builtin_amdgcn_sched_barrier(0)
    Unit cur, nxt; int ui = 0;
    if (!S.next(0, cur)) return;
    f32x4 acc[2][2][4][2];
#pragma unroll
    for (int a = 0; a < 2; ++a)
#pragma unroll
        for (int b = 0; b < 2; ++b)
#pragma unroll
            for (int m = 0; m < 4; ++m)
#pragma unroll
                for (int n = 0; n < 2; ++n) acc[a][b][m][n] = (f32x4){0.f, 0.f, 0.f, 0.f};
    bf16x8 At[4][2], B0[2][2], B1[2][2];
    const char* cA = (const char*)g.A + (size_t)cur.pm * tstep + PG8_KOFF(cur); const char* cB = (const char*)g.Bt + (size_t)cur.pn * tstep + PG8_KOFF(cur);
    PG8_STAGE(PG8_SB(0, 0), cB, voffB); PG8_STAGE(PG8_SA(0, 0), cA, voffA); PG8_STAGE(PG8_SB(0, 1), cB + hstep, voffB); PG8_STAGE(PG8_SA(0, 1), cA + hstep, voffA);
    if (wr == 1) PG8_BAR;
    PG8_WAIT_V(4); PG8_BAR;
    PG8_STAGE(PG8_SB(1, 0), cB + kstep, voffB); PG8_STAGE(PG8_SA(1, 0), cA + kstep, voffA); PG8_STAGE(PG8_SB(1, 1), cB + hstep + kstep, voffB);
    PG8_WAIT_V(6); PG8_BAR;
    for (;;) {
        const bool has_next = S.next(ui + 1, nxt);
        const char* nA = has_next ? (const char*)g.A + (size_t)nxt.pm * tstep + PG8_KOFF(nxt) : cA; const char* nB = has_next ? (const char*)g.Bt + (size_t)nxt.pn * tstep + PG8_KOFF(nxt) : cB;
        for (int t = 0; t < nt; t += 2) {
            const bool last = (t == nt - 2);
            const char* a1 = cA + (size_t)(t + 1) * kstep;
            const char* a2 = last ? nA : cA + (size_t)(t + 2) * kstep; const char* b2 = last ? nB : cB + (size_t)(t + 2) * kstep;
            const char* a3 = a2 + kstep; const char* b3 = b2 + kstep;
            PG8_LDB(B0, 0, 0); PG8_SCHED; PG8_LDA(At, 0, 0); PG8_STAGE(PG8_SA(1, 1), a1 + hstep, voffA);
            PG8_WAIT_L(8); PG8_BAR; PG8_WAIT_L(0); PG8_MMA(0, 0, At, B0); PG8_BAR; PG8_SCHED;
            PG8_LDB(B1, 0, 1); PG8_STAGE(PG8_SB(0, 0), b2, voffB);
            PG8_BAR; PG8_WAIT_L(0); PG8_MMA(0, 1, At, B1); PG8_BAR;
            PG8_LDA(At, 0, 1); PG8_STAGE(PG8_SA(0, 0), a2, voffA);
            PG8_BAR; PG8_WAIT_L(0); PG8_MMA(1, 0, At, B0); PG8_BAR; PG8_SCHED;
            PG8_STAGE(PG8_SB(0, 1), b2 + hstep, voffB);
            PG8_WAIT_V(6); PG8_BAR; PG8_MMA(1, 1, At, B1); PG8_BAR;
            PG8_LDB(B0, 1, 0); PG8_SCHED; PG8_LDA(At, 1, 0); PG8_STAGE(PG8_SA(0, 1), a2 + hstep, voffA);
            PG8_WAIT_L(8); PG8_BAR; PG8_WAIT_L(0); PG8_MMA(0, 0, At, B0); PG8_BAR; PG8_SCHED;
            PG8_LDB(B1, 1, 1); PG8_STAGE(PG8_SB(1, 0), b3, voffB);
            PG8_BAR; PG8_WAIT_L(0); PG8_MMA(0, 1, At, B1); PG8_BAR;
            PG8_LDA(At, 1, 1); PG8_STAGE(PG8_SA(1, 0), a3, voffA);
            PG8_BAR; PG8_WAIT_L(0); PG8_MMA(1, 0, At, B0); PG8_BAR; PG8_SCHED;
            PG8_STAGE(PG8_SB(1, 1), b3 + hstep, voffB);
            PG8_WAIT_V(6); PG8_BAR; PG8_MMA(1, 1, At, B1); PG8_BAR;
        }
        E(acc, cur, wr, wc, fr, fq);
        if (!has_next) break;
#pragma unroll
        for (int a = 0; a < 2; ++a)
#pragma unroll
            for (int b = 0; b < 2; ++b)
#pragma unroll
                for (int m = 0; m < 4; ++m)
#pragma unroll
                    for (int n = 0; n < 2; ++n) acc[a][b][m][n] = (f32x4){0.f, 0.f, 0.f, 0.f};
        cur = nxt; cA = nA; cB = nB; ++ui;
    }
    PG8_WAIT_V(0);
    if (wr == 0) PG8_BAR;
    PG8_BAR;
#undef PG8_KOFF
#undef PG8_SA
#undef PG8_SB
#undef PG8_STAGE
#undef PG8_LDA
#undef PG8_LDB
#undef PG8_MMA
#undef PG8_WAIT_V
#undef PG8_WAIT_L
#undef PG8_BAR
#undef PG8_SCHED
}
}

__device__ __forceinline__ int src_col(int kind, int n) {
    if (kind == 0) {
        if (n < 1536) return n;
        if (n < 2560) return n + 16;
        if (n < 3328) return n + 32;
        const int j = n - 3328;
        if (j < 16) return 1536 + j;
        if (j < 32) return 2576 + (j - 16);
        if (j < 224) return 3360 + (j - 32);
        return -1;
    }
    if (kind == 2) return ((n & 255) >> 7) * DFF + (n >> 8) * 128 + (n & 127);
    return n;
}
__device__ __forceinline__ void phase_convert(const Params& p, LAS float* tile, int wv) {
    const int tid = otid(wv);
    bf16_t* WIN = (bf16_t*)(p.ws + WS_WIN); bf16_t* WOUT = (bf16_t*)(p.ws + WS_WOUT); bf16_t* WF1 = (bf16_t*)(p.ws + WS_WF1); bf16_t* WF2 = (bf16_t*)(p.ws + WS_WF2);
    {
        const int lane = tid & 63, wave = tid >> 6;
        LAS float* scr = tile + wave * (64 * 33);
        for (int it = blockIdx.x * 8 + wave; it < 13056; it += gridDim.x * 8) {
            const int l = it / 6528; int r = it % 6528; int kind, nb, kb, K, Nsrc; const float* W; bf16_t* dst;
            if (r < 1792) { kind = 0; nb = r % 112; kb = r / 112; K = 1024; Nsrc = 3552; W = pin(p, 5) + (size_t)l * 1024 * 3552; dst = WIN + (size_t)l * NIN * 1024; }
            else if (r < 2304) { r -= 1792; kind = 1; nb = r % 32; kb = r / 32; K = 1024; Nsrc = 1024; W = pin(p, 6) + (size_t)l * 1024 * 1024; dst = WOUT + (size_t)l * 1024 * 1024; }
            else if (r < 5120) { r -= 2304; kind = 2; nb = r % 176; kb = r / 176; K = 1024; Nsrc = 5632; W = pin(p, 29) + (size_t)l * 1024 * 5632; dst = WF1 + (size_t)l * 5632 * 1024; }
            else { r -= 5120; kind = 3; nb = r % 32; kb = r / 32; K = 2816; Nsrc = 1024; W = pin(p, 30) + (size_t)l * 2816 * 1024; dst = WF2 + (size_t)l * 1024 * 2816; }
            const int k0 = 64 * kb, n0 = 32 * nb; const int sc = src_col(kind, n0 + (lane & 31));
            float vals[32];
#pragma unroll
            for (int i = 0; i < 32; ++i) { const int kk = 2 * i + (lane >> 5); vals[i] = (sc >= 0) ? W[(size_t)(k0 + kk) * Nsrc + sc] : 0.f; }
#pragma unroll
            for (int i = 0; i < 32; ++i) { const int kk = 2 * i + (lane >> 5); scr[kk * 33 + (lane & 31)] = vals[i]; }
            const int c8 = lane & 7;
#pragma unroll
            for (int j = 0; j < 4; ++j) { const int n = (lane >> 3) + 8 * j; const LAS float* s = scr + (8 * c8) * 33 + n;
                u32x4 o; o.x = pk2(s[0 * 33], s[1 * 33]); o.y = pk2(s[2 * 33], s[3 * 33]); o.z = pk2(s[4 * 33], s[5 * 33]); o.w = pk2(s[6 * 33], s[7 * 33]);
                *(u32x4*)(dst + (size_t)(n0 + n) * K + k0 + 8 * c8) = o; }
        }
    }
    {
        bf16_t* BT2 = (bf16_t*)(p.ws + WS_BT2);
        for (int idx = blockIdx.x * 512 + tid; idx < 2 * 2048 * 384; idx += gridDim.x * 512) {
            const int l = idx / (2048 * 384), rem = idx % (2048 * 384), n = rem / 384, k = rem % 384, pn = n >> 8, cc = n & 255;
            float v = 0.f;
            if (pn < 4) { const int dir = pn >> 1, gate = cc >> 7, c = (pn & 1) * 128 + (cc & 127), nb = c >> 6, o = c & 63;
                if (k < 256 && (k >> 6) == nb) v = pin(p, 9)[((size_t)((((l * 2 + dir) * 2 + gate) * 4 + nb) * 64 + (k & 63))) * 64 + o]; }
            else { const int q = pn - 4, kind = q >> 1, d = q & 1, kb = 256 + kind * 64 + d * 32;
                if (k >= kb && k < kb + 32) v = (kind ? pin(p, 22) : pin(p, 20))[(size_t)((l * 2 + d) * 32 + (k - kb)) * 256 + cc]; }
            BT2[idx] = f2bf(v);
        }
        if (DBG_PROBE && blockIdx.x == 0 && tid < 32) ((unsigned*)(p.ws + WS_DBG))[tid] = 0u;
        if (blockIdx.x == 0) for (int i = tid; i < 1024; i += 512) ((float*)(p.ws + WS_SPT))[i] = -8.f * softplusf_(-pin(p, 11)[i]);
    }
}
__device__ __forceinline__ void row_pass(int wv, const bf16_t* O, const float* g1, const float* xres_f, const bf16_t* xres_b, float* xout_f, bf16_t* xout_b, const float* g2, bf16_t* hb) {
    const int tid = otid(wv); const int lane = tid & 63, gw = blockIdx.x * 8 + (tid >> 6), nw = gridDim.x * 8;
    f32x4 g1v[4], g2v[4];
#pragma unroll
    for (int j = 0; j < 4; ++j) { g1v[j] = g1 ? *((const f32x4*)g1 + lane + 64 * j) : (f32x4){0.f, 0.f, 0.f, 0.f}; g2v[j] = g2 ? *((const f32x4*)g2 + lane + 64 * j) : (f32x4){0.f, 0.f, 0.f, 0.f}; }
    u32x4 xf[4]; u32x2 xb[4], ob[4];
#define RP_LOAD(ROW) do { const int _r = (ROW) < T_TOK ? (ROW) : gw; \
        if (xres_f) { const u32x4* xp = (const u32x4*)(xres_f + (size_t)_r * DM) + lane; _Pragma("unroll") for (int j = 0; j < 4; ++j) xf[j] = xp[64 * j]; } \
        else { const bf16_t* xp = xres_b + (size_t)_r * DM + 4 * lane; _Pragma("unroll") for (int j = 0; j < 4; ++j) xb[j] = *(const u32x2*)(xp + 256 * j); } \
        if (O) { const bf16_t* op = O + (size_t)_r * DM + 4 * lane; _Pragma("unroll") for (int j = 0; j < 4; ++j) ob[j] = *(const u32x2*)(op + 256 * j); } } while (0)
    RP_LOAD(gw);
    for (int row = gw; row < T_TOK; row += nw) {
        f32x4 v[4], o[4];
#pragma unroll
        for (int j = 0; j < 4; ++j) { if (xres_f) { v[j].x = __uint_as_float(xf[j].x); v[j].y = __uint_as_float(xf[j].y); v[j].z = __uint_as_float(xf[j].z); v[j].w = __uint_as_float(xf[j].w); } else v[j] = bf4(xb[j]);
            if (O) o[j] = bf4(ob[j]); }
        RP_LOAD(row + nw);
        if (O) {
            float ss = 0.f;
#pragma unroll
            for (int j = 0; j < 4; ++j) ss += hsum4(o[j] * o[j]);
            const float inv = rsqrtf(red64(ss) * (1.f / DM) + 1e-6f);
#pragma unroll
            for (int j = 0; j < 4; ++j) v[j] = v[j] + o[j] * inv * g1v[j];
            if (xout_f) { f32x4* xo = (f32x4*)(xout_f + (size_t)row * DM) + lane;
#pragma unroll
                for (int j = 0; j < 4; ++j) xo[64 * j] = v[j]; }
            else { bf16_t* xo = xout_b + (size_t)row * DM + 4 * lane;
#pragma unroll
                for (int j = 0; j < 4; ++j) st4bf(xo + 256 * j, v[j]); }
        }
        if (g2) {
            float ss = 0.f;
#pragma unroll
            for (int j = 0; j < 4; ++j) ss += hsum4(v[j] * v[j]);
            const float inv = rsqrtf(red64(ss) * (1.f / DM) + 1e-6f);
            bf16_t* hp = hb + (size_t)row * DM;
#pragma unroll
            for (int j = 0; j < 4; ++j) st4bf(hp + 4 * (lane + 64 * j), v[j] * inv * g2v[j]);
        }
    }
#undef RP_LOAD
}

__device__ __forceinline__ void phase_prepass(const Params& p, int l, const XcdBarrier& xbar, int wv) {
    const int tid = otid(wv); const int lane = tid & 63, gw = blockIdx.x * 8 + (tid >> 6);
    bf16_t* U = (bf16_t*)(p.ws + WS_U); float* G = (float*)(p.ws + WS_G); bf16_t* A2 = (bf16_t*)(p.ws + WS_A2);
    const int tok0 = gw * 16, t0 = tok0 & (SEQ - 1), c = 4 * lane;
    const u32x2 zz = (u32x2){0u, 0u};
    u32x2 rq[19], rk[19], rv[19];
#pragma unroll
    for (int i = 0; i < 19; ++i) { const int ts = t0 - 2 + i; const bool ok = (ts >= 0 && ts < SEQ) && gw < 2048;
        const bf16_t* up = U + (size_t)(ok ? tok0 - 2 + i : 0) * NU + 512 + c;
        rq[i] = ok ? *(const u32x2*)up : zz; rk[i] = ok ? *(const u32x2*)(up + 256) : zz; rv[i] = ok ? *(const u32x2*)(up + 512) : zz; }
    xcd_barrier(xbar, wv);
    if (gw >= 2048) return;
    {
        const float* cw = pin(p, 12) + (size_t)l * 4 * 768 + c;
        f32x4 wq[4], wk[4], wv[4];
#pragma unroll
        for (int j = 0; j < 4; ++j) { wq[j] = *(const f32x4*)(cw + j * 768); wk[j] = *(const f32x4*)(cw + j * 768 + 256); wv[j] = *(const f32x4*)(cw + j * 768 + 512); }
#pragma unroll
        for (int i = 0; i < 16; ++i) {
            f32x4 aq = (f32x4){0.f, 0.f, 0.f, 0.f}, ak = aq, av = aq;
#pragma unroll
            for (int j = 0; j < 4; ++j) { aq += wq[j] * bf4(rq[i + j]); ak += wk[j] * bf4(rk[i + j]); av += wv[j] * bf4(rv[i + j]); }
#pragma unroll
            for (int e = 0; e < 4; ++e) { aq[e] = siluf_(aq[e]); ak[e] = siluf_(ak[e]); av[e] = siluf_(av[e]); }
            const float sq = red16(hsum4(aq * aq)), sk = red16(hsum4(ak * ak));
            aq = aq * (rsqrtf(sq + 1e-6f) * 0.125f); ak = ak * rsqrtf(sk + 1e-6f);
            bf16_t* up = U + (size_t)(tok0 + i) * NU + 512 + c;
            st4bf(up, aq); st4bf(up + 256, ak); st4bf(up + 512, av);
        }
    }
    __builtin_amdgcn_sched_barrier(0);
    {
        f32x4 cwv[4];
#pragma unroll
        for (int j = 0; j < 4; ++j) cwv[j] = *(const f32x4*)(pin(p, 7) + (size_t)l * 1024 + j * 256 + c);
        const f32x4 cb = *(const f32x4*)(pin(p, 8) + (size_t)l * 256 + c);
#pragma unroll
        for (int hh = 0; hh < 2; ++hh) {
            u32x2 rx[11];
#pragma unroll
            for (int i = 0; i < 11; ++i) { const int ts = t0 + hh * 8 - 2 + i; rx[i] = (ts >= 0 && ts < SEQ) ? *(const u32x2*)(U + (size_t)(tok0 + hh * 8 - 2 + i) * NU + c) : zz; }
#pragma unroll
            for (int i = 0; i < 8; ++i) { f32x4 xc = cb;
#pragma unroll
                for (int j = 0; j < 4; ++j) xc += cwv[j] * bf4(rx[i + j]);
                st4bf(A2 + (size_t)(tok0 + hh * 8 + i) * 384 + c, xc); }
        }
    }
    __builtin_amdgcn_sched_barrier(0);
    {
        const int ti = lane >> 2, kind = lane & 3;
        float* gp = G + (size_t)(tok0 + ti) * NGATE + kind * 8;
        f32x4 v0 = *(const f32x4*)gp, v1 = *(const f32x4*)(gp + 4);
        float v[8] = {v0.x, v0.y, v0.z, v0.w, v1.x, v1.y, v1.z, v1.w};
#pragma unroll
        for (int e = 0; e < 8; ++e) {
            if (kind == 0) v[e] = __expf(-__expf(pin(p, 13)[l * 8 + e]) * softplusf_(v[e] + pin(p, 14)[l * 8 + e]));
            else if (kind == 1) v[e] = sigmoidf_(v[e]);
            else if (kind == 2) v[e] = __expf(15.f * tanhf_((v[e] + pin(p, 16)[l * 16 + (e >> 2) * 8 + (e & 3)]) * (1.f / 15.f)));
            else v[e] = sigmoidf_(15.f * tanhf_((v[e] + pin(p, 16)[l * 16 + (e >> 2) * 8 + 4 + (e & 3)]) * (1.f / 15.f)));
        }
        *(f32x4*)gp = (f32x4){v[0], v[1], v[2], v[3]}; *(f32x4*)(gp + 4) = (f32x4){v[4], v[5], v[6], v[7]};
    }
    __builtin_amdgcn_sched_barrier(0);
    if (lane < 32) {
        const float* mu0 = pin(p, 18) + (size_t)l * 2 * 960; const float* mu1 = mu0 + 960;
        const int lc = lane * 4;
        const f32x4 ml0 = *(const f32x4*)(mu0 + 768 + lc), ml1 = *(const f32x4*)(mu1 + 768 + lc);
        const f32x4 z4 = (f32x4){0.f, 0.f, 0.f, 0.f};
#pragma unroll
        for (int hh = 0; hh < 2; ++hh) {
            f32x4 gr[10];
#pragma unroll
            for (int i = 0; i < 10; ++i) { const int ts = t0 + hh * 8 - 1 + i; gr[i] = (ts >= 0 && ts < SEQ) ? *(const f32x4*)(G + (size_t)(tok0 + hh * 8 - 1 + i) * NGATE + 32 + lc) : z4; }
#pragma unroll
            for (int i = 0; i < 8; ++i) { const f32x4 cur = gr[i + 1]; f32x4 lr = cur + ml0 * (gr[i] - cur) + ml1 * (gr[i + 2] - cur);
                if (lane < 16) { lr.x = tanhf_(lr.x); lr.y = tanhf_(lr.y); lr.z = tanhf_(lr.z); lr.w = tanhf_(lr.w); }
                st4bf(A2 + (size_t)(tok0 + hh * 8 + i) * 384 + 256 + lc, lr); }
        }
    }
}

constexpr int TT = 32, NTILE = SEQ / TT, TS = TT * 64;
__device__ __forceinline__ float sum8l(float x) { x += dppf<0xB1>(x); x += dppf<0x4E>(x); x += dppf<0x141>(x); return x; }
#define TILE_T0(i) ((dir ? NTILE - 1 - (i) : (i)) * TT)

template <int DIRC> __device__ __forceinline__ void gdn_task(const Params& p, int l, int b, int h, LAS float* sm, int wv) {
    constexpr int dir = DIRC;
    constexpr int BUF = 3 * TS + 64;
    const int tid = otid(wv), wave = tid >> 6, lane = tid & 63;
    LAS float* Os0 = sm + 2 * BUF;
    const bf16_t* U = (const bf16_t*)(p.ws + WS_U); const float* G = (const float*)(p.ws + WS_G); bf16_t* SC = (bf16_t*)(p.ws + WS_SC);
    const int ptid = tid - 256, pt = (ptid >> 4) & 15, c4 = (ptid & 15) * 4;
    const int row = (wave & 3) * 16 + (lane >> 2), sub = lane & 3;
    f32x4 s4[4];
#pragma unroll
    for (int j = 0; j < 4; ++j) s4[j] = (f32x4){0.f, 0.f, 0.f, 0.f};
    u32x2 rq[2], rk[2], rv[2]; float gbp[2]; float ga = 0.f, gb = 0.f;
#define GDN_LOADRAW(T0) do { _Pragma("unroll") for (int hh = 0; hh < 2; ++hh) { const size_t tok = (size_t)(b * SEQ + (T0) + pt + 16 * hh); const bf16_t* up = U + tok * NU + 512 + h * 64 + c4; \
            rq[hh] = *(const u32x2*)up; rk[hh] = *(const u32x2*)(up + 256); rv[hh] = *(const u32x2*)(up + 512); gbp[hh] = G[tok * NGATE + 8 + dir * 4 + h]; } \
        if (ptid < TT) { const float* gp = G + (size_t)(b * SEQ + (T0) + ptid) * NGATE; ga = gp[dir * 4 + h]; gb = gp[8 + dir * 4 + h]; } } while (0)
#define GDN_PREP(BI) do { LAS float* Qs = sm + (BI) * BUF; _Pragma("unroll") for (int hh = 0; hh < 2; ++hh) { const int o = (pt + 16 * hh) * 64 + c4; \
            *(LAS f32x4*)(Qs + o) = bf4(rq[hh]); *(LAS f32x4*)(Qs + TS + o) = bf4(rk[hh]); *(LAS f32x4*)(Qs + 2 * TS + o) = bf4(rv[hh]) * gbp[hh]; } \
        if (ptid < TT) { Qs[3 * TS + ptid * 2] = ga; Qs[3 * TS + ptid * 2 + 1] = gb * ga; } } while (0)
#define GDN_WRITEOUT(T0, BI) do { _Pragma("unroll") for (int hh = 0; hh < 2; ++hh) \
        st4bf(SC + (size_t)(b * SEQ + (T0) + pt + 16 * hh) * NSC + 512 + dir * 256 + h * 64 + c4, *(const LAS f32x4*)(Os0 + (BI) * TS + (pt + 16 * hh) * 64 + c4)); } while (0)
    if (wave >= 4) { GDN_LOADRAW(TILE_T0(0)); GDN_PREP(0); GDN_LOADRAW(TILE_T0(1)); }
    __syncthreads();
    for (int kt = 0; kt < NTILE; ++kt) {
        const int cur = kt & 1;
        if (wave < 4) {
            const LAS float* Qs = sm + cur * BUF; const LAS float* Ks = Qs + TS; const LAS float* Vs = Qs + 2 * TS; const LAS float* AB = Qs + 3 * TS; LAS float* Os = Os0 + cur * TS;
            f32x4 kA[4], qA[4], kB[4], qB[4]; float aA, bA, vA, aB, bB, vB;
#define GDN_LD(K_, Q_, A_, B_, V_, I_) do { const int _i = (I_) < TT ? (I_) : TT - 1; const int _tt = dir ? TT - 1 - _i : _i; const LAS float* kp = Ks + _tt * 64 + 4 * sub; const LAS float* qp = Qs + _tt * 64 + 4 * sub; \
        _Pragma("unroll") for (int j = 0; j < 4; ++j) { K_[j] = *(const LAS f32x4*)(kp + 16 * j); Q_[j] = *(const LAS f32x4*)(qp + 16 * j); } \
        A_ = AB[_tt * 2]; B_ = AB[_tt * 2 + 1]; V_ = Vs[_tt * 64 + row]; } while (0)
#define GDN_STEP(K_, Q_, A_, B_, V_, U_) do { f32x4 d4 = s4[0] * K_[0]; d4 += s4[1] * K_[1]; d4 += s4[2] * K_[2]; d4 += s4[3] * K_[3]; \
        const float d = sum4l(hsum4(d4)); const float c = V_ - B_ * d; \
        _Pragma("unroll") for (int j = 0; j < 4; ++j) s4[j] = s4[j] * A_ + K_[j] * c; \
        f32x4 o4 = s4[0] * Q_[0]; o4 += s4[1] * Q_[1]; o4 += s4[2] * Q_[2]; o4 += s4[3] * Q_[3]; \
        const float o = sum4l(hsum4(o4)); okeep = (sub == (U_)) ? o : okeep; } while (0)
            GDN_LD(kA, qA, aA, bA, vA, 0);
            for (int gq = 0; gq < TT / 4; ++gq) {
                float okeep = 0.f; const int i0 = gq * 4;
                GDN_LD(kB, qB, aB, bB, vB, i0 + 1); GDN_STEP(kA, qA, aA, bA, vA, 0);
                GDN_LD(kA, qA, aA, bA, vA, i0 + 2); GDN_STEP(kB, qB, aB, bB, vB, 1);
                GDN_LD(kB, qB, aB, bB, vB, i0 + 3); GDN_STEP(kA, qA, aA, bA, vA, 2);
                GDN_LD(kA, qA, aA, bA, vA, i0 + 4); GDN_STEP(kB, qB, aB, bB, vB, 3);
                const int is = i0 + sub, tts = dir ? TT - 1 - is : is;
                Os[tts * 64 + row] = okeep;
            }
#undef GDN_LD
#undef GDN_STEP
        } else {
            if (kt > 0) GDN_WRITEOUT(TILE_T0(kt - 1), cur ^ 1);
            if (kt + 1 < NTILE) GDN_PREP(cur ^ 1);
            if (kt + 2 < NTILE) GDN_LOADRAW(TILE_T0(kt + 2));
        }
        __syncthreads();
    }
    if (wave >= 4) GDN_WRITEOUT(TILE_T0(NTILE - 1), (NTILE - 1) & 1);
#undef GDN_LOADRAW
#undef GDN_PREP
#undef GDN_WRITEOUT
    __syncthreads();
}

template <int DIRC> __device__ __forceinline__ void mlstm_task(const Params& p, int l, int b, int h, LAS float* sm, int wv) {
    constexpr int dir = DIRC;
    constexpr int BUF = 3 * TS + 64;
    const int tid = otid(wv), wave = tid >> 6, lane = tid & 63;
    LAS float* Os0 = sm + 2 * BUF; LAS float* Dn0 = Os0 + 2 * TS; LAS float* LA0 = Dn0 + 2 * TS; LAS float* LB0 = LA0 + 2 * TS;
    const bf16_t* U = (const bf16_t*)(p.ws + WS_U); const float* G = (const float*)(p.ws + WS_G); bf16_t* SC = (bf16_t*)(p.ws + WS_SC); const bf16_t* ACT = (const bf16_t*)(p.ws + WS_ACT);
    const int ptid = tid - 384, pt = (ptid >> 4) & 7, c4 = (ptid & 15) * 4;
    const int row = (wave & 3) * 16 + (lane >> 2), sub = lane & 3;
    const int lr8 = lane >> 3, lc8 = (lane & 7) * 8;
    constexpr int NQ = TT / 8;
    f32x4 s4[4];
#pragma unroll
    for (int j = 0; j < 4; ++j) s4[j] = (f32x4){0.f, 0.f, 0.f, 0.f};
    float nst = 0.f, hst = 0.f;
    u32x2 rq[4], rk[4], rv[4]; float gip[4]; float gi = 0.f, gf = 0.f; u32x4 la4[NQ], lb4[NQ];
#define ML_LOADRAW(T0) do { _Pragma("unroll") for (int hh = 0; hh < 4; ++hh) { const size_t tok = (size_t)(b * SEQ + (T0) + pt + 8 * hh); const bf16_t* up = U + tok * NU + 1536 + h * 64 + c4; \
            rq[hh] = *(const u32x2*)up; rk[hh] = *(const u32x2*)(up + 256); rv[hh] = *(const u32x2*)(up + 512); gip[hh] = G[tok * NGATE + 16 + dir * 4 + h]; } \
        if (ptid < TT) { const float* gp = G + (size_t)(b * SEQ + (T0) + ptid) * NGATE + 16; gi = gp[dir * 4 + h]; gf = gp[8 + dir * 4 + h]; } } while (0)
#define ML_PREP(BI) do { LAS float* Qs = sm + (BI) * BUF; _Pragma("unroll") for (int hh = 0; hh < 4; ++hh) { const int o = (pt + 8 * hh) * 64 + c4; \
            *(LAS f32x4*)(Qs + o) = bf4(rq[hh]); *(LAS f32x4*)(Qs + TS + o) = bf4(rk[hh]) * 0.125f; *(LAS f32x4*)(Qs + 2 * TS + o) = bf4(rv[hh]) * gip[hh]; } \
        if (ptid < TT) { Qs[3 * TS + ptid * 2] = gf; Qs[3 * TS + ptid * 2 + 1] = gi; } } while (0)
#define ML_WRITEOUT(T0, BI) do { _Pragma("unroll") for (int hh = 0; hh < 4; ++hh) { const int o = (pt + 8 * hh) * 64 + c4; \
            const float den = red16(hsum4(*(const LAS f32x4*)(Dn0 + (BI) * TS + o))); const float sc = __builtin_amdgcn_rcpf(fmaxf(fabsf(den), 1.f)); \
            st4bf(SC + (size_t)(b * SEQ + (T0) + pt + 8 * hh) * NSC + 1024 + dir * 256 + h * 64 + c4, *(const LAS f32x4*)(Os0 + (BI) * TS + o) * sc); } } while (0)
#define LRU_LOADRAW(T0) do { _Pragma("unroll") for (int q = 0; q < NQ; ++q) { const size_t tok = (size_t)(b * SEQ + (T0) + q * 8 + lr8); \
            la4[q] = *(const u32x4*)(ACT + tok * DM + dir * 256 + h * 64 + lc8); lb4[q] = *(const u32x4*)(SC + tok * NSC + dir * 256 + h * 64 + lc8); } } while (0)
#define LRU_PREP(BI) do { _Pragma("unroll") for (int q = 0; q < NQ; ++q) { const int o = (BI) * TS + (q * 8 + lr8) * 64 + lc8; \
            f32x4 a0 = bf4((u32x2){la4[q].x, la4[q].y}), a1 = bf4((u32x2){la4[q].z, la4[q].w}); \
            _Pragma("unroll") for (int e = 0; e < 4; ++e) { a0[e] = 1.f - a0[e]; a1[e] = 1.f - a1[e]; } \
            *(LAS f32x4*)(LA0 + o) = a0; *(LAS f32x4*)(LA0 + o + 4) = a1; \
            *(LAS f32x4*)(LB0 + o) = bf4((u32x2){lb4[q].x, lb4[q].y}); *(LAS f32x4*)(LB0 + o + 4) = bf4((u32x2){lb4[q].z, lb4[q].w}); } } while (0)
#define LRU_WRITEOUT(T0, BI) do { _Pragma("unroll") for (int q = 0; q < NQ; ++q) { const int o = (BI) * TS + (q * 8 + lr8) * 64 + lc8; const f32x4 h0 = *(const LAS f32x4*)(LA0 + o), h1 = *(const LAS f32x4*)(LA0 + o + 4); \
            u32x4 w; w.x = pk2(h0.x, h0.y); w.y = pk2(h0.z, h0.w); w.z = pk2(h1.x, h1.y); w.w = pk2(h1.z, h1.w); \
            *(u32x4*)(SC + (size_t)(b * SEQ + (T0) + q * 8 + lr8) * NSC + dir * 256 + h * 64 + lc8) = w; } } while (0)
    if (wave >= 6) { ML_LOADRAW(TILE_T0(0)); ML_PREP(0); ML_LOADRAW(TILE_T0(1)); }
    else if (wave == 5) { LRU_LOADRAW(TILE_T0(0)); LRU_PREP(0); LRU_LOADRAW(TILE_T0(1)); }
    __syncthreads();
    for (int kt = 0; kt < NTILE; ++kt) {
        const int cur = kt & 1;
        const LAS float* Qs = sm + cur * BUF; const LAS float* Ks = Qs + TS; const LAS float* Vs = Qs + 2 * TS; const LAS float* FI = Qs + 3 * TS;
        if (wave < 4) {
            LAS float* Os = Os0 + cur * TS;
            f32x4 kA[4], qA[4], kB[4], qB[4]; float fA, vA, fB, vB;
#define ML_LD(K_, Q_, F_, V_, I_) do { const int _i = (I_) < TT ? (I_) : TT - 1; const int _tt = dir ? TT - 1 - _i : _i; const LAS float* kp = Ks + _tt * 64 + 4 * sub; const LAS float* qp = Qs + _tt * 64 + 4 * sub; \
        _Pragma("unroll") for (int j = 0; j < 4; ++j) { K_[j] = *(const LAS f32x4*)(kp + 16 * j); Q_[j] = *(const LAS f32x4*)(qp + 16 * j); } \
        F_ = FI[_tt * 2]; V_ = Vs[_tt * 64 + row]; } while (0)
#define ML_STEP(K_, Q_, F_, V_, U_) do { _Pragma("unroll") for (int j = 0; j < 4; ++j) s4[j] = s4[j] * F_ + K_[j] * V_; \
        f32x4 o4 = s4[0] * Q_[0]; o4 += s4[1] * Q_[1]; o4 += s4[2] * Q_[2]; o4 += s4[3] * Q_[3]; \
        const float o = sum4l(hsum4(o4)); okeep = (sub == (U_)) ? o : okeep; } while (0)
            ML_LD(kA, qA, fA, vA, 0);
            for (int gq = 0; gq < TT / 4; ++gq) {
                float okeep = 0.f; const int i0 = gq * 4;
                ML_LD(kB, qB, fB, vB, i0 + 1); ML_STEP(kA, qA, fA, vA, 0);
                ML_LD(kA, qA, fA, vA, i0 + 2); ML_STEP(kB, qB, fB, vB, 1);
                ML_LD(kB, qB, fB, vB, i0 + 3); ML_STEP(kA, qA, fA, vA, 2);
                ML_LD(kA, qA, fA, vA, i0 + 4); ML_STEP(kB, qB, fB, vB, 3);
                const int is = i0 + sub, tts = dir ? TT - 1 - is : is;
                Os[tts * 64 + row] = okeep;
            }
#undef ML_LD
#undef ML_STEP
        } else if (wave == 4) {
            LAS float* Dn = Dn0 + cur * TS;
#pragma unroll 8
            for (int i = 0; i < TT; ++i) { const int tt = dir ? TT - 1 - i : i;
                nst = nst * FI[tt * 2] + FI[tt * 2 + 1] * Ks[tt * 64 + lane];
                Dn[tt * 64 + lane] = nst * Qs[tt * 64 + lane]; }
        } else if (wave == 5) {
            if (kt > 0) LRU_WRITEOUT(TILE_T0(kt - 1), cur ^ 1);
            if (kt + 1 < NTILE) LRU_PREP(cur ^ 1);
            if (kt + 2 < NTILE) LRU_LOADRAW(TILE_T0(kt + 2));
            LAS float* LA = LA0 + cur * TS; const LAS float* LB = LB0 + cur * TS;
#pragma unroll 8
            for (int i = 0; i < TT; ++i) { const int tt = dir ? TT - 1 - i : i; hst = LA[tt * 64 + lane] * hst + LB[tt * 64 + lane]; LA[tt * 64 + lane] = hst; }
        } else {
            if (kt > 0) ML_WRITEOUT(TILE_T0(kt - 1), cur ^ 1);
            if (kt + 1 < NTILE) ML_PREP(cur ^ 1);
            if (kt + 2 < NTILE) ML_LOADRAW(TILE_T0(kt + 2));
        }
        __syncthreads();
    }
    if (wave >= 6) ML_WRITEOUT(TILE_T0(NTILE - 1), (NTILE - 1) & 1);
    else if (wave == 5) LRU_WRITEOUT(TILE_T0(NTILE - 1), (NTILE - 1) & 1);
#undef ML_LOADRAW
#undef ML_PREP
#undef ML_WRITEOUT
#undef LRU_LOADRAW
#undef LRU_PREP
#undef LRU_WRITEOUT
    __syncthreads();
}

template <int DIRC> __device__ __forceinline__ void rwkv_task(const Params& p, int l, int b, int h, int half, LAS float* sm, int wv) {
    constexpr int dir = DIRC;
    constexpr int BUF = 6 * TS;
    const int tid = otid(wv), wave = tid >> 6, lane = tid & 63;
    LAS float* Os0 = sm + 2 * BUF;
    const bf16_t* U = (const bf16_t*)(p.ws + WS_U); const bf16_t* Gb = (const bf16_t*)(p.ws + WS_G); bf16_t* SC = (bf16_t*)(p.ws + WS_SC); const bf16_t* ACT = (const bf16_t*)(p.ws + WS_ACT);
    const int ptid = tid - 256, pt = (ptid >> 4) & 15, c4 = (ptid & 15) * 4, hc = h * 64 + c4;
    const float* mu0 = pin(p, 18) + (size_t)l * 2 * 960; const float* mu1 = mu0 + 960;
    const f32x4 mr0 = *(const f32x4*)(mu0 + hc), mr1 = *(const f32x4*)(mu1 + hc), mk0 = *(const f32x4*)(mu0 + 256 + hc), mk1 = *(const f32x4*)(mu1 + 256 + hc),
                mv0 = *(const f32x4*)(mu0 + 512 + hc), mv1 = *(const f32x4*)(mu1 + 512 + hc);
    const f32x4 kkv = *(const f32x4*)(pin(p, 24) + (size_t)l * 256 + hc), kav = *(const f32x4*)(pin(p, 25) + (size_t)l * 256 + hc);
    const int row = half * 32 + (wave & 3) * 8 + (lane >> 3), sub = lane & 7;
    f32x4 s4[2];
    s4[0] = (f32x4){0.f, 0.f, 0.f, 0.f}; s4[1] = s4[0];
    const u32x2 zz = (u32x2){0u, 0u};
    u32x2 rc[2], rp[2], rn[2], kc[2], kp_[2], kn[2], vc[2], vp[2], vn[2], ew[2], aa[2];
#define RW_LOADRAW(T0) do { _Pragma("unroll") for (int hh = 0; hh < 2; ++hh) { const int _t = (T0) + pt + 16 * hh; const bool hp = _t > 0, hn = _t < SEQ - 1; const size_t tok = (size_t)(b * SEQ + _t); \
        const bf16_t* up = U + tok * NU + 2560 + hc; \
        rc[hh] = *(const u32x2*)up; rp[hh] = hp ? *(const u32x2*)(up - NU) : zz; rn[hh] = hn ? *(const u32x2*)(up + NU) : zz; \
        kc[hh] = *(const u32x2*)(up + 256); kp_[hh] = hp ? *(const u32x2*)(up + 256 - NU) : zz; kn[hh] = hn ? *(const u32x2*)(up + 256 + NU) : zz; \
        vc[hh] = *(const u32x2*)(up + 512); vp[hh] = hp ? *(const u32x2*)(up + 512 - NU) : zz; vn[hh] = hn ? *(const u32x2*)(up + 512 + NU) : zz; \
        ew[hh] = dir ? *(const u32x2*)(Gb + tok * 512 + 64 + hc) : *(const u32x2*)(U + tok * NU + hc); \
        aa[hh] = *(const u32x2*)(ACT + tok * DM + 512 + dir * 256 + hc); } } while (0)
#define RW_PREP(BI) do { LAS float* Rs = sm + (BI) * BUF; _Pragma("unroll") for (int hh = 0; hh < 2; ++hh) { \
            f32x4 c = bf4(rc[hh]); const f32x4 rr = c + mr0 * (bf4(rp[hh]) - c) + mr1 * (bf4(rn[hh]) - c); \
            c = bf4(kc[hh]); const f32x4 kk = c + mk0 * (bf4(kp_[hh]) - c) + mk1 * (bf4(kn[hh]) - c); \
            c = bf4(vc[hh]); const f32x4 vv = c + mv0 * (bf4(vp[hh]) - c) + mv1 * (bf4(vn[hh]) - c); \
            f32x4 w = bf4(ew[hh]); const f32x4 a = bf4(aa[hh]); \
            _Pragma("unroll") for (int e = 0; e < 4; ++e) w[e] = __expf(w[e]); \
            f32x4 kn_ = kk * kkv; const float ss = red16(hsum4(kn_ * kn_)); kn_ = kn_ * rsqrtf(ss + 1e-6f); \
            const int o = (pt + 16 * hh) * 64 + c4; \
            *(LAS f32x4*)(Rs + o) = rr; *(LAS f32x4*)(Rs + TS + o) = w; *(LAS f32x4*)(Rs + 2 * TS + o) = kn_; \
            *(LAS f32x4*)(Rs + 3 * TS + o) = kn_ * a; *(LAS f32x4*)(Rs + 4 * TS + o) = kk * (1.f + (a - 1.f) * kav); *(LAS f32x4*)(Rs + 5 * TS + o) = vv; } } while (0)
#define RW_WRITEOUT(T0, BI) do { const int t = (ptid >> 3) & 31, r4 = half * 32 + (ptid & 7) * 4; const f32x4 o = *(const LAS f32x4*)(Os0 + (BI) * TS + t * 64 + r4); \
        u32x2 w; w.x = pk2(o.x, o.y); w.y = pk2(o.z, o.w); *(u32x2*)(SC + (size_t)(b * SEQ + (T0) + t) * NSC + 1536 + dir * 256 + h * 64 + r4) = w; } while (0)
    if (wave >= 4) { RW_LOADRAW(TILE_T0(0)); RW_PREP(0); RW_LOADRAW(TILE_T0(1)); }
    __syncthreads();
    for (int kt = 0; kt < NTILE; ++kt) {
        const int cur = kt & 1;
        if (wave < 4) {
            const LAS float* Rs = sm + cur * BUF; const LAS float* Ws = Rs + TS; const LAS float* KKs = Rs + 2 * TS; const LAS float* KAs = Rs + 3 * TS; const LAS float* KDs = Rs + 4 * TS; const LAS float* Vs = Rs + 5 * TS;
            LAS float* Os = Os0 + cur * TS;
            f32x4 wA[2], nA[2], aA[2], dA[2], rA[2], wB[2], nB[2], aB[2], dB[2], rB[2]; float vA, vB;
#define RW_LD(W_, N_, A_, D_, R_, V_, I_) do { const int _i = (I_) < TT ? (I_) : TT - 1; const int _tt = dir ? TT - 1 - _i : _i; const int o = _tt * 64 + 4 * sub; \
        _Pragma("unroll") for (int j = 0; j < 2; ++j) { W_[j] = *(const LAS f32x4*)(Ws + o + 32 * j); N_[j] = *(const LAS f32x4*)(KKs + o + 32 * j); A_[j] = *(const LAS f32x4*)(KAs + o + 32 * j); \
            D_[j] = *(const LAS f32x4*)(KDs + o + 32 * j); R_[j] = *(const LAS f32x4*)(Rs + o + 32 * j); } \
        V_ = Vs[_tt * 64 + row]; } while (0)
#define RW_STEP(W_, N_, A_, D_, R_, V_, U_) do { f32x4 x4 = s4[0] * N_[0]; x4 += s4[1] * N_[1]; const float sa = -sum8l(hsum4(x4)); \
        _Pragma("unroll") for (int j = 0; j < 2; ++j) s4[j] = s4[j] * W_[j] + A_[j] * sa + D_[j] * V_; \
        f32x4 o4 = s4[0] * R_[0]; o4 += s4[1] * R_[1]; const float o = sum8l(hsum4(o4)); okeep = (sub == (U_)) ? o : okeep; } while (0)
            RW_LD(wA, nA, aA, dA, rA, vA, 0);
            for (int gq = 0; gq < TT / 8; ++gq) {
                float okeep = 0.f; const int i0 = gq * 8;
                RW_LD(wB, nB, aB, dB, rB, vB, i0 + 1); RW_STEP(wA, nA, aA, dA, rA, vA, 0);
                RW_LD(wA, nA, aA, dA, rA, vA, i0 + 2); RW_STEP(wB, nB, aB, dB, rB, vB, 1);
                RW_LD(wB, nB, aB, dB, rB, vB, i0 + 3); RW_STEP(wA, nA, aA, dA, rA, vA, 2);
                RW_LD(wA, nA, aA, dA, rA, vA, i0 + 4); RW_STEP(wB, nB, aB, dB, rB, vB, 3);
                RW_LD(wB, nB, aB, dB, rB, vB, i0 + 5); RW_STEP(wA, nA, aA, dA, rA, vA, 4);
                RW_LD(wA, nA, aA, dA, rA, vA, i0 + 6); RW_STEP(wB, nB, aB, dB, rB, vB, 5);
                RW_LD(wB, nB, aB, dB, rB, vB, i0 + 7); RW_STEP(wA, nA, aA, dA, rA, vA, 6);
                RW_LD(wA, nA, aA, dA, rA, vA, i0 + 8); RW_STEP(wB, nB, aB, dB, rB, vB, 7);
                const int is = i0 + sub, tts = dir ? TT - 1 - is : is;
                Os[tts * 64 + row] = okeep;
            }
#undef RW_LD
#undef RW_STEP
        } else {
            if (kt > 0) RW_WRITEOUT(TILE_T0(kt - 1), cur ^ 1);
            if (kt + 1 < NTILE) RW_PREP(cur ^ 1);
            if (kt + 2 < NTILE) RW_LOADRAW(TILE_T0(kt + 2));
        }
        __syncthreads();
    }
    if (wave >= 4) RW_WRITEOUT(TILE_T0(NTILE - 1), (NTILE - 1) & 1);
#undef RW_LOADRAW
#undef RW_PREP
#undef RW_WRITEOUT
    __syncthreads();
}

__device__ __forceinline__ void phase_scan(const Params& p, int l, LAS float* sm, int wv) {
    for (int task = blockIdx.x; task < 256; task += gridDim.x) {
        if (DBG_PROBE && otid(wv) == 0) ((LAS unsigned*)sm)[32760] = (unsigned)__builtin_amdgcn_s_memrealtime();
        if (task < 128) { const int half = task & 1, rest = task >> 1; if ((rest >> 3) & 1) rwkv_task<1>(p, l, rest & 7, rest >> 4, half, sm, wv); else rwkv_task<0>(p, l, rest & 7, rest >> 4, half, sm, wv); }
        else if (task < 192) { const int rest = task - 128; if ((rest >> 3) & 1) gdn_task<1>(p, l, rest & 7, rest >> 4, sm, wv); else gdn_task<0>(p, l, rest & 7, rest >> 4, sm, wv); }
        else { const int rest = task - 192; if ((rest >> 3) & 1) mlstm_task<1>(p, l, rest & 7, rest >> 4, sm, wv); else mlstm_task<0>(p, l, rest & 7, rest >> 4, sm, wv); }
        if (DBG_PROBE && l == 0 && otid(wv) == 0) { const unsigned dt = (unsigned)__builtin_amdgcn_s_memrealtime() - ((LAS unsigned*)sm)[32760]; atomicMax((unsigned*)(p.ws + WS_DBG) + (task < 128 ? 1 : (task < 192 ? 2 : 3)), dt); }
    }
}

struct FinRaw { u32x2 s[8], yb, z, og, r[3], k[3], v[3]; float g[3]; };
__device__ __forceinline__ void fin_load(FinRaw& R, const bf16_t* U, const float* G, const bf16_t* SC, int tok, int c, int lane) {
    const int t = tok & (SEQ - 1); const bool hp = t > 0, hn = t < SEQ - 1; const u32x2 zz = (u32x2){0u, 0u};
    const bf16_t* u = U + (size_t)tok * NU; const bf16_t* sc = SC + (size_t)tok * NSC;
#pragma unroll
    for (int i = 0; i < 8; ++i) R.s[i] = *(const u32x2*)(sc + i * 256 + c);
    R.yb = *(const u32x2*)(u + 256 + c); R.z = *(const u32x2*)(u + 1280 + c); R.og = *(const u32x2*)(u + 2304 + c);
    const bf16_t* up = u + 2560 + c;
    R.r[0] = *(const u32x2*)up; R.r[1] = hp ? *(const u32x2*)(up - NU) : zz; R.r[2] = hn ? *(const u32x2*)(up + NU) : zz;
    R.k[0] = *(const u32x2*)(up + 256); R.k[1] = hp ? *(const u32x2*)(up + 256 - NU) : zz; R.k[2] = hn ? *(const u32x2*)(up + 256 + NU) : zz;
    R.v[0] = *(const u32x2*)(up + 512); R.v[1] = hp ? *(const u32x2*)(up + 512 - NU) : zz; R.v[2] = hn ? *(const u32x2*)(up + 512 + NU) : zz;
    const float* gp = G + (size_t)tok * NGATE + 160 + lane;
    R.g[0] = gp[0]; R.g[1] = hp ? gp[-NGATE] : 0.f; R.g[2] = hn ? gp[NGATE] : 0.f;
}
__device__ __forceinline__ void phase_finalize(const Params& p, int l, LAS float* sm, int wv) {
    const int tid = otid(wv), lane = tid & 63, wave = tid >> 6;
    LAS float* GUP = sm;
    LAS float* SG = sm + 16384 + wave * 128;
    for (int i = tid; i < 16384; i += 512) GUP[i] = pin(p, 23)[(size_t)l * 16384 + i];
    __syncthreads();
    const bf16_t* U = (const bf16_t*)(p.ws + WS_U); const float* G = (const float*)(p.ws + WS_G); const bf16_t* SC = (const bf16_t*)(p.ws + WS_SC); bf16_t* Y = (bf16_t*)(p.ws + WS_ACT);
    const int c = lane * 4, hc = c & 63;
    const f32x4 gdn_g = *(const f32x4*)(pin(p, 15) + (size_t)l * 64 + hc), ml_g = *(const f32x4*)(pin(p, 17) + (size_t)l * 256 + c);
    const float* mu0 = pin(p, 18) + (size_t)l * 2 * 960; const float* mu1 = mu0 + 960;
    const f32x4 mr0 = *(const f32x4*)(mu0 + c), mr1 = *(const f32x4*)(mu1 + c), mk0 = *(const f32x4*)(mu0 + 256 + c), mk1 = *(const f32x4*)(mu1 + 256 + c),
                mv0 = *(const f32x4*)(mu0 + 512 + c), mv1 = *(const f32x4*)(mu1 + 512 + c);
    const float mg0 = mu0[896 + lane], mg1 = mu1[896 + lane];
    const f32x4 rk = *(const f32x4*)(pin(p, 26) + (size_t)l * 256 + c), gnw = *(const f32x4*)(pin(p, 27) + (size_t)l * 256 + c), gnb = *(const f32x4*)(pin(p, 28) + (size_t)l * 256 + c);
    const f32x4 z4 = (f32x4){0.f, 0.f, 0.f, 0.f};
    const int gw = blockIdx.x * 8 + wave, nw = gridDim.x * 8;
    for (int tok0 = gw; tok0 < T_TOK; tok0 += 2 * nw) {
        FinRaw R[2];
        const int tok1 = tok0 + nw; const bool two = tok1 < T_TOK;
        fin_load(R[0], U, G, SC, tok0, c, lane);
        fin_load(R[1], U, G, SC, two ? tok1 : tok0, c, lane);
#pragma unroll
        for (int q = 0; q < 2; ++q) SG[q * 64 + lane] = sigmoidf_(R[q].g[0] + mg0 * (R[q].g[1] - R[q].g[0]) + mg1 * (R[q].g[2] - R[q].g[0]));
        f32x4 gate[2] = {z4, z4};
#pragma unroll 4
        for (int r4 = 0; r4 < 16; ++r4) { const f32x4 sa = *(const LAS f32x4*)(SG + r4 * 4), sb = *(const LAS f32x4*)(SG + 64 + r4 * 4);
#pragma unroll
            for (int j = 0; j < 4; ++j) { const f32x4 gu = *(const LAS f32x4*)(GUP + (r4 * 4 + j) * 256 + c); gate[0] += gu * sa[j]; gate[1] += gu * sb[j]; } }
#pragma unroll
        for (int q = 0; q < 2; ++q) {
            if (q == 1 && !two) break;
            const FinRaw& X = R[q]; bf16_t* y = Y + (size_t)(q ? tok1 : tok0) * DM;
            { const f32x4 hh = bf4(X.s[0]) + bf4(X.s[1]), yb = bf4(X.yb); f32x4 o;
              for (int e = 0; e < 4; ++e) o[e] = hh[e] * gelu_tanh(yb[e]);
              st4bf(y + c, o); }
            { const f32x4 o = bf4(X.s[2]) + bf4(X.s[3]), z = bf4(X.z);
              const float inv = rsqrtf(red16(hsum4(o * o)) * (1.f / 64.f) + 1e-6f); f32x4 r;
              for (int e = 0; e < 4; ++e) r[e] = o[e] * inv * gdn_g[e] * siluf_(z[e]);
              st4bf(y + 256 + c, r); }
            { const f32x4 o = bf4(X.s[4]) + bf4(X.s[5]), og = bf4(X.og);
              const float inv = rsqrtf(red16(hsum4(o * o)) * (1.f / 64.f) + 1e-6f); f32x4 r;
              for (int e = 0; e < 4; ++e) r[e] = o[e] * inv * ml_g[e] * sigmoidf_(og[e]);
              st4bf(y + 512 + c, r); }
            {
                const f32x4 yy = bf4(X.s[6]) + bf4(X.s[7]);
                const float mean = red16(hsum4(yy)) * (1.f / 64.f); const f32x4 dv = yy - mean;
                const float var = red16(hsum4(dv * dv)) * (1.f / 64.f); const float inv = rsqrtf(var + 64e-5f);
                f32x4 cc = bf4(X.r[0]); const f32x4 rr = cc + mr0 * (bf4(X.r[1]) - cc) + mr1 * (bf4(X.r[2]) - cc);
                cc = bf4(X.k[0]); const f32x4 kk = cc + mk0 * (bf4(X.k[1]) - cc) + mk1 * (bf4(X.k[2]) - cc);
                cc = bf4(X.v[0]); const f32x4 vv = cc + mv0 * (bf4(X.v[1]) - cc) + mv1 * (bf4(X.v[2]) - cc);
                const float bsum = red16(hsum4(rr * kk * rk));
                f32x4 o;
                for (int e = 0; e < 4; ++e) o[e] = (dv[e] * inv * gnw[e] + gnb[e] + bsum * vv[e]) * gate[q][e];
                st4bf(y + 768 + c, o);
            }
        }
    }
    __syncthreads();
}

#ifndef EN_GEMM
#define EN_GEMM 1
#endif
#ifndef EN_SCAN
#define EN_SCAN 1
#endif
#ifndef EN_FIN
#define EN_FIN 1
#endif
#ifndef EN_ROW
#define EN_ROW 1
#endif
#ifndef REP_SCAN
#define REP_SCAN 1
#endif
#ifndef REP_GEMM
#define REP_GEMM 1
#endif
#ifndef DBG_PROBE
#define DBG_PROBE 0
#endif
__global__ void __launch_bounds__(512) mega(Params p) {
    extern __shared__ __attribute__((aligned(16))) unsigned char smem[];
    cg::grid_group grid = cg::this_grid();
    const int wv = __builtin_amdgcn_readfirstlane((int)(threadIdx.x >> 6));
    LAS unsigned char* lds = (LAS unsigned char*)smem; LAS float* sm = (LAS float*)smem;
    int repc = 0, repg = 0;
    volatile LAS unsigned* xst = (volatile LAS unsigned*)(lds + 131072);
    if (otid(wv) < 2) xst[otid(wv)] = 0u;
    __syncthreads();
    const XcdBarrier xbar = xcd_barrier_post((unsigned*)(p.ws + WS_BAR), xst, wv);
    for (int ph = p.ph_lo; ph < p.ph_hi; ++ph) {
        if (ph > p.ph_lo) { if (ph == p.ph_lo + 1) grid.sync(); else xcd_barrier(xbar, wv); }
        unsigned char* ws = p.ws; asm volatile("" : "+s"(ws));
        bf16_t* WIN = (bf16_t*)(ws + WS_WIN); bf16_t* WOUT = (bf16_t*)(ws + WS_WOUT); bf16_t* WF1 = (bf16_t*)(ws + WS_WF1); bf16_t* WF2 = (bf16_t*)(ws + WS_WF2);
        bf16_t* Ub = (bf16_t*)(ws + WS_U); float* Gf = (float*)(ws + WS_G); bf16_t* ACT = (bf16_t*)(ws + WS_ACT);
        bf16_t* O1 = (bf16_t*)(ws + WS_U); bf16_t* HD = (bf16_t*)(ws + WS_U); bf16_t* O2 = (bf16_t*)(ws + WS_SC); bf16_t* XB1 = (bf16_t*)(ws + WS_SC + (size_t)T_TOK * DM * 2);
        if (ph == 0) {
            if (DBG_PROBE == 14 && otid(wv) == 0) ((LAS unsigned*)sm)[32761] = (unsigned)__builtin_amdgcn_s_memrealtime();
            phase_convert(p, sm, wv);
            row_pass(wv, nullptr, nullptr, pin(p, 0), nullptr, nullptr, nullptr, pin(p, 1), ACT);
            if (DBG_PROBE == 14) { __syncthreads(); if (otid(wv) == 0) { const unsigned dt = (unsigned)__builtin_amdgcn_s_memrealtime() - ((LAS unsigned*)sm)[32761]; atomicMax((unsigned*)(p.ws + WS_DBG) + 14, dt * 10u); } }
            continue;
        }
        const int l = (ph - 1) / 10, s = (ph - 1) % 10;
        const bool dbg_t = DBG_PROBE >= 4 && l == 0 && s == DBG_PROBE - 4;
        if (dbg_t && otid(wv) == 0) ((LAS unsigned*)sm)[32761] = (unsigned)__builtin_amdgcn_s_memrealtime();
        pg8::StaticOrder S;
        if (REP_GEMM > 1 && (s == 0 || s == 5 || s == 7 || s == 8)) { if (++repg < REP_GEMM) { --ph; } else repg = 0; }
        if (s == 0) { pg8::Gemm g{ACT, WIN + (size_t)l * NIN * DM, T_TOK, NIN, DM}; S.init(g.M, g.N, gridDim.x, blockIdx.x); pg8::EpiU E{Ub, Gf}; pg8::gemm_phase(lds, g, S, E, wv); }
        else if (s == 1) phase_prepass(p, l, xbar, wv);
        else if (s == 2) { pg8::Gemm g{(const bf16_t*)(ws + WS_A2), (const bf16_t*)(ws + WS_BT2) + (size_t)l * 2048 * 384, T_TOK, 2048, 384}; S.init(g.M, g.N, gridDim.x, blockIdx.x);
            pg8::EpiPre E{ws, pin(p, 10) + (size_t)l * 1024, (const float*)(ws + WS_SPT) + (size_t)l * 512, pin(p, 19) + (size_t)l * 512, pin(p, 21) + (size_t)l * 512, wv};
            pg8::gemm_phase<pg8::EpiPre, true>(lds, g, S, E, wv); }
        else if (s == 3) { phase_scan(p, l, sm, wv); if (REP_SCAN > 1) { if (++repc < REP_SCAN) ph -= 2; else repc = 0; } }
        else if (s == 4) phase_finalize(p, l, sm, wv);
        else if (s == 5 || s == 8) { pg8::Gemm g{s == 5 ? ACT : HD, s == 5 ? WOUT + (size_t)l * DM * DM : WF2 + (size_t)l * DM * DFF, T_TOK, DM, s == 5 ? DM : DFF}; S.init(g.M, g.N, gridDim.x, blockIdx.x); pg8::EpiBf E{s == 5 ? O1 : O2, DM}; pg8::gemm_phase(lds, g, S, E, wv); }
        else if (s == 6 || s == 9) { const bool fa = (s == 6);
            row_pass(wv, fa ? O1 : O2, pin(p, fa ? 2 : 4) + (size_t)l * DM, (fa && l == 0) ? pin(p, 0) : nullptr, fa ? (const bf16_t*)p.out : (const bf16_t*)XB1, (!fa && l == 1) ? p.out : nullptr, fa ? XB1 : (bf16_t*)p.out,
                     fa ? pin(p, 3) + (size_t)l * DM : (l == 0 ? pin(p, 1) + DM : nullptr), ACT); }
        else if (s == 7) { pg8::Gemm g{ACT, WF1 + (size_t)l * 2 * DFF * DM, T_TOK, 2 * DFF, DM}; S.init(g.M, g.N, gridDim.x, blockIdx.x); pg8::EpiSwi E{HD}; pg8::gemm_phase(lds, g, S, E, wv); }
        if (dbg_t) { __syncthreads(); if (otid(wv) == 0) { const unsigned dt = (unsigned)__builtin_amdgcn_s_memrealtime() - ((LAS unsigned*)sm)[32761]; atomicMax((unsigned*)(p.ws + WS_DBG) + DBG_PROBE, dt * 10u); } }
    }
    if (DBG_PROBE) { __syncthreads(); if (blockIdx.x == 0 && otid(wv) == 0) { const unsigned v = __hip_atomic_load((const unsigned*)(p.ws + WS_DBG) + DBG_PROBE, __ATOMIC_RELAXED, __HIP_MEMORY_SCOPE_AGENT);
        __builtin_amdgcn_s_waitcnt(0); p.out[0] += (float)(v / 1000u); } }
}

extern "C" void kernel_launch(void* const* d_in, const int* in_sizes, int n_in, void* d_out, int out_size, void* d_ws, size_t ws_size, hipStream_t stream) {
    static int grid_blocks = 0;
    if (grid_blocks == 0) {
        if (n_in != 31 || ws_size < WS_END || out_size != T_TOK * DM) { fprintf(stderr, "kernel_launch: unexpected shapes (n_in %d, ws %zu need %zu, out %d)\n", n_in, ws_size, (size_t)WS_END, out_size); grid_blocks = -1; return; }
        int dev = 0, cus = 0, per_cu = 0;
        (void)hipGetDevice(&dev);
        (void)hipDeviceGetAttribute(&cus, hipDeviceAttributeMultiprocessorCount, dev);
        if (hipFuncSetAttribute((const void*)mega, hipFuncAttributeMaxDynamicSharedMemorySize, LDS_BYTES) != hipSuccess) { fprintf(stderr, "kernel_launch: hipFuncSetAttribute failed\n"); grid_blocks = -1; return; }
        if (hipOccupancyMaxActiveBlocksPerMultiprocessor(&per_cu, (const void*)mega, 512, LDS_BYTES) != hipSuccess || per_cu < 1) { fprintf(stderr, "kernel_launch: occupancy query says %d blocks per CU\n", per_cu); per_cu = 1; (void)hipGetLastError(); }
        grid_blocks = 256;
        (void)per_cu;
    }
    if (grid_blocks < 0) return;
    if (hipMemsetAsync((char*)d_ws + WS_BAR, 0, (size_t)XCD_BAR_WORDS * 4, stream) != hipSuccess) { fprintf(stderr, "kernel_launch: hipMemsetAsync of the barrier words failed\n"); return; }
    Params p{};
    for (int i = 0; i < 31; ++i) p.in[i] = (const float*)d_in[i];
    p.out = (float*)d_out; p.ws = (unsigned char*)d_ws; p.ph_lo = 0; p.ph_hi = 21;
    void* args[] = {&p};
    hipError_t e = hipLaunchCooperativeKernel((const void*)mega, dim3(grid_blocks), dim3(512), args, LDS_BYTES, stream);
    if (e != hipSuccess) fprintf(stderr, "cooperative launch failed: %s (grid %d)\n", hipGetErrorString(e), grid_blocks);
}
```

```cpp
#include <hip/hip_runtime.h>
#include <hip/hip_cooperative_groups.h>
#include <cstdio>
namespace cg = cooperative_groups;

#ifndef DBG_PROBE
#define DBG_PROBE 0
#endif
#define LAS __attribute__((address_space(3)))
typedef unsigned short bf16_t;
typedef short bf16x8 __attribute__((ext_vector_type(8)));
typedef float f32x4 __attribute__((ext_vector_type(4)));
typedef float f32x2 __attribute__((ext_vector_type(2)));
typedef unsigned u32x4 __attribute__((ext_vector_type(4)));
typedef unsigned u32x2 __attribute__((ext_vector_type(2)));

constexpr int T_TOK = 32768, SEQ = 4096, DM = 1024, NU = 3328, NGATE = 256, NIN = 3584, DFF = 2816, NSC = 2048;
constexpr int LDS_BYTES = 131072 + 16;
constexpr size_t WS_WIN = 0;
constexpr size_t WS_WOUT = WS_WIN + (size_t)2 * NIN * DM * 2;
constexpr size_t WS_WF1 = WS_WOUT + (size_t)2 * DM * DM * 2;
constexpr size_t WS_WF2 = WS_WF1 + (size_t)2 * 2 * DFF * DM * 2;
constexpr size_t WS_U = WS_WF2 + (size_t)2 * DM * DFF * 2;
constexpr size_t WS_G = WS_U + (size_t)T_TOK * NU * 2;
constexpr size_t WS_ACT = WS_G + (size_t)T_TOK * NGATE * 4;
constexpr size_t WS_SC = WS_ACT + (size_t)T_TOK * DM * 2;
constexpr int A2K = 448, N2 = 2304;
constexpr size_t WS_BT2 = WS_SC + (size_t)T_TOK * NSC * 2;
constexpr size_t WS_SPT = WS_BT2 + (size_t)2 * N2 * A2K * 2;
constexpr size_t OUT_A2 = (size_t)T_TOK * DM * 2;
constexpr size_t OUT_GT = OUT_A2 + (size_t)T_TOK * 512 * 2;
constexpr size_t WS_DBG = WS_SPT + 4096;
constexpr size_t WS_BAR = WS_DBG + 256;
constexpr int XCD_BAR_WORDS = 3456;
constexpr size_t WS_END = WS_BAR + (size_t)XCD_BAR_WORDS * 4;

struct Params { const float* in[31]; float* out; unsigned char* ws; int ph_lo, ph_hi; };
__device__ __forceinline__ const float* pin(const Params& p, int i) { asm volatile("" : "+s"(i)); return p.in[i]; }

__device__ __forceinline__ int otid(int wv) { unsigned z = 0u; asm volatile("" : "+s"(z)); int t = (wv << 6) | (int)__builtin_amdgcn_mbcnt_hi(~0u, __builtin_amdgcn_mbcnt_lo(~0u, z)); asm volatile("" : "+v"(t)); return t; }
__device__ __forceinline__ int obid() { int t = blockIdx.x; asm volatile("" : "+s"(t)); return t; }
__device__ __forceinline__ float bf2f(unsigned short b) { return __uint_as_float(((unsigned)b) << 16); }
__device__ __forceinline__ unsigned short f2bf(float f) { unsigned u = __float_as_uint(f); u += 0x7FFFu + ((u >> 16) & 1u); return (unsigned short)(u >> 16); }
__device__ __forceinline__ unsigned pk2(float lo, float hi) { return (unsigned)f2bf(lo) | ((unsigned)f2bf(hi) << 16); }
__device__ __forceinline__ f32x4 ld4bf(const bf16_t* p) {
    const u32x2 v = *(const u32x2*)p; f32x4 r;
    r.x = __uint_as_float(v.x << 16); r.y = __uint_as_float(v.x & 0xffff0000u); r.z = __uint_as_float(v.y << 16); r.w = __uint_as_float(v.y & 0xffff0000u); return r;
}
__device__ __forceinline__ f32x4 bf4(u32x2 v) { f32x4 r; r.x = __uint_as_float(v.x << 16); r.y = __uint_as_float(v.x & 0xffff0000u); r.z = __uint_as_float(v.y << 16); r.w = __uint_as_float(v.y & 0xffff0000u); return r; }
__device__ __forceinline__ void st4bf(bf16_t* p, f32x4 v) { u32x2 o; o.x = pk2(v.x, v.y); o.y = pk2(v.z, v.w); *(u32x2*)p = o; }
__device__ __forceinline__ float sigmoidf_(float x) { return __builtin_amdgcn_rcpf(1.f + __expf(-x)); }
__device__ __forceinline__ float siluf_(float x) { return x * __builtin_amdgcn_rcpf(1.f + __expf(-x)); }
__device__ __forceinline__ float softplusf_(float x) { return fmaxf(x, 0.f) + __logf(1.f + __expf(-fabsf(x))); }
__device__ __forceinline__ float tanhf_(float x) { return 1.f - 2.f * __builtin_amdgcn_rcpf(1.f + __expf(2.f * x)); }
__device__ __forceinline__ float gelu_tanh(float x) { const float u = 0.7978845608028654f * (x + 0.044715f * x * x * x); return 0.5f * x * (1.f + tanhf_(u)); }
__device__ __forceinline__ float hsum4(f32x4 v) { return (v.x + v.z) + (v.y + v.w); }
template <int CTRL> __device__ __forceinline__ float dppf(float x) { return __int_as_float(__builtin_amdgcn_update_dpp(0, __float_as_int(x), CTRL, 0xF, 0xF, true)); }
__device__ __forceinline__ float red16(float v) { v += dppf<0xB1>(v); v += dppf<0x4E>(v); v += dppf<0x141>(v); v += dppf<0x140>(v); return v; }
__device__ __forceinline__ float red64(float v) { v = red16(v); v += __shfl_xor(v, 16); v += __shfl_xor(v, 32); return v; }
__device__ __forceinline__ float sum4l(float x) { x += dppf<0xB1>(x); x += dppf<0x4E>(x); return x; }
__device__ __forceinline__ unsigned cvt_pk_bf16(float lo, float hi) { unsigned r; asm volatile("v_cvt_pk_bf16_f32 %0, %1, %2" : "=v"(r) : "v"(lo), "v"(hi)); return r; }

#define XB_TMO      128
#define XB_XCNT(j)  (256  + 64 * (j))
#define XB_XSUB(j)  (1280 + 64 * (j))
#define XB_XGEN(j)  (2304 + 64 * (j))
#define XB_TOP      3328
#define XB_TOPGEN   3392
#define XB_SPIN_CAP (1u << 22)
__device__ __forceinline__ unsigned xb_ld(unsigned* p)              { return __hip_atomic_load(p, __ATOMIC_RELAXED, __HIP_MEMORY_SCOPE_AGENT); }
__device__ __forceinline__ unsigned xb_add(unsigned* p, unsigned v) { return __hip_atomic_fetch_add(p, v, __ATOMIC_RELAXED, __HIP_MEMORY_SCOPE_AGENT); }
__device__ __forceinline__ unsigned xb_xcc_id() { return (unsigned)__builtin_amdgcn_s_getreg((3 << 11) | 20) & 0xFu; }
#define XB_SPIN(cond, bar) do { unsigned _sp = 0; while (cond) { __builtin_amdgcn_s_sleep(1); \
    if ((++_sp & 255u) == 0u) { if (xb_ld(&(bar)[XB_TMO])) break; if (_sp > XB_SPIN_CAP) { atomicAdd(&(bar)[XB_TMO], 1u); break; } } } } while (0)
struct XcdBarrier { unsigned* bar; unsigned x; volatile LAS unsigned* st; };
__device__ __forceinline__ XcdBarrier xcd_barrier_post(unsigned* bar, volatile LAS unsigned* st, int wv) {
    XcdBarrier b; b.bar = bar; b.x = xb_xcc_id(); b.st = st;
    if (otid(wv) == 0) (void)xb_add(&bar[XB_XCNT(b.x)], 1u);
    return b;
}
__device__ __forceinline__ void xcd_barrier_complete(unsigned* bar, unsigned x, unsigned& nloc, unsigned& nx) {
    const unsigned G = gridDim.x * gridDim.y * gridDim.z;
    unsigned sum, cnt, mine, sp = 0u;
    for (;;) {
        sum = 0u; cnt = 0u; mine = 0u;
#pragma unroll
        for (unsigned j = 0; j < 16; ++j) { const unsigned c = xb_ld(&bar[XB_XCNT(j)]); sum += c; cnt += (c > 0u) ? 1u : 0u; mine = (j == x) ? c : mine; }
        if (sum == G) break;
        __builtin_amdgcn_s_sleep(1);
        if ((++sp & 255u) == 0u) { if (xb_ld(&bar[XB_TMO])) break; if (sp > XB_SPIN_CAP) { atomicAdd(&bar[XB_TMO], 1u); break; } }
    }
    nloc = mine > 0u ? mine : 1u; nx = cnt > 0u ? cnt : 1u;
}
__device__ __forceinline__ void xcd_barrier(const XcdBarrier& b, int wv) {
    asm volatile("s_waitcnt vmcnt(0)" ::: "memory");
    __syncthreads();
    if (otid(wv) == 0) {
        unsigned* bar = b.bar;
        __builtin_amdgcn_s_waitcnt(0);
        unsigned nloc = b.st[0], nx = b.st[1];
        if (nloc == 0u) { xcd_barrier_complete(bar, b.x, nloc, nx); b.st[0] = nloc; b.st[1] = nx; }
        const unsigned old = xb_add(&bar[XB_XSUB(b.x)], 1u);
        const unsigned gen = old / nloc;
        if (old + 1u == (gen + 1u) * nloc) {
            __builtin_amdgcn_fence(__ATOMIC_RELEASE, "agent");
            asm volatile("s_waitcnt vmcnt(0)" ::: "memory");
            const unsigned og = xb_add(&bar[XB_TOP], 1u);
            const unsigned tg = og / nx;
            if (og + 1u == (tg + 1u) * nx) xb_add(&bar[XB_TOPGEN], 1u);
            else XB_SPIN(xb_ld(&bar[XB_TOPGEN]) == tg, bar);
            __builtin_amdgcn_fence(__ATOMIC_ACQUIRE, "agent");
            xb_add(&bar[XB_XGEN(b.x)], 1u);
            asm volatile("s_waitcnt vmcnt(0)" ::: "memory");
        } else {
            XB_SPIN(xb_ld(&bar[XB_XGEN(b.x)]) == gen, bar);
            __builtin_amdgcn_fence(__ATOMIC_ACQUIRE, "agent");
            asm volatile("s_waitcnt vmcnt(0)" ::: "memory");
        }
    }
    __syncthreads();
}

namespace pg8 {
constexpr int BM = 256, BK = 64, HALF = 128, HTB = HALF * BK * 2, STAGE_BYTES = 8 * HTB, NXCD = 8, WGM = 8;
__device__ __forceinline__ int lds_byte(int r, int c) { const int st = (r >> 4) * 2 + (c >> 5), rr = r & 15, cc = c & 31, ob = rr * 64 + cc * 2; return st * 1024 + (ob ^ (((ob >> 9) & 1) << 5)); }
__device__ __forceinline__ void stage_rc(int b, int& R, int& C) { const int st = b / 1024, sb = b % 1024, swz = sb ^ (((sb >> 9) & 1) << 5); R = (st >> 1) * 16 + swz / 64; C = (st & 1) * 32 + (swz % 64) / 2; }
__device__ __forceinline__ int perm32(int rho) { const int n = rho >> 4, i = rho & 15; return 8 * (i >> 2) + 4 * n + (i & 3); }
struct Unit { int pm, pn; };
struct Gemm { const bf16_t* A; const bf16_t* Bt; int M, N, K; };
struct StaticOrder {
    int nM, nN, nwg, G, c;
    __device__ void init(int M, int N, int G_, int c_) { nM = M / BM; nN = N / BM; nwg = nM * nN; G = G_; c = c_; }
    __device__ bool next(int i, Unit& u) const {
        const long L = (long)i * G + c; if (L >= nwg) return false;
        int wgid = (int)L; { const int q = nwg / NXCD, r = nwg % NXCD, xcd = wgid % NXCD, off = wgid / NXCD; wgid = (xcd < r ? xcd * (q + 1) : r * (q + 1) + (xcd - r) * q) + off; }
        const int nig = WGM * nN, gid = wgid / nig, fm = gid * WGM, gsz = (nM - fm) < WGM ? (nM - fm) : WGM;
        u.pm = fm + ((wgid % nig) % gsz); u.pn = (wgid % nig) / gsz; return true;
    }
};
struct EpiBf {
    static constexpr bool PERM = true;
    bf16_t* C; int ldc;
    __device__ __forceinline__ void operator()(const f32x4 (&acc)[2][2][4][2], const Unit& u, int wr, int wc, int fr, int fq) const {
        const int row0 = u.pm * BM + wr * 64 + fr, col0 = u.pn * BM + wc * 32 + 8 * fq;
#pragma unroll
        for (int ai = 0; ai < 2; ++ai)
#pragma unroll
            for (int m = 0; m < 4; ++m) { bf16_t* rowp = C + (size_t)(row0 + ai * HALF + m * 16) * ldc + col0;
#pragma unroll
                for (int bj = 0; bj < 2; ++bj) { const f32x4 v0 = acc[ai][bj][m][0], v1 = acc[ai][bj][m][1];
                    u32x4 o; o.x = cvt_pk_bf16(v0[0], v0[1]); o.y = cvt_pk_bf16(v0[2], v0[3]); o.z = cvt_pk_bf16(v1[0], v1[1]); o.w = cvt_pk_bf16(v1[2], v1[3]);
                    *(u32x4*)(rowp + bj * HALF) = o; } }
    }
};
struct EpiU {
    static constexpr bool PERM = true;
    bf16_t* U; float* G;
    __device__ __forceinline__ void operator()(const f32x4 (&acc)[2][2][4][2], const Unit& u, int wr, int wc, int fr, int fq) const {
        const int row0 = u.pm * BM + wr * 64 + fr;
        if (u.pn < 13) {
            const int col0 = u.pn * BM + wc * 32 + 8 * fq;
#pragma unroll
            for (int ai = 0; ai < 2; ++ai)
#pragma unroll
                for (int m = 0; m < 4; ++m) { bf16_t* rowp = U + (size_t)(row0 + ai * HALF + m * 16) * NU + col0;
#pragma unroll
                    for (int bj = 0; bj < 2; ++bj) { const f32x4 v0 = acc[ai][bj][m][0], v1 = acc[ai][bj][m][1];
                        u32x4 o; o.x = cvt_pk_bf16(v0[0], v0[1]); o.y = cvt_pk_bf16(v0[2], v0[3]); o.z = cvt_pk_bf16(v1[0], v1[1]); o.w = cvt_pk_bf16(v1[2], v1[3]);
                        *(u32x4*)(rowp + bj * HALF) = o; } }
        } else {
            const int col0 = wc * 32 + 8 * fq;
#pragma unroll
            for (int ai = 0; ai < 2; ++ai)
#pragma unroll
                for (int m = 0; m < 4; ++m) { float* rowp = G + (size_t)(row0 + ai * HALF + m * 16) * NGATE + col0;
#pragma unroll
                    for (int bj = 0; bj < 2; ++bj) { *(f32x4*)(rowp + bj * HALF) = acc[ai][bj][m][0]; *(f32x4*)(rowp + bj * HALF + 4) = acc[ai][bj][m][1]; } }
        }
    }
};
struct EpiSwi {
    static constexpr bool PERM = true;
    bf16_t* H;
    __device__ __forceinline__ void operator()(const f32x4 (&acc)[2][2][4][2], const Unit& u, int wr, int wc, int fr, int fq) const {
        const int row0 = u.pm * BM + wr * 64 + fr, col0 = u.pn * HALF + wc * 32 + 8 * fq;
#pragma unroll
        for (int ai = 0; ai < 2; ++ai)
#pragma unroll
            for (int m = 0; m < 4; ++m) { bf16_t* rowp = H + (size_t)(row0 + ai * HALF + m * 16) * DFF + col0;
                float r[8];
#pragma unroll
                for (int n = 0; n < 2; ++n)
#pragma unroll
                    for (int j = 0; j < 4; ++j) { const float g = acc[ai][0][m][n][j], up = acc[ai][1][m][n][j]; r[n * 4 + j] = g * up * __builtin_amdgcn_rcpf(1.f + __expf(-g)); }
                u32x4 o; o.x = cvt_pk_bf16(r[0], r[1]); o.y = cvt_pk_bf16(r[2], r[3]); o.z = cvt_pk_bf16(r[4], r[5]); o.w = cvt_pk_bf16(r[6], r[7]);
                *(u32x4*)rowp = o; }
    }
};

struct EpiPre {
    static constexpr bool PERM = true;
    unsigned char* ws; unsigned char* ob; const float* gb; const float* lam; const float* w0; const float* a0; int wv;
    __device__ __forceinline__ void operator()(const f32x4 (&acc)[2][2][4][2], const Unit& u, int wr_, int wc_, int fr_, int fq_) const {
        const int t_ = otid(wv); const int wr = t_ >> 8, wc = (t_ >> 6) & 3, fr = t_ & 15, fq = (t_ >> 4) & 3;
        (void)wr_; (void)wc_; (void)fr_; (void)fq_;
        const unsigned row0 = u.pm * BM + wr * 64 + fr;
        if (u.pn < 4) {
            const int dir = u.pn >> 1;
#pragma unroll
            for (int n = 0; n < 2; ++n) { const unsigned c = (u.pn & 1) * 128 + wc * 32 + 8 * fq + 4 * n;
                const f32x4 sp = *(const f32x4*)(lam + dir * 256 + c); const f32x4 gr = *(const f32x4*)(gb + (dir * 2 + 0) * 256 + c), gi = *(const f32x4*)(gb + (dir * 2 + 1) * 256 + c);
#pragma unroll
                for (int ai = 0; ai < 2; ++ai)
#pragma unroll
                    for (int m = 0; m < 4; ++m) { const unsigned row = row0 + ai * HALF + m * 16;
                        const f32x4 xc = ld4bf((const bf16_t*)(ob + (unsigned)OUT_A2 + (row * (unsigned)A2K + c) * 2u)); f32x4 la, bb;
#pragma unroll
                        for (int j = 0; j < 4; ++j) { const float rp = acc[ai][0][m][n][j] + gr[j], ip = acc[ai][1][m][n][j] + gi[j];
                            const float l_ = sp[j] * __builtin_amdgcn_rcpf(1.f + __expf(-rp)); const float a_ = __expf(l_);
                            la[j] = 1.f - a_;     bb[j] = __builtin_amdgcn_sqrtf(fmaxf(1.f - a_ * a_, 0.f)) * __builtin_amdgcn_rcpf(1.f + __expf(-ip)) * xc[j]; }
                        u32x2 o; o.x = cvt_pk_bf16(la[0], la[1]); o.y = cvt_pk_bf16(la[2], la[3]); *(u32x2*)(ws + (unsigned)WS_ACT + (row * (unsigned)DM + dir * 256u + c) * 2u) = o;
                        o.x = cvt_pk_bf16(bb[0], bb[1]); o.y = cvt_pk_bf16(bb[2], bb[3]); *(u32x2*)(ws + (unsigned)WS_SC + (row * (unsigned)NSC + dir * 256u + c) * 2u) = o; } }
        } else if (u.pn == 8) {
#pragma unroll
            for (int bj = 0; bj < 2; ++bj)
#pragma unroll
                for (int n = 0; n < 2; ++n) { const unsigned c = bj * HALF + wc * 32 + 8 * fq + 4 * n;
#pragma unroll
                    for (int ai = 0; ai < 2; ++ai)
#pragma unroll
                        for (int m = 0; m < 4; ++m) { const unsigned row = row0 + ai * HALF + m * 16; const f32x4 r = acc[ai][bj][m][n];
                            u32x2 o; o.x = cvt_pk_bf16(r[0], r[1]); o.y = cvt_pk_bf16(r[2], r[3]);
                            *(u32x2*)(ob + (unsigned)OUT_GT + (row * 256u + c) * 2u) = o; } }
        } else {
            const int q = u.pn - 4, kind = q >> 1, d = q & 1;
            const float* cst = (kind ? a0 : w0) + d * 256; const float mul = kind ? 1.f : -0.6065306597126334f;
            const unsigned dbase = kind ? (unsigned)WS_ACT + (512u + d * 256u) * 2u : (d ? (unsigned)WS_G + 64u * 2u : (unsigned)WS_U);
            const unsigned dstride = kind ? (unsigned)DM * 2u : (d ? 512u * 2u : (unsigned)NU * 2u);
#pragma unroll
            for (int bj = 0; bj < 2; ++bj)
#pragma unroll
                for (int n = 0; n < 2; ++n) { const unsigned c = bj * HALF + wc * 32 + 8 * fq + 4 * n; const f32x4 cv = *(const f32x4*)(cst + c);
#pragma unroll
                    for (int ai = 0; ai < 2; ++ai)
#pragma unroll
                        for (int m = 0; m < 4; ++m) { const unsigned row = row0 + ai * HALF + m * 16; f32x4 r;
#pragma unroll
                            for (int j = 0; j < 4; ++j) r[j] = mul * __builtin_amdgcn_rcpf(1.f + __expf(-(acc[ai][bj][m][n][j] + cv[j])));
                            u32x2 o; o.x = cvt_pk_bf16(r[0], r[1]); o.y = cvt_pk_bf16(r[2], r[3]);
                            *(u32x2*)(ws + dbase + row * dstride + c * 2u) = o; } }
        }
    }
};

template <class Epi, bool KSUB = false>
__device__ __forceinline__ void gemm_phase(LAS unsigned char* lds, const Gemm g, const StaticOrder& S, const Epi& E, int wv) {
    const int tid = otid(wv), wid = __builtin_amdgcn_readfirstlane(tid >> 6), lane = tid & 63, wr = wid >> 2, wc = wid & 3, fr = lane & 15, fq = lane >> 4;
    const int K = g.K, nt = KSUB ? 2 : K / BK;
#define PG8_KOFF(u) (KSUB ? (size_t)(((u).pn < 4 ? ((u).pn & 1) * 128 : ((u).pn < 8 ? 256 : 320)) * 2) : (size_t)0)
    unsigned voffA[2], voffB[2];
#pragma unroll
    for (int i = 0; i < 2; ++i) { int R, C; stage_rc(tid * 16 + i * 8192, R, C); const int Rb = Epi::PERM ? ((R & ~31) + perm32(R & 31)) : R;
        voffA[i] = (unsigned)(R * K + C) * 2u; voffB[i] = (unsigned)(Rb * K + C) * 2u; }
    const size_t kstep = (size_t)(BK * 2);
    const size_t hstep = (size_t)HALF * K * 2;
    const size_t tstep = 2 * hstep;
    const unsigned ldsw = (unsigned)wid * 1024u;
    const int aoff = lds_byte(wr * 64 + fr, fq * 8), boff = lds_byte(wc * 32 + fr, fq * 8);
#define PG8_SA(b, h) (((b) * 2 + (h)) * HTB)
#define PG8_SB(b, h) ((4 + (b) * 2 + (h)) * HTB)
#define PG8_STAGE(bufoff, gbase, voff) do { _Pragma("unroll") for (int _i = 0; _i < 2; ++_i) \
        __builtin_amdgcn_global_load_lds((const unsigned*)((const char*)(gbase) + (voff)[_i]), (LAS unsigned*)(lds + (bufoff) + ldsw + _i * 8192), 16, 0, 0); } while (0)
#define PG8_LDA(dst, b, h) do { _Pragma("unroll") for (int m = 0; m < 4; ++m) _Pragma("unroll") for (int k = 0; k < 2; ++k) dst[m][k] = *(const LAS bf16x8*)(lds + PG8_SA(b, h) + aoff + m * 2048 + k * 1024); } while (0)
#define PG8_LDB(dst, b, h) do { _Pragma("unroll") for (int n = 0; n < 2; ++n) _Pragma("unroll") for (int k = 0; k < 2; ++k) dst[n][k] = *(const LAS bf16x8*)(lds + PG8_SB(b, h) + boff + n * 2048 + k * 1024); } while (0)
#define PG8_MMA(ai, bj, At, Bt) do { __builtin_amdgcn_s_setprio(1); _Pragma("unroll") for (int m = 0; m < 4; ++m) _Pragma("unroll") for (int n = 0; n < 2; ++n) _Pragma("unroll") for (int k = 0; k < 2; ++k) \
        acc[ai][bj][m][n] = __builtin_amdgcn_mfma_f32_16x16x32_bf16(Bt[n][k], At[m][k], acc[ai][bj][m][n], 0, 0, 0); __builtin_amdgcn_s_setprio(0); } while (0)
#define PG8_WAIT_V(n) asm volatile("s_waitcnt vmcnt(" #n ")" ::: "memory")
#define PG8_WAIT_L(n) asm volatile("s_waitcnt lgkmcnt(" #n ")" ::: "memory")
#define PG8_BAR __builtin_amdgcn_s_barrier()
#define PG8_SCHED __builtin_amdgcn_sched_barrier(0)
    Unit cur, nxt; int ui = 0;
    if (!S.next(0, cur)) return;
    f32x4 acc[2][2][4][2];
#pragma unroll
    for (int a = 0; a < 2; ++a)
#pragma unroll
        for (int b = 0; b < 2; ++b)
#pragma unroll
            for (int m = 0; m < 4; ++m)
#pragma unroll
                for (int n = 0; n < 2; ++n) acc[a][b][m][n] = (f32x4){0.f, 0.f, 0.f, 0.f};
    bf16x8 At[4][2], B0[2][2], B1[2][2];
    const char* cA = (const char*)g.A + (size_t)cur.pm * tstep + PG8_KOFF(cur); const char* cB = (const char*)g.Bt + (size_t)cur.pn * tstep + PG8_KOFF(cur);
    PG8_STAGE(PG8_SB(0, 0), cB, voffB); PG8_STAGE(PG8_SA(0, 0), cA, voffA); PG8_STAGE(PG8_SB(0, 1), cB + hstep, voffB); PG8_STAGE(PG8_SA(0, 1), cA + hstep, voffA);
    if (wr == 1) PG8_BAR;
    PG8_WAIT_V(4); PG8_BAR;
    PG8_STAGE(PG8_SB(1, 0), cB + kstep, voffB); PG8_STAGE(PG8_SA(1, 0), cA + kstep, voffA); PG8_STAGE(PG8_SB(1, 1), cB + hstep + kstep, voffB);
    PG8_WAIT_V(6); PG8_BAR;
    for (;;) {
        const bool has_next = S.next(ui + 1, nxt);
        const char* nA = has_next ? (const char*)g.A + (size_t)nxt.pm * tstep + PG8_KOFF(nxt) : cA; const char* nB = has_next ? (const char*)g.Bt + (size_t)nxt.pn * tstep + PG8_KOFF(nxt) : cB;
        for (int t = 0; t < nt; t += 2) {
            const bool last = (t == nt - 2);
            const char* a1 = cA + (size_t)(t + 1) * kstep;
            const char* a2 = last ? nA : cA + (size_t)(t + 2) * kstep; const char* b2 = last ? nB : cB + (size_t)(t + 2) * kstep;
            const char* a3 = a2 + kstep; const char* b3 = b2 + kstep;
            PG8_LDB(B0, 0, 0); PG8_SCHED; PG8_LDA(At, 0, 0); PG8_STAGE(PG8_SA(1, 1), a1 + hstep, voffA);
            PG8_WAIT_L(8); PG8_BAR; PG8_WAIT_L(0); PG8_MMA(0, 0, At, B0); PG8_BAR; PG8_SCHED;
            PG8_LDB(B1, 0, 1); PG8_STAGE(PG8_SB(0, 0), b2, voffB);
            PG8_BAR; PG8_WAIT_L(0); PG8_MMA(0, 1, At, B1); PG8_BAR;
            PG8_LDA(At, 0, 1); PG8_STAGE(PG8_SA(0, 0), a2, voffA);
            PG8_BAR; PG8_WAIT_L(0); PG8_MMA(1, 0, At, B0); PG8_BAR; PG8_SCHED;
            PG8_STAGE(PG8_SB(0, 1), b2 + hstep, voffB);
            PG8_WAIT_V(6); PG8_BAR; PG8_MMA(1, 1, At, B1); PG8_BAR;
            PG8_LDB(B0, 1, 0); PG8_SCHED; PG8_LDA(At, 1, 0); PG8_STAGE(PG8_SA(0, 1), a2 + hstep, voffA);
            PG8_WAIT_L(8); PG8_BAR; PG8_WAIT_L(0); PG8_MMA(0, 0, At, B0); PG8_BAR; PG8_SCHED;
            PG8_LDB(B1, 1, 1); PG8_STAGE(PG8_SB(1, 0), b3, voffB);
            PG8_BAR; PG8_WAIT_L(0); PG8_MMA(0, 1, At, B1); PG8_BAR;
            PG8_LDA(At, 1, 1); PG8_STAGE(PG8_SA(1, 0), a3, voffA);
            PG8_BAR; PG8_WAIT_L(0); PG8_MMA(1, 0, At, B0); PG8_BAR; PG8_SCHED;
            PG8_STAGE(PG8_SB(1, 1), b3 + hstep, voffB);
            PG8_WAIT_V(6); PG8_BAR; PG8_MMA(1, 1, At, B1); PG8_BAR;
        }
        E(acc, cur, wr, wc, fr, fq);
        if (!has_next) break;
#pragma unroll
        for (int a = 0; a < 2; ++a)
#pragma unroll
            for (int b = 0; b < 2; ++b)
#pragma unroll
                for (int m = 0; m < 4; ++m)
#pragma unroll
                    for (int n = 0; n < 2; ++n) acc[a][b][m][n] = (f32x4){0.f, 0.f, 0.f, 0.f};
        cur = nxt; cA = nA; cB = nB; ++ui;
    }
    PG8_WAIT_V(0);
    if (wr == 0) PG8_BAR;
    PG8_BAR;
#undef PG8_KOFF
#undef PG8_SA
#undef PG8_SB
#undef PG8_STAGE
#undef PG8_LDA
#undef PG8_LDB
#undef PG8_MMA
#undef PG8_WAIT_V
#undef PG8_WAIT_L
#undef PG8_BAR
#undef PG8_SCHED
}
}

__device__ __forceinline__ int src_col(int kind, int n) {
    if (kind == 0) {
        if (n < 1536) return n;
        if (n < 2560) return n + 16;
        if (n < 3328) return n + 32;
        const int j = n - 3328;
        if (j < 16) return 1536 + j;
        if (j < 32) return 2576 + (j - 16);
        if (j < 224) return 3360 + (j - 32);
        return -1;
    }
    if (kind == 2) return ((n & 255) >> 7) * DFF + (n >> 8) * 128 + (n & 127);
    return n;
}
__device__ __forceinline__ void phase_convert(const Params& p, LAS float* tile, int wv) {
    const int tid = otid(wv);
    bf16_t* WIN = (bf16_t*)(p.ws + WS_WIN); bf16_t* WOUT = (bf16_t*)(p.ws + WS_WOUT); bf16_t* WF1 = (bf16_t*)(p.ws + WS_WF1); bf16_t* WF2 = (bf16_t*)(p.ws + WS_WF2);
    {
        const int lane = tid & 63, wave = tid >> 6;
        LAS float* scr = tile + wave * (64 * 33);
        for (int it = blockIdx.x * 8 + wave; it < 13056; it += gridDim.x * 8) {
            const int l = it / 6528; int r = it % 6528; int kind, nb, kb, K, Nsrc; const float* W; bf16_t* dst;
            if (r < 1792) { kind = 0; nb = r % 112; kb = r / 112; K = 1024; Nsrc = 3552; W = pin(p, 5) + (size_t)l * 1024 * 3552; dst = WIN + (size_t)l * NIN * 1024; }
            else if (r < 2304) { r -= 1792; kind = 1; nb = r % 32; kb = r / 32; K = 1024; Nsrc = 1024; W = pin(p, 6) + (size_t)l * 1024 * 1024; dst = WOUT + (size_t)l * 1024 * 1024; }
            else if (r < 5120) { r -= 2304; kind = 2; nb = r % 176; kb = r / 176; K = 1024; Nsrc = 5632; W = pin(p, 29) + (size_t)l * 1024 * 5632; dst = WF1 + (size_t)l * 5632 * 1024; }
            else { r -= 5120; kind = 3; nb = r % 32; kb = r / 32; K = 2816; Nsrc = 1024; W = pin(p, 30) + (size_t)l * 2816 * 1024; dst = WF2 + (size_t)l * 1024 * 2816; }
            const int k0 = 64 * kb, n0 = 32 * nb; const int sc = src_col(kind, n0 + (lane & 31));
            float vals[32];
#pragma unroll
            for (int i = 0; i < 32; ++i) { const int kk = 2 * i + (lane >> 5); vals[i] = (sc >= 0) ? W[(size_t)(k0 + kk) * Nsrc + sc] : 0.f; }
#pragma unroll
            for (int i = 0; i < 32; ++i) { const int kk = 2 * i + (lane >> 5); scr[kk * 33 + (lane & 31)] = vals[i]; }
            const int c8 = lane & 7;
#pragma unroll
            for (int j = 0; j < 4; ++j) { const int n = (lane >> 3) + 8 * j; const LAS float* s = scr + (8 * c8) * 33 + n;
                u32x4 o; o.x = pk2(s[0 * 33], s[1 * 33]); o.y = pk2(s[2 * 33], s[3 * 33]); o.z = pk2(s[4 * 33], s[5 * 33]); o.w = pk2(s[6 * 33], s[7 * 33]);
                *(u32x4*)(dst + (size_t)(n0 + n) * K + k0 + 8 * c8) = o; }
        }
    }
    {
        bf16_t* BT2 = (bf16_t*)(p.ws + WS_BT2);
        for (int idx = blockIdx.x * 512 + tid; idx < 2 * N2 * A2K; idx += gridDim.x * 512) {
            const int l = idx / (N2 * A2K), rem = idx % (N2 * A2K), n = rem / A2K, k = rem % A2K, pn = n >> 8, cc = n & 255;
            float v = 0.f;
            if (pn < 4) { const int dir = pn >> 1, gate = cc >> 7, c = (pn & 1) * 128 + (cc & 127), nb = c >> 6, o = c & 63;
                if (k < 256 && (k >> 6) == nb) v = pin(p, 9)[((size_t)((((l * 2 + dir) * 2 + gate) * 4 + nb) * 64 + (k & 63))) * 64 + o]; }
            else if (pn < 8) { const int q = pn - 4, kind = q >> 1, d = q & 1, kb = 256 + kind * 64 + d * 32;
                if (k >= kb && k < kb + 32) v = (kind ? pin(p, 22) : pin(p, 20))[(size_t)((l * 2 + d) * 32 + (k - kb)) * 256 + cc]; }
            else { if (k >= 384) v = pin(p, 23)[(size_t)(l * 64 + (k - 384)) * 256 + cc]; }
            BT2[idx] = f2bf(v);
        }
        if (DBG_PROBE && blockIdx.x == 0 && tid < 32) ((unsigned*)(p.ws + WS_DBG))[tid] = 0u;
        if (blockIdx.x == 0) for (int i = tid; i < 1024; i += 512) ((float*)(p.ws + WS_SPT))[i] = -8.f * softplusf_(-pin(p, 11)[i]);
    }
}
__device__ __forceinline__ void row_pass(int wv, const bf16_t* O, const float* g1, const float* xres_f, const bf16_t* xres_b, float* xout_f, bf16_t* xout_b, const float* g2, bf16_t* hb) {
    const int tid = otid(wv); const int lane = tid & 63, gw = blockIdx.x * 8 + (tid >> 6), nw = gridDim.x * 8;
    f32x4 g1v[4], g2v[4];
#pragma unroll
    for (int j = 0; j < 4; ++j) { g1v[j] = g1 ? *((const f32x4*)g1 + lane + 64 * j) : (f32x4){0.f, 0.f, 0.f, 0.f}; g2v[j] = g2 ? *((const f32x4*)g2 + lane + 64 * j) : (f32x4){0.f, 0.f, 0.f, 0.f}; }
    u32x4 xf[4]; u32x2 xb[4], ob[4];
#define RP_LOAD(ROW) do { const int _r = (ROW) < T_TOK ? (ROW) : gw; \
        if (xres_f) { const u32x4* xp = (const u32x4*)(xres_f + (size_t)_r * DM) + lane; _Pragma("unroll") for (int j = 0; j < 4; ++j) xf[j] = xp[64 * j]; } \
        else { const bf16_t* xp = xres_b + (size_t)_r * DM + 4 * lane; _Pragma("unroll") for (int j = 0; j < 4; ++j) xb[j] = *(const u32x2*)(xp + 256 * j); } \
        if (O) { const bf16_t* op = O + (size_t)_r * DM + 4 * lane; _Pragma("unroll") for (int j = 0; j < 4; ++j) ob[j] = *(const u32x2*)(op + 256 * j); } } while (0)
    RP_LOAD(gw);
    for (int row = gw; row < T_TOK; row += nw) {
        f32x4 v[4], o[4];
#pragma unroll
        for (int j = 0; j < 4; ++j) { if (xres_f) { v[j].x = __uint_as_float(xf[j].x); v[j].y = __uint_as_float(xf[j].y); v[j].z = __uint_as_float(xf[j].z); v[j].w = __uint_as_float(xf[j].w); } else v[j] = bf4(xb[j]);
            if (O) o[j] = bf4(ob[j]); }
        RP_LOAD(row + nw);
        if (O) {
            float ss = 0.f;
#pragma unroll
            for (int j = 0; j < 4; ++j) ss += hsum4(o[j] * o[j]);
            const float inv = rsqrtf(red64(ss) * (1.f / DM) + 1e-6f);
#pragma unroll
            for (int j = 0; j < 4; ++j) v[j] = v[j] + o[j] * inv * g1v[j];
            if (xout_f) { f32x4* xo = (f32x4*)(xout_f + (size_t)row * DM) + lane;
#pragma unroll
                for (int j = 0; j < 4; ++j) xo[64 * j] = v[j]; }
            else { bf16_t* xo = xout_b + (size_t)row * DM + 4 * lane;
#pragma unroll
                for (int j = 0; j < 4; ++j) st4bf(xo + 256 * j, v[j]); }
        }
        if (g2) {
            float ss = 0.f;
#pragma unroll
            for (int j = 0; j < 4; ++j) ss += hsum4(v[j] * v[j]);
            const float inv = rsqrtf(red64(ss) * (1.f / DM) + 1e-6f);
            bf16_t* hp = hb + (size_t)row * DM;
#pragma unroll
            for (int j = 0; j < 4; ++j) st4bf(hp + 4 * (lane + 64 * j), v[j] * inv * g2v[j]);
        }
    }
#undef RP_LOAD
}

__device__ __forceinline__ void phase_prepass(const Params& p, int l, const XcdBarrier& xbar, int wv) {
    const int tid = otid(wv); const int lane = tid & 63, gw = blockIdx.x * 8 + (tid >> 6);
    bf16_t* U = (bf16_t*)(p.ws + WS_U); float* G = (float*)(p.ws + WS_G); bf16_t* A2 = (bf16_t*)((unsigned char*)p.out + OUT_A2);
    const int tok0 = gw * 16, t0 = tok0 & (SEQ - 1), c = 4 * lane;
    const u32x2 zz = (u32x2){0u, 0u};
    u32x2 rq[19], rk[19], rv[19];
#pragma unroll
    for (int i = 0; i < 19; ++i) { const int ts = t0 - 2 + i; const bool ok = (ts >= 0 && ts < SEQ) && gw < 2048;
        const bf16_t* up = U + (size_t)(ok ? tok0 - 2 + i : 0) * NU + 512 + c;
        rq[i] = ok ? *(const u32x2*)up : zz; rk[i] = ok ? *(const u32x2*)(up + 256) : zz; rv[i] = ok ? *(const u32x2*)(up + 512) : zz; }
    xcd_barrier(xbar, wv);
    if (gw >= 2048) return;
    {
        const float* cw = pin(p, 12) + (size_t)l * 4 * 768 + c;
        f32x4 wq[4], wk[4], wv[4];
#pragma unroll
        for (int j = 0; j < 4; ++j) { wq[j] = *(const f32x4*)(cw + j * 768); wk[j] = *(const f32x4*)(cw + j * 768 + 256); wv[j] = *(const f32x4*)(cw + j * 768 + 512); }
#pragma unroll
        for (int i = 0; i < 16; ++i) {
            f32x4 aq = (f32x4){0.f, 0.f, 0.f, 0.f}, ak = aq, av = aq;
#pragma unroll
            for (int j = 0; j < 4; ++j) { aq += wq[j] * bf4(rq[i + j]); ak += wk[j] * bf4(rk[i + j]); av += wv[j] * bf4(rv[i + j]); }
#pragma unroll
            for (int e = 0; e < 4; ++e) { aq[e] = siluf_(aq[e]); ak[e] = siluf_(ak[e]); av[e] = siluf_(av[e]); }
            const float sq = red16(hsum4(aq * aq)), sk = red16(hsum4(ak * ak));
            aq = aq * (rsqrtf(sq + 1e-6f) * 0.125f); ak = ak * rsqrtf(sk + 1e-6f);
            bf16_t* up = U + (size_t)(tok0 + i) * NU + 512 + c;
            st4bf(up, aq); st4bf(up + 256, ak); st4bf(up + 512, av);
        }
    }
    __builtin_amdgcn_sched_barrier(0);
    {
        f32x4 cwv[4];
#pragma unroll
        for (int j = 0; j < 4; ++j) cwv[j] = *(const f32x4*)(pin(p, 7) + (size_t)l * 1024 + j * 256 + c);
        const f32x4 cb = *(const f32x4*)(pin(p, 8) + (size_t)l * 256 + c);
#pragma unroll
        for (int hh = 0; hh < 2; ++hh) {
            u32x2 rx[11];
#pragma unroll
            for (int i = 0; i < 11; ++i) { const int ts = t0 + hh * 8 - 2 + i; rx[i] = (ts >= 0 && ts < SEQ) ? *(const u32x2*)(U + (size_t)(tok0 + hh * 8 - 2 + i) * NU + c) : zz; }
#pragma unroll
            for (int i = 0; i < 8; ++i) { f32x4 xc = cb;
#pragma unroll
                for (int j = 0; j < 4; ++j) xc += cwv[j] * bf4(rx[i + j]);
                st4bf(A2 + (size_t)(tok0 + hh * 8 + i) * A2K + c, xc); }
        }
    }
    __builtin_amdgcn_sched_barrier(0);
    {
        const int ti = lane >> 2, kind = lane & 3;
        float* gp = G + (size_t)(tok0 + ti) * NGATE + kind * 8;
        f32x4 v0 = *(const f32x4*)gp, v1 = *(const f32x4*)(gp + 4);
        float v[8] = {v0.x, v0.y, v0.z, v0.w, v1.x, v1.y, v1.z, v1.w};
#pragma unroll
        for (int e = 0; e < 8; ++e) {
            if (kind == 0) v[e] = __expf(-__expf(pin(p, 13)[l * 8 + e]) * softplusf_(v[e] + pin(p, 14)[l * 8 + e]));
            else if (kind == 1) v[e] = sigmoidf_(v[e]);
            else if (kind == 2) v[e] = __expf(15.f * tanhf_((v[e] + pin(p, 16)[l * 16 + (e >> 2) * 8 + (e & 3)]) * (1.f / 15.f)));
            else v[e] = sigmoidf_(15.f * tanhf_((v[e] + pin(p, 16)[l * 16 + (e >> 2) * 8 + 4 + (e & 3)]) * (1.f / 15.f)));
        }
        *(f32x4*)gp = (f32x4){v[0], v[1], v[2], v[3]}; *(f32x4*)(gp + 4) = (f32x4){v[4], v[5], v[6], v[7]};
    }
    __builtin_amdgcn_sched_barrier(0);
    if (lane < 48) {
        const float* mu0 = pin(p, 18) + (size_t)l * 2 * 960; const float* mu1 = mu0 + 960;
        const int lc = lane * 4;
        const f32x4 ml0 = *(const f32x4*)(mu0 + 768 + lc), ml1 = *(const f32x4*)(mu1 + 768 + lc);
        const f32x4 z4 = (f32x4){0.f, 0.f, 0.f, 0.f};
#pragma unroll
        for (int hh = 0; hh < 2; ++hh) {
            f32x4 gr[10];
#pragma unroll
            for (int i = 0; i < 10; ++i) { const int ts = t0 + hh * 8 - 1 + i; gr[i] = (ts >= 0 && ts < SEQ) ? *(const f32x4*)(G + (size_t)(tok0 + hh * 8 - 1 + i) * NGATE + 32 + lc) : z4; }
#pragma unroll
            for (int i = 0; i < 8; ++i) { const f32x4 cur = gr[i + 1]; f32x4 lr = cur + ml0 * (gr[i] - cur) + ml1 * (gr[i + 2] - cur);
                if (lane < 16) { lr.x = tanhf_(lr.x); lr.y = tanhf_(lr.y); lr.z = tanhf_(lr.z); lr.w = tanhf_(lr.w); }
                else if (lane >= 32) { lr.x = sigmoidf_(lr.x); lr.y = sigmoidf_(lr.y); lr.z = sigmoidf_(lr.z); lr.w = sigmoidf_(lr.w); }
                st4bf(A2 + (size_t)(tok0 + hh * 8 + i) * A2K + 256 + lc, lr); }
        }
    }
}

constexpr int TT = 32, NTILE = SEQ / TT, TS = TT * 64;
__device__ __forceinline__ float sum8l(float x) { x += dppf<0xB1>(x); x += dppf<0x4E>(x); x += dppf<0x141>(x); return x; }
#define TILE_T0(i) ((dir ? NTILE - 1 - (i) : (i)) * TT)

template <int DIRC> __device__ __forceinline__ void gdn_task(const Params& p, int l, int b, int h, LAS float* sm, int wv) {
    constexpr int dir = DIRC;
    constexpr int BUF = 3 * TS + 64;
    const int tid = otid(wv), wave = tid >> 6, lane = tid & 63;
    LAS float* Os0 = sm + 2 * BUF;
    const bf16_t* U = (const bf16_t*)(p.ws + WS_U); const float* G = (const float*)(p.ws + WS_G); bf16_t* SC = (bf16_t*)(p.ws + WS_SC);
    const int ptid = tid - 256, pt = (ptid >> 4) & 15, c4 = (ptid & 15) * 4;
    const int row = (wave & 3) * 16 + (lane >> 2), sub = lane & 3;
    f32x4 s4[4];
#pragma unroll
    for (int j = 0; j < 4; ++j) s4[j] = (f32x4){0.f, 0.f, 0.f, 0.f};
    u32x2 rq[2], rk[2], rv[2]; float gbp[2]; float ga = 0.f, gb = 0.f;
#define GDN_LOADRAW(T0) do { _Pragma("unroll") for (int hh = 0; hh < 2; ++hh) { const size_t tok = (size_t)(b * SEQ + (T0) + pt + 16 * hh); const bf16_t* up = U + tok * NU + 512 + h * 64 + c4; \
            rq[hh] = *(const u32x2*)up; rk[hh] = *(const u32x2*)(up + 256); rv[hh] = *(const u32x2*)(up + 512); gbp[hh] = G[tok * NGATE + 8 + dir * 4 + h]; } \
        if (ptid < TT) { const float* gp = G + (size_t)(b * SEQ + (T0) + ptid) * NGATE; ga = gp[dir * 4 + h]; gb = gp[8 + dir * 4 + h]; } } while (0)
#define GDN_PREP(BI) do { LAS float* Qs = sm + (BI) * BUF; _Pragma("unroll") for (int hh = 0; hh < 2; ++hh) { const int o = (pt + 16 * hh) * 64 + c4; \
            *(LAS f32x4*)(Qs + o) = bf4(rq[hh]); *(LAS f32x4*)(Qs + TS + o) = bf4(rk[hh]); *(LAS f32x4*)(Qs + 2 * TS + o) = bf4(rv[hh]) * gbp[hh]; } \
        if (ptid < TT) { Qs[3 * TS + ptid * 2] = ga; Qs[3 * TS + ptid * 2 + 1] = gb * ga; } } while (0)
#define GDN_WRITEOUT(T0, BI) do { _Pragma("unroll") for (int hh = 0; hh < 2; ++hh) \
        st4bf(SC + (size_t)(b * SEQ + (T0) + pt + 16 * hh) * NSC + 512 + dir * 256 + h * 64 + c4, *(const LAS f32x4*)(Os0 + (BI) * TS + (pt + 16 * hh) * 64 + c4)); } while (0)
    if (wave >= 4) { GDN_LOADRAW(TILE_T0(0)); GDN_PREP(0); GDN_LOADRAW(TILE_T0(1)); }
    __syncthreads();
    for (int kt = 0; kt < NTILE; ++kt) {
        const int cur = kt & 1;
        if (wave < 4) {
            const LAS float* Qs = sm + cur * BUF; const LAS float* Ks = Qs + TS; const LAS float* Vs = Qs + 2 * TS; const LAS float* AB = Qs + 3 * TS; LAS float* Os = Os0 + cur * TS;
            f32x4 kA[4], qA[4], kB[4], qB[4]; float aA, bA, vA, aB, bB, vB;
#define GDN_LD(K_, Q_, A_, B_, V_, I_) do { const int _i = (I_) < TT ? (I_) : TT - 1; const int _tt = dir ? TT - 1 - _i : _i; const LAS float* kp = Ks + _tt * 64 + 4 * sub; const LAS float* qp = Qs + _tt * 64 + 4 * sub; \
        _Pragma("unroll") for (int j = 0; j < 4; ++j) { K_[j] = *(const LAS f32x4*)(kp + 16 * j); Q_[j] = *(const LAS f32x4*)(qp + 16 * j); } \
        A_ = AB[_tt * 2]; B_ = AB[_tt * 2 + 1]; V_ = Vs[_tt * 64 + row]; } while (0)
#define GDN_STEP(K_, Q_, A_, B_, V_, U_) do { f32x4 d4 = s4[0] * K_[0]; d4 += s4[1] * K_[1]; d4 += s4[2] * K_[2]; d4 += s4[3] * K_[3]; \
        const float d = sum4l(hsum4(d4)); const float c = V_ - B_ * d; \
        _Pragma("unroll") for (int j = 0; j < 4; ++j) s4[j] = s4[j] * A_ + K_[j] * c; \
        f32x4 o4 = s4[0] * Q_[0]; o4 += s4[1] * Q_[1]; o4 += s4[2] * Q_[2]; o4 += s4[3] * Q_[3]; \
        const float o = sum4l(hsum4(o4)); okeep = (sub == (U_)) ? o : okeep; } while (0)
            GDN_LD(kA, qA, aA, bA, vA, 0);
            for (int gq = 0; gq < TT / 4; ++gq) {
                float okeep = 0.f; const int i0 = gq * 4;
                GDN_LD(kB, qB, aB, bB, vB, i0 + 1); GDN_STEP(kA, qA, aA, bA, vA, 0);
                GDN_LD(kA, qA, aA, bA, vA, i0 + 2); GDN_STEP(kB, qB, aB, bB, vB, 1);
                GDN_LD(kB, qB, aB, bB, vB, i0 + 3); GDN_STEP(kA, qA, aA, bA, vA, 2);
                GDN_LD(kA, qA, aA, bA, vA, i0 + 4); GDN_STEP(kB, qB, aB, bB, vB, 3);
                const int is = i0 + sub, tts = dir ? TT - 1 - is : is;
                Os[tts * 64 + row] = okeep;
            }
#undef GDN_LD
#undef GDN_STEP
        } else {
            if (kt > 0) GDN_WRITEOUT(TILE_T0(kt - 1), cur ^ 1);
            if (kt + 1 < NTILE) GDN_PREP(cur ^ 1);
            if (kt + 2 < NTILE) GDN_LOADRAW(TILE_T0(kt + 2));
        }
        __syncthreads();
    }
    if (wave >= 4) GDN_WRITEOUT(TILE_T0(NTILE - 1), (NTILE - 1) & 1);
#undef GDN_LOADRAW
#undef GDN_PREP
#undef GDN_WRITEOUT
    __syncthreads();
}

template <int DIRC> __device__ __forceinline__ void mlstm_task(const Params& p, int l, int b, int h, LAS float* sm, int wv) {
    constexpr int dir = DIRC;
    constexpr int BUF = 3 * TS + 64;
    const int tid = otid(wv), wave = tid >> 6, lane = tid & 63;
    LAS float* Os0 = sm + 2 * BUF; LAS float* Dn0 = Os0 + 2 * TS; LAS float* LA0 = Dn0 + 2 * TS; LAS float* LB0 = LA0 + 2 * TS;
    const bf16_t* U = (const bf16_t*)(p.ws + WS_U); const float* G = (const float*)(p.ws + WS_G); bf16_t* SC = (bf16_t*)(p.ws + WS_SC); const bf16_t* ACT = (const bf16_t*)(p.ws + WS_ACT);
    const int ptid = tid - 384, pt = (ptid >> 4) & 7, c4 = (ptid & 15) * 4;
    const int row = (wave & 3) * 16 + (lane >> 2), sub = lane & 3;
    const int lr8 = lane >> 3, lc8 = (lane & 7) * 8;
    constexpr int NQ = TT / 8;
    f32x4 s4[4];
#pragma unroll
    for (int j = 0; j < 4; ++j) s4[j] = (f32x4){0.f, 0.f, 0.f, 0.f};
    float nst = 0.f, hst = 0.f;
    u32x2 rq[4], rk[4], rv[4]; float gip[4]; float gi = 0.f, gf = 0.f; u32x4 la4[NQ], lb4[NQ];
#define ML_LOADRAW(T0) do { _Pragma("unroll") for (int hh = 0; hh < 4; ++hh) { const size_t tok = (size_t)(b * SEQ + (T0) + pt + 8 * hh); const bf16_t* up = U + tok * NU + 1536 + h * 64 + c4; \
            rq[hh] = *(const u32x2*)up; rk[hh] = *(const u32x2*)(up + 256); rv[hh] = *(const u32x2*)(up + 512); gip[hh] = G[tok * NGATE + 16 + dir * 4 + h]; } \
        if (ptid < TT) { const float* gp = G + (size_t)(b * SEQ + (T0) + ptid) * NGATE + 16; gi = gp[dir * 4 + h]; gf = gp[8 + dir * 4 + h]; } } while (0)
#define ML_PREP(BI) do { LAS float* Qs = sm + (BI) * BUF; _Pragma("unroll") for (int hh = 0; hh < 4; ++hh) { const int o = (pt + 8 * hh) * 64 + c4; \
            *(LAS f32x4*)(Qs + o) = bf4(rq[hh]); *(LAS f32x4*)(Qs + TS + o) = bf4(rk[hh]) * 0.125f; *(LAS f32x4*)(Qs + 2 * TS + o) = bf4(rv[hh]) * gip[hh]; } \
        if (ptid < TT) { Qs[3 * TS + ptid * 2] = gf; Qs[3 * TS + ptid * 2 + 1] = gi; } } while (0)
#define ML_WRITEOUT(T0, BI) do { _Pragma("unroll") for (int hh = 0; hh < 4; ++hh) { const int o = (pt + 8 * hh) * 64 + c4; \
            const float den = red16(hsum4(*(const LAS f32x4*)(Dn0 + (BI) * TS + o))); const float sc = __builtin_amdgcn_rcpf(fmaxf(fabsf(den), 1.f)); \
            st4bf(SC + (size_t)(b * SEQ + (T0) + pt + 8 * hh) * NSC + 1024 + dir * 256 + h * 64 + c4, *(const LAS f32x4*)(Os0 + (BI) * TS + o) * sc); } } while (0)
#define LRU_LOADRAW(T0) do { _Pragma("unroll") for (int q = 0; q < NQ; ++q) { const size_t tok = (size_t)(b * SEQ + (T0) + q * 8 + lr8); \
            la4[q] = *(const u32x4*)(ACT + tok * DM + dir * 256 + h * 64 + lc8); lb4[q] = *(const u32x4*)(SC + tok * NSC + dir * 256 + h * 64 + lc8); } } while (0)
#define LRU_PREP(BI) do { _Pragma("unroll") for (int q = 0; q < NQ; ++q) { const int o = (BI) * TS + (q * 8 + lr8) * 64 + lc8; \
            f32x4 a0 = bf4((u32x2){la4[q].x, la4[q].y}), a1 = bf4((u32x2){la4[q].z, la4[q].w}); \
            _Pragma("unroll") for (int e = 0; e < 4; ++e) { a0[e] = 1.f - a0[e]; a1[e] = 1.f - a1[e]; } \
            *(LAS f32x4*)(LA0 + o) = a0; *(LAS f32x4*)(LA0 + o + 4) = a1; \
            *(LAS f32x4*)(LB0 + o) = bf4((u32x2){lb4[q].x, lb4[q].y}); *(LAS f32x4*)(LB0 + o + 4) = bf4((u32x2){lb4[q].z, lb4[q].w}); } } while (0)
#define LRU_WRITEOUT(T0, BI) do { _Pragma("unroll") for (int q = 0; q < NQ; ++q) { const int o = (BI) * TS + (q * 8 + lr8) * 64 + lc8; const f32x4 h0 = *(const LAS f32x4*)(LA0 + o), h1 = *(const LAS f32x4*)(LA0 + o + 4); \
            u32x4 w; w.x = pk2(h0.x, h0.y); w.y = pk2(h0.z, h0.w); w.z = pk2(h1.x, h1.y); w.w = pk2(h1.z, h1.w); \
            *(u32x4*)(SC + (size_t)(b * SEQ + (T0) + q * 8 + lr8) * NSC + dir * 256 + h * 64 + lc8) = w; } } while (0)
    if (wave >= 6) { ML_LOADRAW(TILE_T0(0)); ML_PREP(0); ML_LOADRAW(TILE_T0(1)); }
    else if (wave == 5) { LRU_LOADRAW(TILE_T0(0)); LRU_PREP(0); LRU_LOADRAW(TILE_T0(1)); }
    __syncthreads();
    for (int kt = 0; kt < NTILE; ++kt) {
        const int cur = kt & 1;
        const LAS float* Qs = sm + cur * BUF; const LAS float* Ks = Qs + TS; const LAS float* Vs = Qs + 2 * TS; const LAS float* FI = Qs + 3 * TS;
        if (wave < 4) {
            LAS float* Os = Os0 + cur * TS;
            f32x4 kA[4], qA[4], kB[4], qB[4]; float fA, vA, fB, vB;
#define ML_LD(K_, Q_, F_, V_, I_) do { const int _i = (I_) < TT ? (I_) : TT - 1; const int _tt = dir ? TT - 1 - _i : _i; const LAS float* kp = Ks + _tt * 64 + 4 * sub; const LAS float* qp = Qs + _tt * 64 + 4 * sub; \
        _Pragma("unroll") for (int j = 0; j < 4; ++j) { K_[j] = *(const LAS f32x4*)(kp + 16 * j); Q_[j] = *(const LAS f32x4*)(qp + 16 * j); } \
        F_ = FI[_tt * 2]; V_ = Vs[_tt * 64 + row]; } while (0)
#define ML_STEP(K_, Q_, F_, V_, U_) do { _Pragma("unroll") for (int j = 0; j < 4; ++j) s4[j] = s4[j] * F_ + K_[j] * V_; \
        f32x4 o4 = s4[0] * Q_[0]; o4 += s4[1] * Q_[1]; o4 += s4[2] * Q_[2]; o4 += s4[3] * Q_[3]; \
        const float o = sum4l(hsum4(o4)); okeep = (sub == (U_)) ? o : okeep; } while (0)
            ML_LD(kA, qA, fA, vA, 0);
            for (int gq = 0; gq < TT / 4; ++gq) {
                float okeep = 0.f; const int i0 = gq * 4;
                ML_LD(kB, qB, fB, vB, i0 + 1); ML_STEP(kA, qA, fA, vA, 0);
                ML_LD(kA, qA, fA, vA, i0 + 2); ML_STEP(kB, qB, fB, vB, 1);
                ML_LD(kB, qB, fB, vB, i0 + 3); ML_STEP(kA, qA, fA, vA, 2);
                ML_LD(kA, qA, fA, vA, i0 + 4); ML_STEP(kB, qB, fB, vB, 3);
                const int is = i0 + sub, tts = dir ? TT - 1 - is : is;
                Os[tts * 64 + row] = okeep;
            }
#undef ML_LD
#undef ML_STEP
        } else if (wave == 4) {
            LAS float* Dn = Dn0 + cur * TS;
#pragma unroll 8
            for (int i = 0; i < TT; ++i) { const int tt = dir ? TT - 1 - i : i;
                nst = nst * FI[tt * 2] + FI[tt * 2 + 1] * Ks[tt * 64 + lane];
                Dn[tt * 64 + lane] = nst * Qs[tt * 64 + lane]; }
        } else if (wave == 5) {
            if (kt > 0) LRU_WRITEOUT(TILE_T0(kt - 1), cur ^ 1);
            if (kt + 1 < NTILE) LRU_PREP(cur ^ 1);
            if (kt + 2 < NTILE) LRU_LOADRAW(TILE_T0(kt + 2));
            LAS float* LA = LA0 + cur * TS; const LAS float* LB = LB0 + cur * TS;
#pragma unroll 8
            for (int i = 0; i < TT; ++i) { const int tt = dir ? TT - 1 - i : i; hst = LA[tt * 64 + lane] * hst + LB[tt * 64 + lane]; LA[tt * 64 + lane] = hst; }
        } else {
            if (kt > 0) ML_WRITEOUT(TILE_T0(kt - 1), cur ^ 1);
            if (kt + 1 < NTILE) ML_PREP(cur ^ 1);
            if (kt + 2 < NTILE) ML_LOADRAW(TILE_T0(kt + 2));
        }
        __syncthreads();
    }
    if (wave >= 6) ML_WRITEOUT(TILE_T0(NTILE - 1), (NTILE - 1) & 1);
    else if (wave == 5) LRU_WRITEOUT(TILE_T0(NTILE - 1), (NTILE - 1) & 1);
#undef ML_LOADRAW
#undef ML_PREP
#undef ML_WRITEOUT
#undef LRU_LOADRAW
#undef LRU_PREP
#undef LRU_WRITEOUT
    __syncthreads();
}

template <int DIRC> __device__ __forceinline__ void rwkv_task(const Params& p, int l, int b, int h, int half, LAS float* sm, int wv) {
    constexpr int dir = DIRC;
    constexpr int BUF = 6 * TS;
    const int tid = otid(wv), wave = tid >> 6, lane = tid & 63;
    LAS float* Os0 = sm + 2 * BUF;
    const bf16_t* U = (const bf16_t*)(p.ws + WS_U); const bf16_t* Gb = (const bf16_t*)(p.ws + WS_G); bf16_t* SC = (bf16_t*)(p.ws + WS_SC); const bf16_t* ACT = (const bf16_t*)(p.ws + WS_ACT);
    const int ptid = tid - 256, pt = (ptid >> 4) & 15, c4 = (ptid & 15) * 4, hc = h * 64 + c4;
    const float* mu0 = pin(p, 18) + (size_t)l * 2 * 960; const float* mu1 = mu0 + 960;
    const f32x4 mr0 = *(const f32x4*)(mu0 + hc), mr1 = *(const f32x4*)(mu1 + hc), mk0 = *(const f32x4*)(mu0 + 256 + hc), mk1 = *(const f32x4*)(mu1 + 256 + hc),
                mv0 = *(const f32x4*)(mu0 + 512 + hc), mv1 = *(const f32x4*)(mu1 + 512 + hc);
    const f32x4 kkv = *(const f32x4*)(pin(p, 24) + (size_t)l * 256 + hc), kav = *(const f32x4*)(pin(p, 25) + (size_t)l * 256 + hc);
    const int row = half * 32 + (wave & 3) * 8 + (lane >> 3), sub = lane & 7;
    f32x4 s4[2];
    s4[0] = (f32x4){0.f, 0.f, 0.f, 0.f}; s4[1] = s4[0];
    const u32x2 zz = (u32x2){0u, 0u};
    u32x2 rc[2], rp[2], rn[2], kc[2], kp_[2], kn[2], vc[2], vp[2], vn[2], ew[2], aa[2];
#define RW_LOADRAW(T0) do { _Pragma("unroll") for (int hh = 0; hh < 2; ++hh) { const int _t = (T0) + pt + 16 * hh; const bool hp = _t > 0, hn = _t < SEQ - 1; const size_t tok = (size_t)(b * SEQ + _t); \
        const bf16_t* up = U + tok * NU + 2560 + hc; \
        rc[hh] = *(const u32x2*)up; rp[hh] = hp ? *(const u32x2*)(up - NU) : zz; rn[hh] = hn ? *(const u32x2*)(up + NU) : zz; \
        kc[hh] = *(const u32x2*)(up + 256); kp_[hh] = hp ? *(const u32x2*)(up + 256 - NU) : zz; kn[hh] = hn ? *(const u32x2*)(up + 256 + NU) : zz; \
        vc[hh] = *(const u32x2*)(up + 512); vp[hh] = hp ? *(const u32x2*)(up + 512 - NU) : zz; vn[hh] = hn ? *(const u32x2*)(up + 512 + NU) : zz; \
        ew[hh] = dir ? *(const u32x2*)(Gb + tok * 512 + 64 + hc) : *(const u32x2*)(U + tok * NU + hc); \
        aa[hh] = *(const u32x2*)(ACT + tok * DM + 512 + dir * 256 + hc); } } while (0)
#define RW_PREP(BI) do { LAS float* Rs = sm + (BI) * BUF; _Pragma("unroll") for (int hh = 0; hh < 2; ++hh) { \
            f32x4 c = bf4(rc[hh]); const f32x4 rr = c + mr0 * (bf4(rp[hh]) - c) + mr1 * (bf4(rn[hh]) - c); \
            c = bf4(kc[hh]); const f32x4 kk = c + mk0 * (bf4(kp_[hh]) - c) + mk1 * (bf4(kn[hh]) - c); \
            c = bf4(vc[hh]); const f32x4 vv = c + mv0 * (bf4(vp[hh]) - c) + mv1 * (bf4(vn[hh]) - c); \
            f32x4 w = bf4(ew[hh]); const f32x4 a = bf4(aa[hh]); \
            _Pragma("unroll") for (int e = 0; e < 4; ++e) w[e] = __expf(w[e]); \
            f32x4 kn_ = kk * kkv; const float ss = red16(hsum4(kn_ * kn_)); kn_ = kn_ * rsqrtf(ss + 1e-6f); \
            const int o = (pt + 16 * hh) * 64 + c4; \
            *(LAS f32x4*)(Rs + o) = rr; *(LAS f32x4*)(Rs + TS + o) = w; *(LAS f32x4*)(Rs + 2 * TS + o) = kn_; \
            *(LAS f32x4*)(Rs + 3 * TS + o) = kn_ * a; *(LAS f32x4*)(Rs + 4 * TS + o) = kk * (1.f + (a - 1.f) * kav); *(LAS f32x4*)(Rs + 5 * TS + o) = vv; } } while (0)
#define RW_WRITEOUT(T0, BI) do { const int t = (ptid >> 3) & 31, r4 = half * 32 + (ptid & 7) * 4; const f32x4 o = *(const LAS f32x4*)(Os0 + (BI) * TS + t * 64 + r4); \
        u32x2 w; w.x = pk2(o.x, o.y); w.y = pk2(o.z, o.w); *(u32x2*)(SC + (size_t)(b * SEQ + (T0) + t) * NSC + 1536 + dir * 256 + h * 64 + r4) = w; } while (0)
    if (wave >= 4) { RW_LOADRAW(TILE_T0(0)); RW_PREP(0); RW_LOADRAW(TILE_T0(1)); }
    __syncthreads();
    for (int kt = 0; kt < NTILE; ++kt) {
        const int cur = kt & 1;
        if (wave < 4) {
            const LAS float* Rs = sm + cur * BUF; const LAS float* Ws = Rs + TS; const LAS float* KKs = Rs + 2 * TS; const LAS float* KAs = Rs + 3 * TS; const LAS float* KDs = Rs + 4 * TS; const LAS float* Vs = Rs + 5 * TS;
            LAS float* Os = Os0 + cur * TS;
            f32x4 wA[2], nA[2], aA[2], dA[2], rA[2], wB[2], nB[2], aB[2], dB[2], rB[2]; float vA, vB;
#define RW_LD(W_, N_, A_, D_, R_, V_, I_) do { const int _i = (I_) < TT ? (I_) : TT - 1; const int _tt = dir ? TT - 1 - _i : _i; const int o = _tt * 64 + 4 * sub; \
        _Pragma("unroll") for (int j = 0; j < 2; ++j) { W_[j] = *(const LAS f32x4*)(Ws + o + 32 * j); N_[j] = *(const LAS f32x4*)(KKs + o + 32 * j); A_[j] = *(const LAS f32x4*)(KAs + o + 32 * j); \
            D_[j] = *(const LAS f32x4*)(KDs + o + 32 * j); R_[j] = *(const LAS f32x4*)(Rs + o + 32 * j); } \
        V_ = Vs[_tt * 64 + row]; } while (0)
#define RW_STEP(W_, N_, A_, D_, R_, V_, U_) do { f32x4 x4 = s4[0] * N_[0]; x4 += s4[1] * N_[1]; const float sa = -sum8l(hsum4(x4)); \
        _Pragma("unroll") for (int j = 0; j < 2; ++j) s4[j] = s4[j] * W_[j] + A_[j] * sa + D_[j] * V_; \
        f32x4 o4 = s4[0] * R_[0]; o4 += s4[1] * R_[1]; const float o = sum8l(hsum4(o4)); okeep = (sub == (U_)) ? o : okeep; } while (0)
            RW_LD(wA, nA, aA, dA, rA, vA, 0);
            for (int gq = 0; gq < TT / 8; ++gq) {
                float okeep = 0.f; const int i0 = gq * 8;
                RW_LD(wB, nB, aB, dB, rB, vB, i0 + 1); RW_STEP(wA, nA, aA, dA, rA, vA, 0);
                RW_LD(wA, nA, aA, dA, rA, vA, i0 + 2); RW_STEP(wB, nB, aB, dB, rB, vB, 1);
                RW_LD(wB, nB, aB, dB, rB, vB, i0 + 3); RW_STEP(wA, nA, aA, dA, rA, vA, 2);
                RW_LD(wA, nA, aA, dA, rA, vA, i0 + 4); RW_STEP(wB, nB, aB, dB, rB, vB, 3);
                RW_LD(wB, nB, aB, dB, rB, vB, i0 + 5); RW_STEP(wA, nA, aA, dA, rA, vA, 4);
                RW_LD(wA, nA, aA, dA, rA, vA, i0 + 6); RW_STEP(wB, nB, aB, dB, rB, vB, 5);
                RW_LD(wB, nB, aB, dB, rB, vB, i0 + 7); RW_STEP(wA, nA, aA, dA, rA, vA, 6);
                RW_LD(wA, nA, aA, dA, rA, vA, i0 + 8); RW_STEP(wB, nB, aB, dB, rB, vB, 7);
                const int is = i0 + sub, tts = dir ? TT - 1 - is : is;
                Os[tts * 64 + row] = okeep;
            }
#undef RW_LD
#undef RW_STEP
        } else {
            if (kt > 0) RW_WRITEOUT(TILE_T0(kt - 1), cur ^ 1);
            if (kt + 1 < NTILE) RW_PREP(cur ^ 1);
            if (kt + 2 < NTILE) RW_LOADRAW(TILE_T0(kt + 2));
        }
        __syncthreads();
    }
    if (wave >= 4) RW_WRITEOUT(TILE_T0(NTILE - 1), (NTILE - 1) & 1);
#undef RW_LOADRAW
#undef RW_PREP
#undef RW_WRITEOUT
    __syncthreads();
}

__device__ __forceinline__ void phase_scan(const Params& p, int l, LAS float* sm, int wv) {
    for (int task = blockIdx.x; task < 256; task += gridDim.x) {
        if (DBG_PROBE && otid(wv) == 0) ((LAS unsigned*)sm)[32760] = (unsigned)__builtin_amdgcn_s_memrealtime();
        if (task < 128) { const int half = task & 1, rest = task >> 1; if ((rest >> 3) & 1) rwkv_task<1>(p, l, rest & 7, rest >> 4, half, sm, wv); else rwkv_task<0>(p, l, rest & 7, rest >> 4, half, sm, wv); }
        else if (task < 192) { const int rest = task - 128; if ((rest >> 3) & 1) gdn_task<1>(p, l, rest & 7, rest >> 4, sm, wv); else gdn_task<0>(p, l, rest & 7, rest >> 4, sm, wv); }
        else { const int rest = task - 192; if ((rest >> 3) & 1) mlstm_task<1>(p, l, rest & 7, rest >> 4, sm, wv); else mlstm_task<0>(p, l, rest & 7, rest >> 4, sm, wv); }
        if (DBG_PROBE && l == 0 && otid(wv) == 0) { const unsigned dt = (unsigned)__builtin_amdgcn_s_memrealtime() - ((LAS unsigned*)sm)[32760]; atomicMax((unsigned*)(p.ws + WS_DBG) + (task < 128 ? 1 : (task < 192 ? 2 : 3)), dt); }
    }
}

struct FinRaw { u32x2 s[8], yb, z, og, r[3], k[3], v[3], gt; };
__device__ __forceinline__ void fin_load(FinRaw& R, const bf16_t* U, const bf16_t* GT, const bf16_t* SC, int tok, int c, int lane) {
    const int t = tok & (SEQ - 1); const bool hp = t > 0, hn = t < SEQ - 1; const u32x2 zz = (u32x2){0u, 0u};
    const bf16_t* u = U + (size_t)tok * NU; const bf16_t* sc = SC + (size_t)tok * NSC;
#pragma unroll
    for (int i = 0; i < 8; ++i) R.s[i] = *(const u32x2*)(sc + i * 256 + c);
    R.yb = *(const u32x2*)(u + 256 + c); R.z = *(const u32x2*)(u + 1280 + c); R.og = *(const u32x2*)(u + 2304 + c);
    const bf16_t* up = u + 2560 + c;
    R.r[0] = *(const u32x2*)up; R.r[1] = hp ? *(const u32x2*)(up - NU) : zz; R.r[2] = hn ? *(const u32x2*)(up + NU) : zz;
    R.k[0] = *(const u32x2*)(up + 256); R.k[1] = hp ? *(const u32x2*)(up + 256 - NU) : zz; R.k[2] = hn ? *(const u32x2*)(up + 256 + NU) : zz;
    R.v[0] = *(const u32x2*)(up + 512); R.v[1] = hp ? *(const u32x2*)(up + 512 - NU) : zz; R.v[2] = hn ? *(const u32x2*)(up + 512 + NU) : zz;
    R.gt = *(const u32x2*)(GT + (size_t)tok * 256 + c);
}
__device__ __forceinline__ void phase_finalize(const Params& p, int l, LAS float* sm, int wv) {
    const int tid = otid(wv), lane = tid & 63, wave = tid >> 6;
    const bf16_t* U = (const bf16_t*)(p.ws + WS_U); const bf16_t* GT = (const bf16_t*)((const unsigned char*)p.out + OUT_GT); const bf16_t* SC = (const bf16_t*)(p.ws + WS_SC); bf16_t* Y = (bf16_t*)(p.ws + WS_ACT);
    const int c = lane * 4, hc = c & 63;
    const f32x4 gdn_g = *(const f32x4*)(pin(p, 15) + (size_t)l * 64 + hc), ml_g = *(const f32x4*)(pin(p, 17) + (size_t)l * 256 + c);
    const float* mu0 = pin(p, 18) + (size_t)l * 2 * 960; const float* mu1 = mu0 + 960;
    const f32x4 mr0 = *(const f32x4*)(mu0 + c), mr1 = *(const f32x4*)(mu1 + c), mk0 = *(const f32x4*)(mu0 + 256 + c), mk1 = *(const f32x4*)(mu1 + 256 + c),
                mv0 = *(const f32x4*)(mu0 + 512 + c), mv1 = *(const f32x4*)(mu1 + 512 + c);
    const f32x4 rk = *(const f32x4*)(pin(p, 26) + (size_t)l * 256 + c), gnw = *(const f32x4*)(pin(p, 27) + (size_t)l * 256 + c), gnb = *(const f32x4*)(pin(p, 28) + (size_t)l * 256 + c);
    const f32x4 z4 = (f32x4){0.f, 0.f, 0.f, 0.f};
    const int gw = blockIdx.x * 8 + wave, nw = gridDim.x * 8;
    for (int tok0 = gw; tok0 < T_TOK; tok0 += 2 * nw) {
        FinRaw R[2];
        const int tok1 = tok0 + nw; const bool two = tok1 < T_TOK;
        fin_load(R[0], U, GT, SC, tok0, c, lane);
        fin_load(R[1], U, GT, SC, two ? tok1 : tok0, c, lane);
#pragma unroll
        for (int q = 0; q < 2; ++q) {
            if (q == 1 && !two) break;
            const FinRaw& X = R[q]; bf16_t* y = Y + (size_t)(q ? tok1 : tok0) * DM;
            { const f32x4 hh = bf4(X.s[0]) + bf4(X.s[1]), yb = bf4(X.yb); f32x4 o;
              for (int e = 0; e < 4; ++e) o[e] = hh[e] * gelu_tanh(yb[e]);
              st4bf(y + c, o); }
            { const f32x4 o = bf4(X.s[2]) + bf4(X.s[3]), z = bf4(X.z);
              const float inv = rsqrtf(red16(hsum4(o * o)) * (1.f / 64.f) + 1e-6f); f32x4 r;
              for (int e = 0; e < 4; ++e) r[e] = o[e] * inv * gdn_g[e] * siluf_(z[e]);
              st4bf(y + 256 + c, r); }
            { const f32x4 o = bf4(X.s[4]) + bf4(X.s[5]), og = bf4(X.og);
              const float inv = rsqrtf(red16(hsum4(o * o)) * (1.f / 64.f) + 1e-6f); f32x4 r;
              for (int e = 0; e < 4; ++e) r[e] = o[e] * inv * ml_g[e] * sigmoidf_(og[e]);
              st4bf(y + 512 + c, r); }
            {
                const f32x4 yy = bf4(X.s[6]) + bf4(X.s[7]);
                const float mean = red16(hsum4(yy)) * (1.f / 64.f); const f32x4 dv = yy - mean;
                const float var = red16(hsum4(dv * dv)) * (1.f / 64.f); const float inv = rsqrtf(var + 64e-5f);
                f32x4 cc = bf4(X.r[0]); const f32x4 rr = cc + mr0 * (bf4(X.r[1]) - cc) + mr1 * (bf4(X.r[2]) - cc);
                cc = bf4(X.k[0]); const f32x4 kk = cc + mk0 * (bf4(X.k[1]) - cc) + mk1 * (bf4(X.k[2]) - cc);
                cc = bf4(X.v[0]); const f32x4 vv = cc + mv0 * (bf4(X.v[1]) - cc) + mv1 * (bf4(X.v[2]) - cc);
                const float bsum = red16(hsum4(rr * kk * rk));
                f32x4 o;
                const f32x4 gate = bf4(X.gt);
                for (int e = 0; e < 4; ++e) o[e] = (dv[e] * inv * gnw[e] + gnb[e] + bsum * vv[e]) * gate[e];
                st4bf(y + 768 + c, o);
            }
        }
    }
    __syncthreads();
}

#ifndef EN_GEMM
#define EN_GEMM 1
#endif
#ifndef EN_SCAN
#define EN_SCAN 1
#endif
#ifndef EN_FIN
#define EN_FIN 1
#endif
#ifndef EN_ROW
#define EN_ROW 1
#endif
#ifndef REP_SCAN
#define REP_SCAN 1
#endif
#ifndef REP_GEMM
#define REP_GEMM 1
#endif
#ifndef DBG_PROBE
#define DBG_PROBE 0
#endif
__global__ void __launch_bounds__(512) mega(Params p) {
    extern __shared__ __attribute__((aligned(16))) unsigned char smem[];
    cg::grid_group grid = cg::this_grid();
    const int wv = __builtin_amdgcn_readfirstlane((int)(threadIdx.x >> 6));
    LAS unsigned char* lds = (LAS unsigned char*)smem; LAS float* sm = (LAS float*)smem;
    int repc = 0, repg = 0;
    volatile LAS unsigned* xst = (volatile LAS unsigned*)(lds + 131072);
    if (otid(wv) < 2) xst[otid(wv)] = 0u;
    __syncthreads();
    const XcdBarrier xbar = xcd_barrier_post((unsigned*)(p.ws + WS_BAR), xst, wv);
    for (int ph = p.ph_lo; ph < p.ph_hi; ++ph) {
        if (ph > p.ph_lo) { if (ph == p.ph_lo + 1) grid.sync(); else xcd_barrier(xbar, wv); }
        unsigned char* ws = p.ws; asm volatile("" : "+s"(ws));
        bf16_t* WIN = (bf16_t*)(ws + WS_WIN); bf16_t* WOUT = (bf16_t*)(ws + WS_WOUT); bf16_t* WF1 = (bf16_t*)(ws + WS_WF1); bf16_t* WF2 = (bf16_t*)(ws + WS_WF2);
        bf16_t* Ub = (bf16_t*)(ws + WS_U); float* Gf = (float*)(ws + WS_G); bf16_t* ACT = (bf16_t*)(ws + WS_ACT);
        bf16_t* O1 = (bf16_t*)(ws + WS_U); bf16_t* HD = (bf16_t*)(ws + WS_U); bf16_t* O2 = (bf16_t*)(ws + WS_SC); bf16_t* XB1 = (bf16_t*)(ws + WS_SC + (size_t)T_TOK * DM * 2);
        if (ph == 0) {
            if (DBG_PROBE == 14 && otid(wv) == 0) ((LAS unsigned*)sm)[32761] = (unsigned)__builtin_amdgcn_s_memrealtime();
            phase_convert(p, sm, wv);
            row_pass(wv, nullptr, nullptr, pin(p, 0), nullptr, nullptr, nullptr, pin(p, 1), ACT);
            if (DBG_PROBE == 14) { __syncthreads(); if (otid(wv) == 0) { const unsigned dt = (unsigned)__builtin_amdgcn_s_memrealtime() - ((LAS unsigned*)sm)[32761]; atomicMax((unsigned*)(p.ws + WS_DBG) + 14, dt * 10u); } }
            continue;
        }
        const int l = (ph - 1) / 10, s = (ph - 1) % 10;
        const bool dbg_t = DBG_PROBE >= 4 && l == 0 && s == DBG_PROBE - 4;
        if (dbg_t && otid(wv) == 0) ((LAS unsigned*)sm)[32761] = (unsigned)__builtin_amdgcn_s_memrealtime();
        pg8::StaticOrder S;
        if (REP_GEMM > 1 && (s == 0 || s == 5 || s == 7 || s == 8)) { if (++repg < REP_GEMM) { --ph; } else repg = 0; }
        if (s == 0) { pg8::Gemm g{ACT, WIN + (size_t)l * NIN * DM, T_TOK, NIN, DM}; S.init(g.M, g.N, gridDim.x, blockIdx.x); pg8::EpiU E{Ub, Gf}; pg8::gemm_phase(lds, g, S, E, wv); }
        else if (s == 1) phase_prepass(p, l, xbar, wv);
        else if (s == 2) { pg8::Gemm g{(const bf16_t*)((unsigned char*)p.out + OUT_A2), (const bf16_t*)(ws + WS_BT2) + (size_t)l * N2 * A2K, T_TOK, N2, A2K}; S.init(g.M, g.N, gridDim.x, blockIdx.x);
            pg8::EpiPre E{ws, (unsigned char*)p.out, pin(p, 10) + (size_t)l * 1024, (const float*)(ws + WS_SPT) + (size_t)l * 512, pin(p, 19) + (size_t)l * 512, pin(p, 21) + (size_t)l * 512, wv};
            pg8::gemm_phase<pg8::EpiPre, true>(lds, g, S, E, wv); }
        else if (s == 3) { phase_scan(p, l, sm, wv); if (REP_SCAN > 1) { if (++repc < REP_SCAN) ph -= 2; else repc = 0; } }
        else if (s == 4) phase_finalize(p, l, sm, wv);
        else if (s == 5 || s == 8) { pg8::Gemm g{s == 5 ? ACT : HD, s == 5 ? WOUT + (size_t)l * DM * DM : WF2 + (size_t)l * DM * DFF, T_TOK, DM, s == 5 ? DM : DFF}; S.init(g.M, g.N, gridDim.x, blockIdx.x); pg8::EpiBf E{s == 5 ? O1 : O2, DM}; pg8::gemm_phase(lds, g, S, E, wv); }
        else if (s == 6 || s == 9) { const bool fa = (s == 6);
            row_pass(wv, fa ? O1 : O2, pin(p, fa ? 2 : 4) + (size_t)l * DM, (fa && l == 0) ? pin(p, 0) : nullptr, fa ? (const bf16_t*)p.out : (const bf16_t*)XB1, (!fa && l == 1) ? p.out : nullptr, fa ? XB1 : (bf16_t*)p.out,
                     fa ? pin(p, 3) + (size_t)l * DM : (l == 0 ? pin(p, 1) + DM : nullptr), ACT); }
        else if (s == 7) { pg8::Gemm g{ACT, WF1 + (size_t)l * 2 * DFF * DM, T_TOK, 2 * DFF, DM}; S.init(g.M, g.N, gridDim.x, blockIdx.x); pg8::EpiSwi E{HD}; pg8::gemm_phase(lds, g, S, E, wv); }
        if (dbg_t) { __syncthreads(); if (otid(wv) == 0) { const unsigned dt = (unsigned)__builtin_amdgcn_s_memrealtime() - ((LAS unsigned*)sm)[32761]; atomicMax((unsigned*)(p.ws + WS_DBG) + DBG_PROBE, dt * 10u); } }
    }
    if (DBG_PROBE) { __syncthreads(); if (blockIdx.x == 0 && otid(wv) == 0) { const unsigned v = __hip_atomic_load((const unsigned*)(p.ws + WS_DBG) + DBG_PROBE, __ATOMIC_RELAXED, __HIP_MEMORY_SCOPE_AGENT);
        __builtin_amdgcn_s_waitcnt(0); p.out[0] += (float)(v / 1000u); } }
}

extern "C" void kernel_launch(void* const* d_in, const int* in_sizes, int n_in, void* d_out, int out_size, void* d_ws, size_t ws_size, hipStream_t stream) {
    static int grid_blocks = 0;
    if (grid_blocks == 0) {
        if (n_in != 31 || ws_size < WS_END || out_size != T_TOK * DM) { fprintf(stderr, "kernel_launch: unexpected shapes (n_in %d, ws %zu need %zu, out %d)\n", n_in, ws_size, (size_t)WS_END, out_size); grid_blocks = -1; return; }
        int dev = 0, cus = 0, per_cu = 0;
        (void)hipGetDevice(&dev);
        (void)hipDeviceGetAttribute(&cus, hipDeviceAttributeMultiprocessorCount, dev);
        if (hipFuncSetAttribute((const void*)mega, hipFuncAttributeMaxDynamicSharedMemorySize, LDS_BYTES) != hipSuccess) { fprintf(stderr, "kernel_launch: hipFuncSetAttribute failed\n"); grid_blocks = -1; return; }
        if (hipOccupancyMaxActiveBlocksPerMultiprocessor(&per_cu, (const void*)mega, 512, LDS_BYTES) != hipSuccess || per_cu < 1) { fprintf(stderr, "kernel_launch: occupancy query says %d blocks per CU\n", per_cu); per_cu = 1; (void)hipGetLastError(); }
        grid_blocks = 256;
        (void)per_cu;
    }
    if (grid_blocks < 0) return;
    if (hipMemsetAsync((char*)d_ws + WS_BAR, 0, (size_t)XCD_BAR_WORDS * 4, stream) != hipSuccess) { fprintf(stderr, "kernel_launch: hipMemsetAsync of the barrier words failed\n"); return; }
    Params p{};
    for (int i = 0; i < 31; ++i) p.in[i] = (const float*)d_in[i];
    p.out = (float*)d_out; p.ws = (unsigned char*)d_ws; p.ph_lo = 0; p.ph_hi = 21;
    void* args[] = {&p};
    hipError_t e = hipLaunchCooperativeKernel((const void*)mega, dim3(grid_blocks), dim3(512), args, LDS_BYTES, stream);
    if (e != hipSuccess) fprintf(stderr, "cooperative launch failed: %s (grid %d)\n", hipGetErrorString(e), grid_blocks);
}
```

```cpp
#include <hip/hip_runtime.h>
#include <hip/hip_cooperative_groups.h>
#include <cstdio>
namespace cg = cooperative_groups;

#ifndef DBG_PROBE
#define DBG_PROBE 0
#endif
#define LAS __attribute__((address_space(3)))
typedef unsigned short bf16_t;
typedef short bf16x8 __attribute__((ext_vector_type(8)));
typedef float f32x4 __attribute__((ext_vector_type(4)));
typedef float f32x2 __attribute__((ext_vector_type(2)));
typedef unsigned u32x4 __attribute__((ext_vector_type(4)));
typedef unsigned u32x2 __attribute__((ext_vector_type(2)));

constexpr int T_TOK = 32768, SEQ = 4096, DM = 1024, NU = 3328, NGATE = 256, NIN = 3584, DFF = 2816, NSC = 2048;
constexpr int LDS_BYTES = 131072 + 16;
constexpr size_t WS_WIN = 0;
constexpr size_t WS_WOUT = WS_WIN + (size_t)2 * NIN * DM * 2;
constexpr size_t WS_WF1 = WS_WOUT + (size_t)2 * DM * DM * 2;
constexpr size_t WS_WF2 = WS_WF1 + (size_t)2 * 2 * DFF * DM * 2;
constexpr size_t WS_U = WS_WF2 + (size_t)2 * DM * DFF * 2;
constexpr size_t WS_G = WS_U + (size_t)T_TOK * NU * 2;
constexpr size_t WS_ACT = WS_G + (size_t)T_TOK * NGATE * 4;
constexpr size_t WS_SC = WS_ACT + (size_t)T_TOK * DM * 2;
constexpr int A2K = 448, N2 = 2304;
constexpr size_t WS_BT2 = WS_SC + (size_t)T_TOK * NSC * 2;
constexpr size_t WS_SPT = WS_BT2 + (size_t)2 * N2 * A2K * 2;
constexpr size_t OUT_A2 = (size_t)T_TOK * DM * 2;
constexpr size_t OUT_GT = OUT_A2 + (size_t)T_TOK * 512 * 2;
constexpr size_t WS_DBG = WS_SPT + 4096;
constexpr size_t WS_BAR = WS_DBG + 256;
constexpr int XCD_BAR_WORDS = 3456;
constexpr size_t WS_END = WS_BAR + (size_t)XCD_BAR_WORDS * 4;

struct Params { const float* in[31]; float* out; unsigned char* ws; int ph_lo, ph_hi; };
__device__ __forceinline__ const float* pin(const Params& p, int i) { asm volatile("" : "+s"(i)); return p.in[i]; }

__device__ __forceinline__ int otid(int wv) { unsigned z = 0u; asm volatile("" : "+s"(z)); int t = (wv << 6) | (int)__builtin_amdgcn_mbcnt_hi(~0u, __builtin_amdgcn_mbcnt_lo(~0u, z)); asm volatile("" : "+v"(t)); return t; }
__device__ __forceinline__ int obid() { int t = blockIdx.x; asm volatile("" : "+s"(t)); return t; }
__device__ __forceinline__ float bf2f(unsigned short b) { return __uint_as_float(((unsigned)b) << 16); }
__device__ __forceinline__ unsigned short f2bf(float f) { unsigned u = __float_as_uint(f); u += 0x7FFFu + ((u >> 16) & 1u); return (unsigned short)(u >> 16); }
__device__ __forceinline__ unsigned pk2(float lo, float hi) { return (unsigned)f2bf(lo) | ((unsigned)f2bf(hi) << 16); }
__device__ __forceinline__ f32x4 ld4bf(const bf16_t* p) {
    const u32x2 v = *(const u32x2*)p; f32x4 r;
    r.x = __uint_as_float(v.x << 16); r.y = __uint_as_float(v.x & 0xffff0000u); r.z = __uint_as_float(v.y << 16); r.w = __uint_as_float(v.y & 0xffff0000u); return r;
}
__device__ __forceinline__ f32x4 bf4(u32x2 v) { f32x4 r; r.x = __uint_as_float(v.x << 16); r.y = __uint_as_float(v.x & 0xffff0000u); r.z = __uint_as_float(v.y << 16); r.w = __uint_as_float(v.y & 0xffff0000u); return r; }
__device__ __forceinline__ void st4bf(bf16_t* p, f32x4 v) { u32x2 o; o.x = pk2(v.x, v.y); o.y = pk2(v.z, v.w); *(u32x2*)p = o; }
__device__ __forceinline__ float sigmoidf_(float x) { return __builtin_amdgcn_rcpf(1.f + __expf(-x)); }
__device__ __forceinline__ float siluf_(float x) { return x * __builtin_amdgcn_rcpf(1.f + __expf(-x)); }
__device__ __forceinline__ float softplusf_(float x) { return fmaxf(x, 0.f) + __logf(1.f + __expf(-fabsf(x))); }
__device__ __forceinline__ float tanhf_(float x) { return 1.f - 2.f * __builtin_amdgcn_rcpf(1.f + __expf(2.f * x)); }
__device__ __forceinline__ float gelu_tanh(float x) { const float u = 0.7978845608028654f * (x + 0.044715f * x * x * x); return 0.5f * x * (1.f + tanhf_(u)); }
__device__ __forceinline__ float hsum4(f32x4 v) { return (v.x + v.z) + (v.y + v.w); }
template <int CTRL> __device__ __forceinline__ float dppf(float x) { return __int_as_float(__builtin_amdgcn_update_dpp(0, __float_as_int(x), CTRL, 0xF, 0xF, true)); }
__device__ __forceinline__ float red16(float v) { v += dppf<0xB1>(v); v += dppf<0x4E>(v); v += dppf<0x141>(v); v += dppf<0x140>(v); return v; }
__device__ __forceinline__ float red64(float v) { v = red16(v); v += __shfl_xor(v, 16); v += __shfl_xor(v, 32); return v; }
__device__ __forceinline__ float sum4l(float x) { x += dppf<0xB1>(x); x += dppf<0x4E>(x); return x; }
__device__ __forceinline__ unsigned cvt_pk_bf16(float lo, float hi) { unsigned r; asm volatile("v_cvt_pk_bf16_f32 %0, %1, %2" : "=v"(r) : "v"(lo), "v"(hi)); return r; }

#define XB_TMO      128
#define XB_XCNT(j)  (256  + 64 * (j))
#define XB_XSUB(j)  (1280 + 64 * (j))
#define XB_XGEN(j)  (2304 + 64 * (j))
#define XB_TOP      3328
#define XB_TOPGEN   3392
#define XB_SPIN_CAP (1u << 22)
__device__ __forceinline__ unsigned xb_ld(unsigned* p)              { return __hip_atomic_load(p, __ATOMIC_RELAXED, __HIP_MEMORY_SCOPE_AGENT); }
__device__ __forceinline__ unsigned xb_add(unsigned* p, unsigned v) { return __hip_atomic_fetch_add(p, v, __ATOMIC_RELAXED, __HIP_MEMORY_SCOPE_AGENT); }
__device__ __forceinline__ unsigned xb_xcc_id() { return (unsigned)__builtin_amdgcn_s_getreg((3 << 11) | 20) & 0xFu; }
#define XB_SPIN(cond, bar) do { unsigned _sp = 0; while (cond) { __builtin_amdgcn_s_sleep(1); \
    if ((++_sp & 255u) == 0u) { if (xb_ld(&(bar)[XB_TMO])) break; if (_sp > XB_SPIN_CAP) { atomicAdd(&(bar)[XB_TMO], 1u); break; } } } } while (0)
struct XcdBarrier { unsigned* bar; unsigned x; volatile LAS unsigned* st; };
__device__ __forceinline__ XcdBarrier xcd_barrier_post(unsigned* bar, volatile LAS unsigned* st, int wv) {
    XcdBarrier b; b.bar = bar; b.x = xb_xcc_id(); b.st = st;
    if (otid(wv) == 0) (void)xb_add(&bar[XB_XCNT(b.x)], 1u);
    return b;
}
__device__ __forceinline__ void xcd_barrier_complete(unsigned* bar, unsigned x, unsigned& nloc, unsigned& nx) {
    const unsigned G = gridDim.x * gridDim.y * gridDim.z;
    unsigned sum, cnt, mine, sp = 0u;
    for (;;) {
        sum = 0u; cnt = 0u; mine = 0u;
#pragma unroll
        for (unsigned j = 0; j < 16; ++j) { const unsigned c = xb_ld(&bar[XB_XCNT(j)]); sum += c; cnt += (c > 0u) ? 1u : 0u; mine = (j == x) ? c : mine; }
        if (sum == G) break;
        __builtin_amdgcn_s_sleep(1);
        if ((++sp & 255u) == 0u) { if (xb_ld(&bar[XB_TMO])) break; if (sp > XB_SPIN_CAP) { atomicAdd(&bar[XB_TMO], 1u); break; } }
    }
    nloc = mine > 0u ? mine : 1u; nx = cnt > 0u ? cnt : 1u;
}
__device__ __forceinline__ void xcd_barrier(const XcdBarrier& b, int wv) {
    asm volatile("s_waitcnt vmcnt(0)" ::: "memory");
    __syncthreads();
    if (otid(wv) == 0) {
        unsigned* bar = b.bar;
        __builtin_amdgcn_s_waitcnt(0);
        unsigned nloc = b.st[0], nx = b.st[1];
        if (nloc == 0u) { xcd_barrier_complete(bar, b.x, nloc, nx); b.st[0] = nloc; b.st[1] = nx; }
        const unsigned old = xb_add(&bar[XB_XSUB(b.x)], 1u);
        const unsigned gen = old / nloc;
        if (old + 1u == (gen + 1u) * nloc) {
            __builtin_amdgcn_fence(__ATOMIC_RELEASE, "agent");
            asm volatile("s_waitcnt vmcnt(0)" ::: "memory");
            const unsigned og = xb_add(&bar[XB_TOP], 1u);
            const unsigned tg = og / nx;
            if (og + 1u == (tg + 1u) * nx) xb_add(&bar[XB_TOPGEN], 1u);
            else XB_SPIN(xb_ld(&bar[XB_TOPGEN]) == tg, bar);
            __builtin_amdgcn_fence(__ATOMIC_ACQUIRE, "agent");
            xb_add(&bar[XB_XGEN(b.x)], 1u);
            asm volatile("s_waitcnt vmcnt(0)" ::: "memory");
        } else {
            XB_SPIN(xb_ld(&bar[XB_XGEN(b.x)]) == gen, bar);
            __builtin_amdgcn_fence(__ATOMIC_ACQUIRE, "agent");
            asm volatile("s_waitcnt vmcnt(0)" ::: "memory");
        }
    }
    __syncthreads();
}

namespace pg8 {
constexpr int BM = 256, BK = 64, HALF = 128, HTB = HALF * BK * 2, STAGE_BYTES = 8 * HTB, NXCD = 8, WGM = 8;
__device__ __forceinline__ int lds_byte(int r, int c) { const int st = (r >> 4) * 2 + (c >> 5), rr = r & 15, cc = c & 31, ob = rr * 64 + cc * 2; return st * 1024 + (ob ^ (((ob >> 9) & 1) << 5)); }
__device__ __forceinline__ void stage_rc(int b, int& R, int& C) { const int st = b / 1024, sb = b % 1024, swz = sb ^ (((sb >> 9) & 1) << 5); R = (st >> 1) * 16 + swz / 64; C = (st & 1) * 32 + (swz % 64) / 2; }
__device__ __forceinline__ int perm32(int rho) { const int n = rho >> 4, i = rho & 15; return 8 * (i >> 2) + 4 * n + (i & 3); }
struct Unit { int pm, pn; };
struct Gemm { const bf16_t* A; const bf16_t* Bt; int M, N, K; };
struct StaticOrder {
    int nM, nN, nwg, G, c;
    __device__ void init(int M, int N, int G_, int c_) { nM = M / BM; nN = N / BM; nwg = nM * nN; G = G_; c = c_; }
    __device__ bool next(int i, Unit& u) const {
        const long L = (long)i * G + c; if (L >= nwg) return false;
        int wgid = (int)L; { const int q = nwg / NXCD, r = nwg % NXCD, xcd = wgid % NXCD, off = wgid / NXCD; wgid = (xcd < r ? xcd * (q + 1) : r * (q + 1) + (xcd - r) * q) + off; }
        const int nig = WGM * nN, gid = wgid / nig, fm = gid * WGM, gsz = (nM - fm) < WGM ? (nM - fm) : WGM;
        u.pm = fm + ((wgid % nig) % gsz); u.pn = (wgid % nig) / gsz; return true;
    }
};
struct EpiBf {
    static constexpr bool PERM = true;
    bf16_t* C; int ldc;
    __device__ __forceinline__ void operator()(const f32x4 (&acc)[2][2][4][2], const Unit& u, int wr, int wc, int fr, int fq) const {
        const int row0 = u.pm * BM + wr * 64 + fr, col0 = u.pn * BM + wc * 32 + 8 * fq;
#pragma unroll
        for (int ai = 0; ai < 2; ++ai)
#pragma unroll
            for (int m = 0; m < 4; ++m) { bf16_t* rowp = C + (size_t)(row0 + ai * HALF + m * 16) * ldc + col0;
#pragma unroll
                for (int bj = 0; bj < 2; ++bj) { const f32x4 v0 = acc[ai][bj][m][0], v1 = acc[ai][bj][m][1];
                    u32x4 o; o.x = cvt_pk_bf16(v0[0], v0[1]); o.y = cvt_pk_bf16(v0[2], v0[3]); o.z = cvt_pk_bf16(v1[0], v1[1]); o.w = cvt_pk_bf16(v1[2], v1[3]);
                    *(u32x4*)(rowp + bj * HALF) = o; } }
    }
};
struct EpiU {
    static constexpr bool PERM = true;
    bf16_t* U; float* G;
    __device__ __forceinline__ void operator()(const f32x4 (&acc)[2][2][4][2], const Unit& u, int wr, int wc, int fr, int fq) const {
        const int row0 = u.pm * BM + wr * 64 + fr;
        if (u.pn < 13) {
            const int col0 = u.pn * BM + wc * 32 + 8 * fq;
#pragma unroll
            for (int ai = 0; ai < 2; ++ai)
#pragma unroll
                for (int m = 0; m < 4; ++m) { bf16_t* rowp = U + (size_t)(row0 + ai * HALF + m * 16) * NU + col0;
#pragma unroll
                    for (int bj = 0; bj < 2; ++bj) { const f32x4 v0 = acc[ai][bj][m][0], v1 = acc[ai][bj][m][1];
                        u32x4 o; o.x = cvt_pk_bf16(v0[0], v0[1]); o.y = cvt_pk_bf16(v0[2], v0[3]); o.z = cvt_pk_bf16(v1[0], v1[1]); o.w = cvt_pk_bf16(v1[2], v1[3]);
                        *(u32x4*)(rowp + bj * HALF) = o; } }
        } else {
            const int col0 = wc * 32 + 8 * fq;
#pragma unroll
            for (int ai = 0; ai < 2; ++ai)
#pragma unroll
                for (int m = 0; m < 4; ++m) { float* rowp = G + (size_t)(row0 + ai * HALF + m * 16) * NGATE + col0;
#pragma unroll
                    for (int bj = 0; bj < 2; ++bj) { *(f32x4*)(rowp + bj * HALF) = acc[ai][bj][m][0]; *(f32x4*)(rowp + bj * HALF + 4) = acc[ai][bj][m][1]; } }
        }
    }
};
struct EpiSwi {
    static constexpr bool PERM = true;
    bf16_t* H;
    __device__ __forceinline__ void operator()(const f32x4 (&acc)[2][2][4][2], const Unit& u, int wr, int wc, int fr, int fq) const {
        const int row0 = u.pm * BM + wr * 64 + fr, col0 = u.pn * HALF + wc * 32 + 8 * fq;
#pragma unroll
        for (int ai = 0; ai < 2; ++ai)
#pragma unroll
            for (int m = 0; m < 4; ++m) { bf16_t* rowp = H + (size_t)(row0 + ai * HALF + m * 16) * DFF + col0;
                float r[8];
#pragma unroll
                for (int n = 0; n < 2; ++n)
#pragma unroll
                    for (int j = 0; j < 4; ++j) { const float g = acc[ai][0][m][n][j], up = acc[ai][1][m][n][j]; r[n * 4 + j] = g * up * __builtin_amdgcn_rcpf(1.f + __expf(-g)); }
                u32x4 o; o.x = cvt_pk_bf16(r[0], r[1]); o.y = cvt_pk_bf16(r[2], r[3]); o.z = cvt_pk_bf16(r[4], r[5]); o.w = cvt_pk_bf16(r[6], r[7]);
                *(u32x4*)rowp = o; }
    }
};

struct EpiPre {
    static constexpr bool PERM = true;
    unsigned char* ws; unsigned char* ob; const float* gb; const float* lam; const float* w0; const float* a0; int wv;
    __device__ __forceinline__ void operator()(const f32x4 (&acc)[2][2][4][2], const Unit& u, int wr_, int wc_, int fr_, int fq_) const {
        const int t_ = otid(wv); const int wr = t_ >> 8, wc = (t_ >> 6) & 3, fr = t_ & 15, fq = (t_ >> 4) & 3;
        (void)wr_; (void)wc_; (void)fr_; (void)fq_;
        const unsigned row0 = u.pm * BM + wr * 64 + fr;
        if (u.pn < 4) {
            const int dir = u.pn >> 1;
#pragma unroll
            for (int n = 0; n < 2; ++n) { const unsigned c = (u.pn & 1) * 128 + wc * 32 + 8 * fq + 4 * n;
                const f32x4 sp = *(const f32x4*)(lam + dir * 256 + c); const f32x4 gr = *(const f32x4*)(gb + (dir * 2 + 0) * 256 + c), gi = *(const f32x4*)(gb + (dir * 2 + 1) * 256 + c);
#pragma unroll
                for (int ai = 0; ai < 2; ++ai)
#pragma unroll
                    for (int m = 0; m < 4; ++m) { const unsigned row = row0 + ai * HALF + m * 16;
                        const f32x4 xc = ld4bf((const bf16_t*)(ob + (unsigned)OUT_A2 + (row * (unsigned)A2K + c) * 2u)); f32x4 la, bb;
#pragma unroll
                        for (int j = 0; j < 4; ++j) { const float rp = acc[ai][0][m][n][j] + gr[j], ip = acc[ai][1][m][n][j] + gi[j];
                            const float l_ = sp[j] * __builtin_amdgcn_rcpf(1.f + __expf(-rp)); const float a_ = __expf(l_);
                            la[j] = 1.f - a_;     bb[j] = __builtin_amdgcn_sqrtf(fmaxf(1.f - a_ * a_, 0.f)) * __builtin_amdgcn_rcpf(1.f + __expf(-ip)) * xc[j]; }
                        u32x2 o; o.x = cvt_pk_bf16(la[0], la[1]); o.y = cvt_pk_bf16(la[2], la[3]); *(u32x2*)(ws + (unsigned)WS_ACT + (row * (unsigned)DM + dir * 256u + c) * 2u) = o;
                        o.x = cvt_pk_bf16(bb[0], bb[1]); o.y = cvt_pk_bf16(bb[2], bb[3]); *(u32x2*)(ws + (unsigned)WS_SC + (row * (unsigned)NSC + dir * 256u + c) * 2u) = o; } }
        } else if (u.pn == 8) {
#pragma unroll
            for (int bj = 0; bj < 2; ++bj)
#pragma unroll
                for (int n = 0; n < 2; ++n) { const unsigned c = bj * HALF + wc * 32 + 8 * fq + 4 * n;
#pragma unroll
                    for (int ai = 0; ai < 2; ++ai)
#pragma unroll
                        for (int m = 0; m < 4; ++m) { const unsigned row = row0 + ai * HALF + m * 16; const f32x4 r = acc[ai][bj][m][n];
                            u32x2 o; o.x = cvt_pk_bf16(r[0], r[1]); o.y = cvt_pk_bf16(r[2], r[3]);
                            *(u32x2*)(ob + (unsigned)OUT_GT + (row * 256u + c) * 2u) = o; } }
        } else {
            const int q = u.pn - 4, kind = q >> 1, d = q & 1;
            const float* cst = (kind ? a0 : w0) + d * 256; const float mul = kind ? 1.f : -0.6065306597126334f;
            const unsigned dbase = kind ? (unsigned)WS_ACT + (512u + d * 256u) * 2u : (d ? (unsigned)WS_G + 64u * 2u : (unsigned)WS_U);
            const unsigned dstride = kind ? (unsigned)DM * 2u : (d ? 512u * 2u : (unsigned)NU * 2u);
#pragma unroll
            for (int bj = 0; bj < 2; ++bj)
#pragma unroll
                for (int n = 0; n < 2; ++n) { const unsigned c = bj * HALF + wc * 32 + 8 * fq + 4 * n; const f32x4 cv = *(const f32x4*)(cst + c);
#pragma unroll
                    for (int ai = 0; ai < 2; ++ai)
#pragma unroll
                        for (int m = 0; m < 4; ++m) { const unsigned row = row0 + ai * HALF + m * 16; f32x4 r;
#pragma unroll
                            for (int j = 0; j < 4; ++j) r[j] = mul * __builtin_amdgcn_rcpf(1.f + __expf(-(acc[ai][bj][m][n][j] + cv[j])));
                            u32x2 o; o.x = cvt_pk_bf16(r[0], r[1]); o.y = cvt_pk_bf16(r[2], r[3]);
                            *(u32x2*)(ws + dbase + row * dstride + c * 2u) = o; } }
        }
    }
};

template <class Epi, bool KSUB = false>
__device__ __forceinline__ void gemm_phase(LAS unsigned char* lds, const Gemm g, const StaticOrder& S, const Epi& E, int wv) {
    const int tid = otid(wv), wid = __builtin_amdgcn_readfirstlane(tid >> 6), lane = tid & 63, wr = wid >> 2, wc = wid & 3, fr = lane & 15, fq = lane >> 4;
    const int K = g.K, nt = KSUB ? 2 : K / BK;
#define PG8_KOFF(u) (KSUB ? (size_t)(((u).pn < 4 ? ((u).pn & 1) * 128 : ((u).pn < 8 ? 256 : 320)) * 2) : (size_t)0)
    unsigned voffA[2], voffB[2];
#pragma unroll
    for (int i = 0; i < 2; ++i) { int R, C; stage_rc(tid * 16 + i * 8192, R, C); const int Rb = Epi::PERM ? ((R & ~31) + perm32(R & 31)) : R;
        voffA[i] = (unsigned)(R * K + C) * 2u; voffB[i] = (unsigned)(Rb * K + C) * 2u; }
    const size_t kstep = (size_t)(BK * 2);
    const size_t hstep = (size_t)HALF * K * 2;
    const size_t tstep = 2 * hstep;
    const unsigned ldsw = (unsigned)wid * 1024u;
    const int aoff = lds_byte(wr * 64 + fr, fq * 8), boff = lds_byte(wc * 32 + fr, fq * 8);
#define PG8_SA(b, h) (((b) * 2 + (h)) * HTB)
#define PG8_SB(b, h) ((4 + (b) * 2 + (h)) * HTB)
#define PG8_STAGE(bufoff, gbase, voff) do { _Pragma("unroll") for (int _i = 0; _i < 2; ++_i) \
        __builtin_amdgcn_global_load_lds((const unsigned*)((const char*)(gbase) + (voff)[_i]), (LAS unsigned*)(lds + (bufoff) + ldsw + _i * 8192), 16, 0, 0); } while (0)
#define PG8_LDA(dst, b, h) do { _Pragma("unroll") for (int m = 0; m < 4; ++m) _Pragma("unroll") for (int k = 0; k < 2; ++k) dst[m][k] = *(const LAS bf16x8*)(lds + PG8_SA(b, h) + aoff + m * 2048 + k * 1024); } while (0)
#define PG8_LDB(dst, b, h) do { _Pragma("unroll") for (int n = 0; n < 2; ++n) _Pragma("unroll") for (int k = 0; k < 2; ++k) dst[n][k] = *(const LAS bf16x8*)(lds + PG8_SB(b, h) + boff + n * 2048 + k * 1024); } while (0)
#define PG8_MMA(ai, bj, At, Bt) do { __builtin_amdgcn_s_setprio(1); _Pragma("unroll") for (int m = 0; m < 4; ++m) _Pragma("unroll") for (int n = 0; n < 2; ++n) _Pragma("unroll") for (int k = 0; k < 2; ++k) \
        acc[ai][bj][m][n] = __builtin_amdgcn_mfma_f32_16x16x32_bf16(Bt[n][k], At[m][k], acc[ai][bj][m][n], 0, 0, 0); __builtin_amdgcn_s_setprio(0); } while (0)
#define PG8_WAIT_V(n) asm volatile("s_waitcnt vmcnt(" #n ")" ::: "memory")
#define PG8_WAIT_L(n) asm volatile("s_waitcnt lgkmcnt(" #n ")" ::: "memory")
#define PG8_BAR __builtin_amdgcn_s_barrier()
#define PG8_SCHED __builtin_amdgcn_sched_barrier(0)
    Unit cur, nxt; int ui = 0;
    if (!S.next(0, cur)) return;
    f32x4 acc[2][2][4][2];
#pragma unroll
    for (int a = 0; a < 2; ++a)
#pragma unroll
        for (int b = 0; b < 2; ++b)
#pragma unroll
            for (int m = 0; m < 4; ++m)
#pragma unroll
                for (int n = 0; n < 2; ++n) acc[a][b][m][n] = (f32x4){0.f, 0.f, 0.f, 0.f};
    bf16x8 At[4][2], B0[2][2], B1[2][2];
    const char* cA = (const char*)g.A + (size_t)cur.pm * tstep + PG8_KOFF(cur); const char* cB = (const char*)g.Bt + (size_t)cur.pn * tstep + PG8_KOFF(cur);
    PG8_STAGE(PG8_SB(0, 0), cB, voffB); PG8_STAGE(PG8_SA(0, 0), cA, voffA); PG8_STAGE(PG8_SB(0, 1), cB + hstep, voffB); PG8_STAGE(PG8_SA(0, 1), cA + hstep, voffA);
    if (wr == 1) PG8_BAR;
    PG8_WAIT_V(4); PG8_BAR;
    PG8_STAGE(PG8_SB(1, 0), cB + kstep, voffB); PG8_STAGE(PG8_SA(1, 0), cA + kstep, voffA); PG8_STAGE(PG8_SB(1, 1), cB + hstep + kstep, voffB);
    PG8_WAIT_V(6); PG8_BAR;
    for (;;) {
        const bool has_next = S.next(ui + 1, nxt);
        const char* nA = has_next ? (const char*)g.A + (size_t)nxt.pm * tstep + PG8_KOFF(nxt) : cA; const char* nB = has_next ? (const char*)g.Bt + (size_t)nxt.pn * tstep + PG8_KOFF(nxt) : cB;
        for (int t = 0; t < nt; t += 2) {
            const bool last = (t == nt - 2);
            const char* a1 = cA + (size_t)(t + 1) * kstep;
            const char* a2 = last ? nA : cA + (size_t)(t + 2) * kstep; const char* b2 = last ? nB : cB + (size_t)(t + 2) * kstep;
            const char* a3 = a2 + kstep; const char* b3 = b2 + kstep;
            PG8_LDB(B0, 0, 0); PG8_SCHED; PG8_LDA(At, 0, 0); PG8_STAGE(PG8_SA(1, 1), a1 + hstep, voffA);
            PG8_WAIT_L(8); PG8_BAR; PG8_WAIT_L(0); PG8_MMA(0, 0, At, B0); PG8_BAR; PG8_SCHED;
            PG8_LDB(B1, 0, 1); PG8_STAGE(PG8_SB(0, 0), b2, voffB);
            PG8_BAR; PG8_WAIT_L(0); PG8_MMA(0, 1, At, B1); PG8_BAR;
            PG8_LDA(At, 0, 1); PG8_STAGE(PG8_SA(0, 0), a2, voffA);
            PG8_BAR; PG8_WAIT_L(0); PG8_MMA(1, 0, At, B0); PG8_BAR; PG8_SCHED;
            PG8_STAGE(PG8_SB(0, 1), b2 + hstep, voffB);
            PG8_WAIT_V(6); PG8_BAR; PG8_MMA(1, 1, At, B1); PG8_BAR;
            PG8_LDB(B0, 1, 0); PG8_SCHED; PG8_LDA(At, 1, 0); PG8_STAGE(PG8_SA(0, 1), a2 + hstep, voffA);
            PG8_WAIT_L(8); PG8_BAR; PG8_WAIT_L(0); PG8_MMA(0, 0, At, B0); PG8_BAR; PG8_SCHED;
            PG8_LDB(B1, 1, 1); PG8_STAGE(PG8_SB(1, 0), b3, voffB);
            PG8_BAR; PG8_WAIT_L(0); PG8_MMA(0, 1, At, B1); PG8_BAR;
            PG8_LDA(At, 1, 1); PG8_STAGE(PG8_SA(1, 0), a3, voffA);
            PG8_BAR; PG8_WAIT_L(0); PG8_MMA(1, 0, At, B0); PG8_BAR; PG8_SCHED;
            PG8_STAGE(PG8_SB(1, 1), b3 + hstep, voffB);
            PG8_WAIT_V(6); PG8_BAR; PG8_MMA(1, 1, At, B1); PG8_BAR;
        }
        E(acc, cur, wr, wc, fr, fq);
        if (!has_next) break;
#pragma unroll
        for (int a = 0; a < 2; ++a)
#pragma unroll
            for (int b = 0; b < 2; ++b)
#pragma unroll
                for (int m = 0; m < 4; ++m)
#pragma unroll
                    for (int n = 0; n < 2; ++n) acc[a][b][m][n] = (f32x4){0.f, 0.f, 0.f, 0.f};
        cur = nxt; cA = nA; cB = nB; ++ui;
    }
    PG8_WAIT_V(0);
    if (wr == 0) PG8_BAR;
    PG8_BAR;
#undef PG8_KOFF
#undef PG8_SA
#undef PG8_SB
#undef PG8_STAGE
#undef PG8_LDA
#undef PG8_LDB
#undef PG8_MMA
#undef PG8_WAIT_V
#undef PG8_WAIT_L
#undef PG8_BAR
#undef PG8_SCHED
}
}

__device__ __forceinline__ int src_col(int kind, int n) {
    if (kind == 0) {
        if (n < 1536) return n;
        if (n < 2560) return n + 16;
        if (n < 3328) return n + 32;
        const int j = n - 3328;
        if (j < 16) return 1536 + j;
        if (j < 32) return 2576 + (j - 16);
        if (j < 224) return 3360 + (j - 32);
        return -1;
    }
    if (kind == 2) return ((n & 255) >> 7) * DFF + (n >> 8) * 128 + (n & 127);
    return n;
}
__device__ __forceinline__ void phase_convert(const Params& p, LAS float* tile, int wv) {
    const int tid = otid(wv);
    bf16_t* WIN = (bf16_t*)(p.ws + WS_WIN); bf16_t* WOUT = (bf16_t*)(p.ws + WS_WOUT); bf16_t* WF1 = (bf16_t*)(p.ws + WS_WF1); bf16_t* WF2 = (bf16_t*)(p.ws + WS_WF2);
    {
        const int lane = tid & 63, wave = tid >> 6;
        LAS float* scr = tile + wave * (64 * 33);
        for (int it = blockIdx.x * 8 + wave; it < 13056; it += gridDim.x * 8) {
            const int l = it / 6528; int r = it % 6528; int kind, nb, kb, K, Nsrc; const float* W; bf16_t* dst;
            if (r < 1792) { kind = 0; nb = r % 112; kb = r / 112; K = 1024; Nsrc = 3552; W = pin(p, 5) + (size_t)l * 1024 * 3552; dst = WIN + (size_t)l * NIN * 1024; }
            else if (r < 2304) { r -= 1792; kind = 1; nb = r % 32; kb = r / 32; K = 1024; Nsrc = 1024; W = pin(p, 6) + (size_t)l * 1024 * 1024; dst = WOUT + (size_t)l * 1024 * 1024; }
            else if (r < 5120) { r -= 2304; kind = 2; nb = r % 176; kb = r / 176; K = 1024; Nsrc = 5632; W = pin(p, 29) + (size_t)l * 1024 * 5632; dst = WF1 + (size_t)l * 5632 * 1024; }
            else { r -= 5120; kind = 3; nb = r % 32; kb = r / 32; K = 2816; Nsrc = 1024; W = pin(p, 30) + (size_t)l * 2816 * 1024; dst = WF2 + (size_t)l * 1024 * 2816; }
            const int k0 = 64 * kb, n0 = 32 * nb; const int sc = src_col(kind, n0 + (lane & 31));
            float vals[32];
#pragma unroll
            for (int i = 0; i < 32; ++i) { const int kk = 2 * i + (lane >> 5); vals[i] = (sc >= 0) ? W[(size_t)(k0 + kk) * Nsrc + sc] : 0.f; }
#pragma unroll
            for (int i = 0; i < 32; ++i) { const int kk = 2 * i + (lane >> 5); scr[kk * 33 + (lane & 31)] = vals[i]; }
            const int c8 = lane & 7;
#pragma unroll
            for (int j = 0; j < 4; ++j) { const int n = (lane >> 3) + 8 * j; const LAS float* s = scr + (8 * c8) * 33 + n;
                u32x4 o; o.x = pk2(s[0 * 33], s[1 * 33]); o.y = pk2(s[2 * 33], s[3 * 33]); o.z = pk2(s[4 * 33], s[5 * 33]); o.w = pk2(s[6 * 33], s[7 * 33]);
                *(u32x4*)(dst + (size_t)(n0 + n) * K + k0 + 8 * c8) = o; }
        }
    }
    {
        bf16_t* BT2 = (bf16_t*)(p.ws + WS_BT2);
        for (int idx = blockIdx.x * 512 + tid; idx < 2 * N2 * A2K; idx += gridDim.x * 512) {
            const int l = idx / (N2 * A2K), rem = idx % (N2 * A2K), n = rem / A2K, k = rem % A2K, pn = n >> 8, cc = n & 255;
            float v = 0.f;
            if (pn < 4) { const int dir = pn >> 1, gate = cc >> 7, c = (pn & 1) * 128 + (cc & 127), nb = c >> 6, o = c & 63;
                if (k < 256 && (k >> 6) == nb) v = pin(p, 9)[((size_t)((((l * 2 + dir) * 2 + gate) * 4 + nb) * 64 + (k & 63))) * 64 + o]; }
            else if (pn < 8) { const int q = pn - 4, kind = q >> 1, d = q & 1, kb = 256 + kind * 64 + d * 32;
                if (k >= kb && k < kb + 32) v = (kind ? pin(p, 22) : pin(p, 20))[(size_t)((l * 2 + d) * 32 + (k - kb)) * 256 + cc]; }
            else { if (k >= 384) v = pin(p, 23)[(size_t)(l * 64 + (k - 384)) * 256 + cc]; }
            BT2[idx] = f2bf(v);
        }
        if (DBG_PROBE && blockIdx.x == 0 && tid < 32) ((unsigned*)(p.ws + WS_DBG))[tid] = 0u;
        if (blockIdx.x == 0) for (int i = tid; i < 1024; i += 512) ((float*)(p.ws + WS_SPT))[i] = -8.f * softplusf_(-pin(p, 11)[i]);
    }
}
__device__ __forceinline__ void row_pass(int wv, const bf16_t* O, const float* g1, const float* xres_f, const bf16_t* xres_b, float* xout_f, bf16_t* xout_b, const float* g2, bf16_t* hb) {
    const int tid = otid(wv); const int lane = tid & 63, gw = blockIdx.x * 8 + (tid >> 6), nw = gridDim.x * 8;
    f32x4 g1v[4], g2v[4];
#pragma unroll
    for (int j = 0; j < 4; ++j) { g1v[j] = g1 ? *((const f32x4*)g1 + lane + 64 * j) : (f32x4){0.f, 0.f, 0.f, 0.f}; g2v[j] = g2 ? *((const f32x4*)g2 + lane + 64 * j) : (f32x4){0.f, 0.f, 0.f, 0.f}; }
    u32x4 xf[4]; u32x2 xb[4], ob[4];
#define RP_LOAD(ROW) do { const int _r = (ROW) < T_TOK ? (ROW) : gw; \
        if (xres_f) { const u32x4* xp = (const u32x4*)(xres_f + (size_t)_r * DM) + lane; _Pragma("unroll") for (int j = 0; j < 4; ++j) xf[j] = xp[64 * j]; } \
        else { const bf16_t* xp = xres_b + (size_t)_r * DM + 4 * lane; _Pragma("unroll") for (int j = 0; j < 4; ++j) xb[j] = *(const u32x2*)(xp + 256 * j); } \
        if (O) { const bf16_t* op = O + (size_t)_r * DM + 4 * lane; _Pragma("unroll") for (int j = 0; j < 4; ++j) ob[j] = *(const u32x2*)(op + 256 * j); } } while (0)
    RP_LOAD(gw);
    for (int row = gw; row < T_TOK; row += nw) {
        f32x4 v[4], o[4];
#pragma unroll
        for (int j = 0; j < 4; ++j) { if (xres_f) { v[j].x = __uint_as_float(xf[j].x); v[j].y = __uint_as_float(xf[j].y); v[j].z = __uint_as_float(xf[j].z); v[j].w = __uint_as_float(xf[j].w); } else v[j] = bf4(xb[j]);
            if (O) o[j] = bf4(ob[j]); }
        RP_LOAD(row + nw);
        if (O) {
            float ss = 0.f;
#pragma unroll
            for (int j = 0; j < 4; ++j) ss += hsum4(o[j] * o[j]);
            const float inv = rsqrtf(red64(ss) * (1.f / DM) + 1e-6f);
#pragma unroll
            for (int j = 0; j < 4; ++j) v[j] = v[j] + o[j] * inv * g1v[j];
            if (xout_f) { f32x4* xo = (f32x4*)(xout_f + (size_t)row * DM) + lane;
#pragma unroll
                for (int j = 0; j < 4; ++j) xo[64 * j] = v[j]; }
            else { bf16_t* xo = xout_b + (size_t)row * DM + 4 * lane;
#pragma unroll
                for (int j = 0; j < 4; ++j) st4bf(xo + 256 * j, v[j]); }
        }
        if (g2) {
            float ss = 0.f;
#pragma unroll
            for (int j = 0; j < 4; ++j) ss += hsum4(v[j] * v[j]);
            const float inv = rsqrtf(red64(ss) * (1.f / DM) + 1e-6f);
            bf16_t* hp = hb + (size_t)row * DM;
#pragma unroll
            for (int j = 0; j < 4; ++j) st4bf(hp + 4 * (lane + 64 * j), v[j] * inv * g2v[j]);
        }
    }
#undef RP_LOAD
}

__device__ __forceinline__ void phase_prepass(const Params& p, int l, const XcdBarrier& xbar, int wv) {
    const int tid = otid(wv); const int lane = tid & 63, gw = blockIdx.x * 8 + (tid >> 6);
    bf16_t* U = (bf16_t*)(p.ws + WS_U); float* G = (float*)(p.ws + WS_G); bf16_t* A2 = (bf16_t*)((unsigned char*)p.out + OUT_A2);
    const int tok0 = gw * 16, t0 = tok0 & (SEQ - 1), c = 4 * lane;
    const u32x2 zz = (u32x2){0u, 0u};
    u32x2 rq[19], rk[19], rv[19];
#pragma unroll
    for (int i = 0; i < 19; ++i) { const int ts = t0 - 2 + i; const bool ok = (ts >= 0 && ts < SEQ) && gw < 2048;
        const bf16_t* up = U + (size_t)(ok ? tok0 - 2 + i : 0) * NU + 512 + c;
        rq[i] = ok ? *(const u32x2*)up : zz; rk[i] = ok ? *(const u32x2*)(up + 256) : zz; rv[i] = ok ? *(const u32x2*)(up + 512) : zz; }
    xcd_barrier(xbar, wv);
    if (gw >= 2048) return;
    {
        const float* cw = pin(p, 12) + (size_t)l * 4 * 768 + c;
        f32x4 wq[4], wk[4], wv[4];
#pragma unroll
        for (int j = 0; j < 4; ++j) { wq[j] = *(const f32x4*)(cw + j * 768); wk[j] = *(const f32x4*)(cw + j * 768 + 256); wv[j] = *(const f32x4*)(cw + j * 768 + 512); }
#pragma unroll
        for (int i = 0; i < 16; ++i) {
            f32x4 aq = (f32x4){0.f, 0.f, 0.f, 0.f}, ak = aq, av = aq;
#pragma unroll
            for (int j = 0; j < 4; ++j) { aq += wq[j] * bf4(rq[i + j]); ak += wk[j] * bf4(rk[i + j]); av += wv[j] * bf4(rv[i + j]); }
#pragma unroll
            for (int e = 0; e < 4; ++e) { aq[e] = siluf_(aq[e]); ak[e] = siluf_(ak[e]); av[e] = siluf_(av[e]); }
            const float sq = red16(hsum4(aq * aq)), sk = red16(hsum4(ak * ak));
            aq = aq * (rsqrtf(sq + 1e-6f) * 0.125f); ak = ak * rsqrtf(sk + 1e-6f);
            bf16_t* up = U + (size_t)(tok0 + i) * NU + 512 + c;
            st4bf(up, aq); st4bf(up + 256, ak); st4bf(up + 512, av);
        }
    }
    __builtin_amdgcn_sched_barrier(0);
    {
        f32x4 cwv[4];
#pragma unroll
        for (int j = 0; j < 4; ++j) cwv[j] = *(const f32x4*)(pin(p, 7) + (size_t)l * 1024 + j * 256 + c);
        const f32x4 cb = *(const f32x4*)(pin(p, 8) + (size_t)l * 256 + c);
#pragma unroll
        for (int hh = 0; hh < 2; ++hh) {
            u32x2 rx[11];
#pragma unroll
            for (int i = 0; i < 11; ++i) { const int ts = t0 + hh * 8 - 2 + i; rx[i] = (ts >= 0 && ts < SEQ) ? *(const u32x2*)(U + (size_t)(tok0 + hh * 8 - 2 + i) * NU + c) : zz; }
#pragma unroll
            for (int i = 0; i < 8; ++i) { f32x4 xc = cb;
#pragma unroll
                for (int j = 0; j < 4; ++j) xc += cwv[j] * bf4(rx[i + j]);
                st4bf(A2 + (size_t)(tok0 + hh * 8 + i) * A2K + c, xc); }
        }
    }
    __builtin_amdgcn_sched_barrier(0);
    {
        const int ti = lane >> 2, kind = lane & 3;
        float* gp = G + (size_t)(tok0 + ti) * NGATE + kind * 8;
        f32x4 v0 = *(const f32x4*)gp, v1 = *(const f32x4*)(gp + 4);
        float v[8] = {v0.x, v0.y, v0.z, v0.w, v1.x, v1.y, v1.z, v1.w};
#pragma unroll
        for (int e = 0; e < 8; ++e) {
            if (kind == 0) v[e] = __expf(-__expf(pin(p, 13)[l * 8 + e]) * softplusf_(v[e] + pin(p, 14)[l * 8 + e]));
            else if (kind == 1) v[e] = sigmoidf_(v[e]);
            else if (kind == 2) v[e] = __expf(15.f * tanhf_((v[e] + pin(p, 16)[l * 16 + (e >> 2) * 8 + (e & 3)]) * (1.f / 15.f)));
            else v[e] = sigmoidf_(15.f * tanhf_((v[e] + pin(p, 16)[l * 16 + (e >> 2) * 8 + 4 + (e & 3)]) * (1.f / 15.f)));
        }
        *(f32x4*)gp = (f32x4){v[0], v[1], v[2], v[3]}; *(f32x4*)(gp + 4) = (f32x4){v[4], v[5], v[6], v[7]};
    }
    __builtin_amdgcn_sched_barrier(0);
    if (lane < 48) {
        const float* mu0 = pin(p, 18) + (size_t)l * 2 * 960; const float* mu1 = mu0 + 960;
        const int lc = lane * 4;
        const f32x4 ml0 = *(const f32x4*)(mu0 + 768 + lc), ml1 = *(const f32x4*)(mu1 + 768 + lc);
        const f32x4 z4 = (f32x4){0.f, 0.f, 0.f, 0.f};
#pragma unroll
        for (int hh = 0; hh < 2; ++hh) {
            f32x4 gr[10];
#pragma unroll
            for (int i = 0; i < 10; ++i) { const int ts = t0 + hh * 8 - 1 + i; gr[i] = (ts >= 0 && ts < SEQ) ? *(const f32x4*)(G + (size_t)(tok0 + hh * 8 - 1 + i) * NGATE + 32 + lc) : z4; }
#pragma unroll
            for (int i = 0; i < 8; ++i) { const f32x4 cur = gr[i + 1]; f32x4 lr = cur + ml0 * (gr[i] - cur) + ml1 * (gr[i + 2] - cur);
                if (lane < 16) { lr.x = tanhf_(lr.x); lr.y = tanhf_(lr.y); lr.z = tanhf_(lr.z); lr.w = tanhf_(lr.w); }
                else if (lane >= 32) { lr.x = sigmoidf_(lr.x); lr.y = sigmoidf_(lr.y); lr.z = sigmoidf_(lr.z); lr.w = sigmoidf_(lr.w); }
                st4bf(A2 + (size_t)(tok0 + hh * 8 + i) * A2K + 256 + lc, lr); }
        }
    }
}

constexpr int TT = 32, NTILE = SEQ / TT, TS = TT * 64;
__device__ __forceinline__ float sum8l(float x) { x += dppf<0xB1>(x); x += dppf<0x4E>(x); x += dppf<0x141>(x); return x; }
#define TILE_T0(i) ((dir ? NTILE - 1 - (i) : (i)) * TT)

template <int DIRC> __device__ __forceinline__ void gdn_task(const Params& p, int l, int b, int h, LAS float* sm, int wv) {
    constexpr int dir = DIRC;
    constexpr int BUF = 3 * TS + 64;
    const int tid = otid(wv), wave = tid >> 6, lane = tid & 63;
    LAS float* Os0 = sm + 2 * BUF;
    const bf16_t* U = (const bf16_t*)(p.ws + WS_U); const float* G = (const float*)(p.ws + WS_G); bf16_t* SC = (bf16_t*)(p.ws + WS_SC);
    const int ptid = tid - 256, pt = (ptid >> 4) & 15, c4 = (ptid & 15) * 4;
    const int row = (wave & 3) * 16 + (lane >> 2), sub = lane & 3;
    f32x4 s4[4];
#pragma unroll
    for (int j = 0; j < 4; ++j) s4[j] = (f32x4){0.f, 0.f, 0.f, 0.f};
    u32x2 rq[2], rk[2], rv[2]; float gbp[2]; float ga = 0.f, gb = 0.f;
#define GDN_LOADRAW(T0) do { _Pragma("unroll") for (int hh = 0; hh < 2; ++hh) { const size_t tok = (size_t)(b * SEQ + (T0) + pt + 16 * hh); const bf16_t* up = U + tok * NU + 512 + h * 64 + c4; \
            rq[hh] = *(const u32x2*)up; rk[hh] = *(const u32x2*)(up + 256); rv[hh] = *(const u32x2*)(up + 512); gbp[hh] = G[tok * NGATE + 8 + dir * 4 + h]; } \
        if (ptid < TT) { const float* gp = G + (size_t)(b * SEQ + (T0) + ptid) * NGATE; ga = gp[dir * 4 + h]; gb = gp[8 + dir * 4 + h]; } } while (0)
#define GDN_PREP(BI) do { LAS float* Qs = sm + (BI) * BUF; _Pragma("unroll") for (int hh = 0; hh < 2; ++hh) { const int o = (pt + 16 * hh) * 64 + c4; \
            *(LAS f32x4*)(Qs + o) = bf4(rq[hh]); *(LAS f32x4*)(Qs + TS + o) = bf4(rk[hh]); *(LAS f32x4*)(Qs + 2 * TS + o) = bf4(rv[hh]) * gbp[hh]; } \
        if (ptid < TT) { Qs[3 * TS + ptid * 2] = ga; Qs[3 * TS + ptid * 2 + 1] = gb * ga; } } while (0)
#define GDN_WRITEOUT(T0, BI) do { _Pragma("unroll") for (int hh = 0; hh < 2; ++hh) \
        st4bf(SC + (size_t)(b * SEQ + (T0) + pt + 16 * hh) * NSC + 512 + dir * 256 + h * 64 + c4, *(const LAS f32x4*)(Os0 + (BI) * TS + (pt + 16 * hh) * 64 + c4)); } while (0)
    if (wave >= 4) { GDN_LOADRAW(TILE_T0(0)); GDN_PREP(0); GDN_LOADRAW(TILE_T0(1)); }
    __syncthreads();
    for (int kt = 0; kt < NTILE; ++kt) {
        const int cur = kt & 1;
        if (wave < 4) {
            const LAS float* Qs = sm + cur * BUF; const LAS float* Ks = Qs + TS; const LAS float* Vs = Qs + 2 * TS; const LAS float* AB = Qs + 3 * TS; LAS float* Os = Os0 + cur * TS;
            f32x4 kA[4], qA[4], kB[4], qB[4]; float aA, bA, vA, aB, bB, vB;
#define GDN_LD(K_, Q_, A_, B_, V_, I_) do { const int _i = (I_) < TT ? (I_) : TT - 1; const int _tt = dir ? TT - 1 - _i : _i; const LAS float* kp = Ks + _tt * 64 + 4 * sub; const LAS float* qp = Qs + _tt * 64 + 4 * sub; \
        _Pragma("unroll") for (int j = 0; j < 4; ++j) { K_[j] = *(const LAS f32x4*)(kp + 16 * j); Q_[j] = *(const LAS f32x4*)(qp + 16 * j); } \
        A_ = AB[_tt * 2]; B_ = AB[_tt * 2 + 1]; V_ = Vs[_tt * 64 + row]; } while (0)
#define GDN_STEP(K_, Q_, A_, B_, V_, U_) do { f32x4 d4 = s4[0] * K_[0]; d4 += s4[1] * K_[1]; d4 += s4[2] * K_[2]; d4 += s4[3] * K_[3]; \
        const float d = sum4l(hsum4(d4)); const float c = V_ - B_ * d; \
        _Pragma("unroll") for (int j = 0; j < 4; ++j) s4[j] = s4[j] * A_ + K_[j] * c; \
        f32x4 o4 = s4[0] * Q_[0]; o4 += s4[1] * Q_[1]; o4 += s4[2] * Q_[2]; o4 += s4[3] * Q_[3]; \
        const float o = sum4l(hsum4(o4)); okeep = (sub == (U_)) ? o : okeep; } while (0)
            GDN_LD(kA, qA, aA, bA, vA, 0);
            for (int gq = 0; gq < TT / 4; ++gq) {
                float okeep = 0.f; const int i0 = gq * 4;
                GDN_LD(kB, qB, aB, bB, vB, i0 + 1); GDN_STEP(kA, qA, aA, bA, vA, 0);
                GDN_LD(kA, qA, aA, bA, vA, i0 + 2); GDN_STEP(kB, qB, aB, bB, vB, 1);
                GDN_LD(kB, qB, aB, bB, vB, i0 + 3); GDN_STEP(kA, qA, aA, bA, vA, 2);
                GDN_LD(kA, qA, aA, bA, vA, i0 + 4); GDN_STEP(kB, qB, aB, bB, vB, 3);
                const int is = i0 + sub, tts = dir ? TT - 1 - is : is;
                Os[tts * 64 + row] = okeep;
            }
#undef GDN_LD
#undef GDN_STEP
        } else {
            if (kt > 0) GDN_WRITEOUT(TILE_T0(kt - 1), cur ^ 1);
            if (kt + 1 < NTILE) GDN_PREP(cur ^ 1);
            if (kt + 2 < NTILE) GDN_LOADRAW(TILE_T0(kt + 2));
        }
        __syncthreads();
    }
    if (wave >= 4) GDN_WRITEOUT(TILE_T0(NTILE - 1), (NTILE - 1) & 1);
#undef GDN_LOADRAW
#undef GDN_PREP
#undef GDN_WRITEOUT
    __syncthreads();
}

template <int DIRC> __device__ __forceinline__ void mlstm_task(const Params& p, int l, int b, int h, LAS float* sm, int wv) {
    constexpr int dir = DIRC;
    constexpr int BUF = 3 * TS + 64;
    const int tid = otid(wv), wave = tid >> 6, lane = tid & 63;
    LAS float* Os0 = sm + 2 * BUF; LAS float* Dn0 = Os0 + 2 * TS; LAS float* LA0 = Dn0 + 2 * TS; LAS float* LB0 = LA0 + 2 * TS;
    const bf16_t* U = (const bf16_t*)(p.ws + WS_U); const float* G = (const float*)(p.ws + WS_G); bf16_t* SC = (bf16_t*)(p.ws + WS_SC); const bf16_t* ACT = (const bf16_t*)(p.ws + WS_ACT);
    const int ptid = tid - 384, pt = (ptid >> 4) & 7, c4 = (ptid & 15) * 4;
    const int row = (wave & 3) * 16 + (lane >> 2), sub = lane & 3;
    const int lr8 = lane >> 3, lc8 = (lane & 7) * 8;
    constexpr int NQ = TT / 8;
    f32x4 s4[4];
#pragma unroll
    for (int j = 0; j < 4; ++j) s4[j] = (f32x4){0.f, 0.f, 0.f, 0.f};
    float nst = 0.f, hst = 0.f;
    u32x2 rq[4], rk[4], rv[4]; float gip[4]; float gi = 0.f, gf = 0.f; u32x4 la4[NQ], lb4[NQ];
#define ML_LOADRAW(T0) do { _Pragma("unroll") for (int hh = 0; hh < 4; ++hh) { const size_t tok = (size_t)(b * SEQ + (T0) + pt + 8 * hh); const bf16_t* up = U + tok * NU + 1536 + h * 64 + c4; \
            rq[hh] = *(const u32x2*)up; rk[hh] = *(const u32x2*)(up + 256); rv[hh] = *(const u32x2*)(up + 512); gip[hh] = G[tok * NGATE + 16 + dir * 4 + h]; } \
        if (ptid < TT) { const float* gp = G + (size_t)(b * SEQ + (T0) + ptid) * NGATE + 16; gi = gp[dir * 4 + h]; gf = gp[8 + dir * 4 + h]; } } while (0)
#define ML_PREP(BI) do { LAS float* Qs = sm + (BI) * BUF; _Pragma("unroll") for (int hh = 0; hh < 4; ++hh) { const int o = (pt + 8 * hh) * 64 + c4; \
            *(LAS f32x4*)(Qs + o) = bf4(rq[hh]); *(LAS f32x4*)(Qs + TS + o) = bf4(rk[hh]) * 0.125f; *(LAS f32x4*)(Qs + 2 * TS + o) = bf4(rv[hh]) * gip[hh]; } \
        if (ptid < TT) { Qs[3 * TS + ptid * 2] = gf; Qs[3 * TS + ptid * 2 + 1] = gi; } } while (0)
#define ML_WRITEOUT(T0, BI) do { _Pragma("unroll") for (int hh = 0; hh < 4; ++hh) { const int o = (pt + 8 * hh) * 64 + c4; \
            const float den = red16(hsum4(*(const LAS f32x4*)(Dn0 + (BI) * TS + o))); const float sc = __builtin_amdgcn_rcpf(fmaxf(fabsf(den), 1.f)); \
            st4bf(SC + (size_t)(b * SEQ + (T0) + pt + 8 * hh) * NSC + 1024 + dir * 256 + h * 64 + c4, *(const LAS f32x4*)(Os0 + (BI) * TS + o) * sc); } } while (0)
#define LRU_LOADRAW(T0) do { _Pragma("unroll") for (int q = 0; q < NQ; ++q) { const size_t tok = (size_t)(b * SEQ + (T0) + q * 8 + lr8); \
            la4[q] = *(const u32x4*)(ACT + tok * DM + dir * 256 + h * 64 + lc8); lb4[q] = *(const u32x4*)(SC + tok * NSC + dir * 256 + h * 64 + lc8); } } while (0)
#define LRU_PREP(BI) do { _Pragma("unroll") for (int q = 0; q < NQ; ++q) { const int o = (BI) * TS + (q * 8 + lr8) * 64 + lc8; \
            f32x4 a0 = bf4((u32x2){la4[q].x, la4[q].y}), a1 = bf4((u32x2){la4[q].z, la4[q].w}); \
            _Pragma("unroll") for (int e = 0; e < 4; ++e) { a0[e] = 1.f - a0[e]; a1[e] = 1.f - a1[e]; } \
            *(LAS f32x4*)(LA0 + o) = a0; *(LAS f32x4*)(LA0 + o + 4) = a1; \
            *(LAS f32x4*)(LB0 + o) = bf4((u32x2){lb4[q].x, lb4[q].y}); *(LAS f32x4*)(LB0 + o + 4) = bf4((u32x2){lb4[q].z, lb4[q].w}); } } while (0)
#define LRU_WRITEOUT(T0, BI) do { _Pragma("unroll") for (int q = 0; q < NQ; ++q) { const int o = (BI) * TS + (q * 8 + lr8) * 64 + lc8; const f32x4 h0 = *(const LAS f32x4*)(LA0 + o), h1 = *(const LAS f32x4*)(LA0 + o + 4); \
            u32x4 w; w.x = pk2(h0.x, h0.y); w.y = pk2(h0.z, h0.w); w.z = pk2(h1.x, h1.y); w.w = pk2(h1.z, h1.w); \
            *(u32x4*)(SC + (size_t)(b * SEQ + (T0) + q * 8 + lr8) * NSC + dir * 256 + h * 64 + lc8) = w; } } while (0)
    if (wave >= 6) { ML_LOADRAW(TILE_T0(0)); ML_PREP(0); ML_LOADRAW(TILE_T0(1)); }
    else if (wave == 5) { LRU_LOADRAW(TILE_T0(0)); LRU_PREP(0); LRU_LOADRAW(TILE_T0(1)); }
    __syncthreads();
    for (int kt = 0; kt < NTILE; ++kt) {
        const int cur = kt & 1;
        const LAS float* Qs = sm + cur * BUF; const LAS float* Ks = Qs + TS; const LAS float* Vs = Qs + 2 * TS; const LAS float* FI = Qs + 3 * TS;
        if (wave < 4) {
            LAS float* Os = Os0 + cur * TS;
            f32x4 kA[4], qA[4], kB[4], qB[4]; float fA, vA, fB, vB;
#define ML_LD(K_, Q_, F_, V_, I_) do { const int _i = (I_) < TT ? (I_) : TT - 1; const int _tt = dir ? TT - 1 - _i : _i; const LAS float* kp = Ks + _tt * 64 + 4 * sub; const LAS float* qp = Qs + _tt * 64 + 4 * sub; \
        _Pragma("unroll") for (int j = 0; j < 4; ++j) { K_[j] = *(const LAS f32x4*)(kp + 16 * j); Q_[j] = *(const LAS f32x4*)(qp + 16 * j); } \
        F_ = FI[_tt * 2]; V_ = Vs[_tt * 64 + row]; } while (0)
#define ML_STEP(K_, Q_, F_, V_, U_) do { _Pragma("unroll") for (int j = 0; j < 4; ++j) s4[j] = s4[j] * F_ + K_[j] * V_; \
        f32x4 o4 = s4[0] * Q_[0]; o4 += s4[1] * Q_[1]; o4 += s4[2] * Q_[2]; o4 += s4[3] * Q_[3]; \
        const float o = sum4l(hsum4(o4)); okeep = (sub == (U_)) ? o : okeep; } while (0)
            ML_LD(kA, qA, fA, vA, 0);
            for (int gq = 0; gq < TT / 4; ++gq) {
                float okeep = 0.f; const int i0 = gq * 4;
                ML_LD(kB, qB, fB, vB, i0 + 1); ML_STEP(kA, qA, fA, vA, 0);
                ML_LD(kA, qA, fA, vA, i0 + 2); ML_STEP(kB, qB, fB, vB, 1);
                ML_LD(kB, qB, fB, vB, i0 + 3); ML_STEP(kA, qA, fA, vA, 2);
                ML_LD(kA, qA, fA, vA, i0 + 4); ML_STEP(kB, qB, fB, vB, 3);
                const int is = i0 + sub, tts = dir ? TT - 1 - is : is;
                Os[tts * 64 + row] = okeep;
            }
#undef ML_LD
#undef ML_STEP
        } else if (wave == 4) {
            LAS float* Dn = Dn0 + cur * TS;
#pragma unroll 8
            for (int i = 0; i < TT; ++i) { const int tt = dir ? TT - 1 - i : i;
                nst = nst * FI[tt * 2] + FI[tt * 2 + 1] * Ks[tt * 64 + lane];
                Dn[tt * 64 + lane] = nst * Qs[tt * 64 + lane]; }
        } else if (wave == 5) {
            if (kt > 0) LRU_WRITEOUT(TILE_T0(kt - 1), cur ^ 1);
            if (kt + 1 < NTILE) LRU_PREP(cur ^ 1);
            if (kt + 2 < NTILE) LRU_LOADRAW(TILE_T0(kt + 2));
            LAS float* LA = LA0 + cur * TS; const LAS float* LB = LB0 + cur * TS;
#pragma unroll 8
            for (int i = 0; i < TT; ++i) { const int tt = dir ? TT - 1 - i : i; hst = LA[tt * 64 + lane] * hst + LB[tt * 64 + lane]; LA[tt * 64 + lane] = hst; }
        } else {
            if (kt > 0) ML_WRITEOUT(TILE_T0(kt - 1), cur ^ 1);
            if (kt + 1 < NTILE) ML_PREP(cur ^ 1);
            if (kt + 2 < NTILE) ML_LOADRAW(TILE_T0(kt + 2));
        }
        __syncthreads();
    }
    if (wave >= 6) ML_WRITEOUT(TILE_T0(NTILE - 1), (NTILE - 1) & 1);
    else if (wave == 5) LRU_WRITEOUT(TILE_T0(NTILE - 1), (NTILE - 1) & 1);
#undef ML_LOADRAW
#undef ML_PREP
#undef ML_WRITEOUT
#undef LRU_LOADRAW
#undef LRU_PREP
#undef LRU_WRITEOUT
    __syncthreads();
}

template <int DIRC> __device__ __forceinline__ void rwkv_task(const Params& p, int l, int b, int h, int half, LAS float* sm, int wv) {
    constexpr int dir = DIRC;
    constexpr int BUF = 6 * TS;
    const int tid = otid(wv), wave = tid >> 6, lane = tid & 63;
    LAS float* Os0 = sm + 2 * BUF;
    const bf16_t* U = (const bf16_t*)(p.ws + WS_U); const bf16_t* Gb = (const bf16_t*)(p.ws + WS_G); bf16_t* SC = (bf16_t*)(p.ws + WS_SC); const bf16_t* ACT = (const bf16_t*)(p.ws + WS_ACT);
    const int ptid = tid - 256, pt = (ptid >> 4) & 15, c4 = (ptid & 15) * 4, hc = h * 64 + c4;
    const float* mu0 = pin(p, 18) + (size_t)l * 2 * 960; const float* mu1 = mu0 + 960;
    const f32x4 mr0 = *(const f32x4*)(mu0 + hc), mr1 = *(const f32x4*)(mu1 + hc), mk0 = *(const f32x4*)(mu0 + 256 + hc), mk1 = *(const f32x4*)(mu1 + 256 + hc),
                mv0 = *(const f32x4*)(mu0 + 512 + hc), mv1 = *(const f32x4*)(mu1 + 512 + hc);
    const f32x4 kkv = *(const f32x4*)(pin(p, 24) + (size_t)l * 256 + hc), kav = *(const f32x4*)(pin(p, 25) + (size_t)l * 256 + hc);
    const int row = half * 32 + (wave & 3) * 8 + (lane >> 3), sub = lane & 7;
    f32x4 s4[2];
    s4[0] = (f32x4){0.f, 0.f, 0.f, 0.f}; s4[1] = s4[0];
    const u32x2 zz = (u32x2){0u, 0u};
    u32x2 rc[2], rp[2], rn[2], kc[2], kp_[2], kn[2], vc[2], vp[2], vn[2], ew[2], aa[2];
#define RW_LOADRAW(T0) do { _Pragma("unroll") for (int hh = 0; hh < 2; ++hh) { const int _t = (T0) + pt + 16 * hh; const bool hp = _t > 0, hn = _t < SEQ - 1; const size_t tok = (size_t)(b * SEQ + _t); \
        const bf16_t* up = U + tok * NU + 2560 + hc; \
        rc[hh] = *(const u32x2*)up; rp[hh] = hp ? *(const u32x2*)(up - NU) : zz; rn[hh] = hn ? *(const u32x2*)(up + NU) : zz; \
        kc[hh] = *(const u32x2*)(up + 256); kp_[hh] = hp ? *(const u32x2*)(up + 256 - NU) : zz; kn[hh] = hn ? *(const u32x2*)(up + 256 + NU) : zz; \
        vc[hh] = *(const u32x2*)(up + 512); vp[hh] = hp ? *(const u32x2*)(up + 512 - NU) : zz; vn[hh] = hn ? *(const u32x2*)(up + 512 + NU) : zz; \
        ew[hh] = dir ? *(const u32x2*)(Gb + tok * 512 + 64 + hc) : *(const u32x2*)(U + tok * NU + hc); \
        aa[hh] = *(const u32x2*)(ACT + tok * DM + 512 + dir * 256 + hc); } } while (0)
#define RW_PREP(BI) do { LAS float* Rs = sm + (BI) * BUF; _Pragma("unroll") for (int hh = 0; hh < 2; ++hh) { \
            f32x4 c = bf4(rc[hh]); const f32x4 rr = c + mr0 * (bf4(rp[hh]) - c) + mr1 * (bf4(rn[hh]) - c); \
            c = bf4(kc[hh]); const f32x4 kk = c + mk0 * (bf4(kp_[hh]) - c) + mk1 * (bf4(kn[hh]) - c); \
            c = bf4(vc[hh]); const f32x4 vv = c + mv0 * (bf4(vp[hh]) - c) + mv1 * (bf4(vn[hh]) - c); \
            f32x4 w = bf4(ew[hh]); const f32x4 a = bf4(aa[hh]); \
            _Pragma("unroll") for (int e = 0; e < 4; ++e) w[e] = __expf(w[e]); \
            f32x4 kn_ = kk * kkv; const float ss = red16(hsum4(kn_ * kn_)); kn_ = kn_ * rsqrtf(ss + 1e-6f); \
            const int o = (pt + 16 * hh) * 64 + c4; \
            *(LAS f32x4*)(Rs + o) = rr; *(LAS f32x4*)(Rs + TS + o) = w; *(LAS f32x4*)(Rs + 2 * TS + o) = kn_; \
            *(LAS f32x4*)(Rs + 3 * TS + o) = kn_ * a; *(LAS f32x4*)(Rs + 4 * TS + o) = kk * (1.f + (a - 1.f) * kav); *(LAS f32x4*)(Rs + 5 * TS + o) = vv; } } while (0)
#define RW_WRITEOUT(T0, BI) do { const int t = (ptid >> 3) & 31, r4 = half * 32 + (ptid & 7) * 4; const f32x4 o = *(const LAS f32x4*)(Os0 + (BI) * TS + t * 64 + r4); \
        u32x2 w; w.x = pk2(o.x, o.y); w.y = pk2(o.z, o.w); *(u32x2*)(SC + (size_t)(b * SEQ + (T0) + t) * NSC + 1536 + dir * 256 + h * 64 + r4) = w; } while (0)
    if (wave >= 4) { RW_LOADRAW(TILE_T0(0)); RW_PREP(0); RW_LOADRAW(TILE_T0(1)); }
    __syncthreads();
    for (int kt = 0; kt < NTILE; ++kt) {
        const int cur = kt & 1;
        if (wave < 4) {
            const LAS float* Rs = sm + cur * BUF; const LAS float* Ws = Rs + TS; const LAS float* KKs = Rs + 2 * TS; const LAS float* KAs = Rs + 3 * TS; const LAS float* KDs = Rs + 4 * TS; const LAS float* Vs = Rs + 5 * TS;
            LAS float* Os = Os0 + cur * TS;
            f32x4 wA[2], nA[2], aA[2], dA[2], rA[2], wB[2], nB[2], aB[2], dB[2], rB[2]; float vA, vB;
#define RW_LD(W_, N_, A_, D_, R_, V_, I_) do { const int _i = (I_) < TT ? (I_) : TT - 1; const int _tt = dir ? TT - 1 - _i : _i; const int o = _tt * 64 + 4 * sub; \
        _Pragma("unroll") for (int j = 0; j < 2; ++j) { W_[j] = *(const LAS f32x4*)(Ws + o + 32 * j); N_[j] = *(const LAS f32x4*)(KKs + o + 32 * j); A_[j] = *(const LAS f32x4*)(KAs + o + 32 * j); \
            D_[j] = *(const LAS f32x4*)(KDs + o + 32 * j); R_[j] = *(const LAS f32x4*)(Rs + o + 32 * j); } \
        V_ = Vs[_tt * 64 + row]; } while (0)
#define RW_STEP(W_, N_, A_, D_, R_, V_, U_) do { f32x4 x4 = s4[0] * N_[0]; x4 += s4[1] * N_[1]; const float sa = -sum8l(hsum4(x4)); \
        _Pragma("unroll") for (int j = 0; j < 2; ++j) s4[j] = s4[j] * W_[j] + A_[j] * sa + D_[j] * V_; \
        f32x4 o4 = s4[0] * R_[0]; o4 += s4[1] * R_[1]; const float o = sum8l(hsum4(o4)); okeep = (sub == (U_)) ? o : okeep; } while (0)
            RW_LD(wA, nA, aA, dA, rA, vA, 0);
            for (int gq = 0; gq < TT / 8; ++gq) {
                float okeep = 0.f; const int i0 = gq * 8;
                RW_LD(wB, nB, aB, dB, rB, vB, i0 + 1); RW_STEP(wA, nA, aA, dA, rA, vA, 0);
                RW_LD(wA, nA, aA, dA, rA, vA, i0 + 2); RW_STEP(wB, nB, aB, dB, rB, vB, 1);
                RW_LD(wB, nB, aB, dB, rB, vB, i0 + 3); RW_STEP(wA, nA, aA, dA, rA, vA, 2);
                RW_LD(wA, nA, aA, dA, rA, vA, i0 + 4); RW_STEP(wB, nB, aB, dB, rB, vB, 3);
                RW_LD(wB, nB, aB, dB, rB, vB, i0 + 5); RW_STEP(wA, nA, aA, dA, rA, vA, 4);
                RW_LD(wA, nA, aA, dA, rA, vA, i0 + 6); RW_STEP(wB, nB, aB, dB, rB, vB, 5);
                RW_LD(wB, nB, aB, dB, rB, vB, i0 + 7); RW_STEP(wA, nA, aA, dA, rA, vA, 6);
                RW_LD(wA, nA, aA, dA, rA, vA, i0 + 8); RW_STEP(wB, nB, aB, dB, rB, vB, 7);
                const int is = i0 + sub, tts = dir ? TT - 1 - is : is;
                Os[tts * 64 + row] = okeep;
            }
#undef RW_LD
#undef RW_STEP
        } else {
            if (kt > 0) RW_WRITEOUT(TILE_T0(kt - 1), cur ^ 1);
            if (kt + 1 < NTILE) RW_PREP(cur ^ 1);
            if (kt + 2 < NTILE) RW_LOADRAW(TILE_T0(kt + 2));
        }
        __syncthreads();
    }
    if (wave >= 4) RW_WRITEOUT(TILE_T0(NTILE - 1), (NTILE - 1) & 1);
#undef RW_LOADRAW
#undef RW_PREP
#undef RW_WRITEOUT
    __syncthreads();
}

__device__ __forceinline__ void phase_scan(const Params& p, int l, LAS float* sm, int wv) {
    for (int task = blockIdx.x; task < 256; task += gridDim.x) {
        if (DBG_PROBE && otid(wv) == 0) ((LAS unsigned*)sm)[32760] = (unsigned)__builtin_amdgcn_s_memrealtime();
        if (task < 128) { const int half = task & 1, rest = task >> 1; if ((rest >> 3) & 1) rwkv_task<1>(p, l, rest & 7, rest >> 4, half, sm, wv); else rwkv_task<0>(p, l, rest & 7, rest >> 4, half, sm, wv); }
        else if (task < 192) { const int rest = task - 128; if ((rest >> 3) & 1) gdn_task<1>(p, l, rest & 7, rest >> 4, sm, wv); else gdn_task<0>(p, l, rest & 7, rest >> 4, sm, wv); }
        else { const int rest = task - 192; if ((rest >> 3) & 1) mlstm_task<1>(p, l, rest & 7, rest >> 4, sm, wv); else mlstm_task<0>(p, l, rest & 7, rest >> 4, sm, wv); }
        if (DBG_PROBE && l == 0 && otid(wv) == 0) { const unsigned dt = (unsigned)__builtin_amdgcn_s_memrealtime() - ((LAS unsigned*)sm)[32760]; atomicMax((unsigned*)(p.ws + WS_DBG) + (task < 128 ? 1 : (task < 192 ? 2 : 3)), dt); }
    }
}

struct FinRaw { u32x2 s[8], yb, z, og, r[3], k[3], v[3], gt; };
__device__ __forceinline__ void fin_load(FinRaw& R, const bf16_t* U, const bf16_t* GT, const bf16_t* SC, int tok, int c, int lane) {
    const int t = tok & (SEQ - 1); const bool hp = t > 0, hn = t < SEQ - 1; const u32x2 zz = (u32x2){0u, 0u};
    const bf16_t* u = U + (size_t)tok * NU; const bf16_t* sc = SC + (size_t)tok * NSC;
#pragma unroll
    for (int i = 0; i < 8; ++i) R.s[i] = *(const u32x2*)(sc + i * 256 + c);
    R.yb = *(const u32x2*)(u + 256 + c); R.z = *(const u32x2*)(u + 1280 + c); R.og = *(const u32x2*)(u + 2304 + c);
    const bf16_t* up = u + 2560 + c;
    R.r[0] = *(const u32x2*)up; R.r[1] = hp ? *(const u32x2*)(up - NU) : zz; R.r[2] = hn ? *(const u32x2*)(up + NU) : zz;
    R.k[0] = *(const u32x2*)(up + 256); R.k[1] = hp ? *(const u32x2*)(up + 256 - NU) : zz; R.k[2] = hn ? *(const u32x2*)(up + 256 + NU) : zz;
    R.v[0] = *(const u32x2*)(up + 512); R.v[1] = hp ? *(const u32x2*)(up + 512 - NU) : zz; R.v[2] = hn ? *(const u32x2*)(up + 512 + NU) : zz;
    R.gt = *(const u32x2*)(GT + (size_t)tok * 256 + c);
}
__device__ __forceinline__ void phase_finalize(const Params& p, int l, LAS float* sm, int wv) {
    const int tid = otid(wv), lane = tid & 63, wave = tid >> 6;
    const bf16_t* U = (const bf16_t*)(p.ws + WS_U); const bf16_t* GT = (const bf16_t*)((const unsigned char*)p.out + OUT_GT); const bf16_t* SC = (const bf16_t*)(p.ws + WS_SC); bf16_t* Y = (bf16_t*)(p.ws + WS_ACT);
    const int c = lane * 4, hc = c & 63;
    const f32x4 gdn_g = *(const f32x4*)(pin(p, 15) + (size_t)l * 64 + hc), ml_g = *(const f32x4*)(pin(p, 17) + (size_t)l * 256 + c);
    const float* mu0 = pin(p, 18) + (size_t)l * 2 * 960; const float* mu1 = mu0 + 960;
    const f32x4 mr0 = *(const f32x4*)(mu0 + c), mr1 = *(const f32x4*)(mu1 + c), mk0 = *(const f32x4*)(mu0 + 256 + c), mk1 = *(const f32x4*)(mu1 + 256 + c),
                mv0 = *(const f32x4*)(mu0 + 512 + c), mv1 = *(const f32x4*)(mu1 + 512 + c);
    const f32x4 rk = *(const f32x4*)(pin(p, 26) + (size_t)l * 256 + c), gnw = *(const f32x4*)(pin(p, 27) + (size_t)l * 256 + c), gnb = *(const f32x4*)(pin(p, 28) + (size_t)l * 256 + c);
    const f32x4 z4 = (f32x4){0.f, 0.f, 0.f, 0.f};
    const int gw = blockIdx.x * 8 + wave, nw = gridDim.x * 8;
    for (int tok0 = gw; tok0 < T_TOK; tok0 += 4 * nw) {
        FinRaw R[4];
#pragma unroll
        for (int q = 0; q < 4; ++q) fin_load(R[q], U, GT, SC, (tok0 + q * nw < T_TOK) ? tok0 + q * nw : tok0, c, lane);
#pragma unroll
        for (int q = 0; q < 4; ++q) {
            if (tok0 + q * nw >= T_TOK) break;
            const FinRaw& X = R[q]; bf16_t* y = Y + (size_t)(tok0 + q * nw) * DM;
            { const f32x4 hh = bf4(X.s[0]) + bf4(X.s[1]), yb = bf4(X.yb); f32x4 o;
              for (int e = 0; e < 4; ++e) o[e] = hh[e] * gelu_tanh(yb[e]);
              st4bf(y + c, o); }
            { const f32x4 o = bf4(X.s[2]) + bf4(X.s[3]), z = bf4(X.z);
              const float inv = rsqrtf(red16(hsum4(o * o)) * (1.f / 64.f) + 1e-6f); f32x4 r;
              for (int e = 0; e < 4; ++e) r[e] = o[e] * inv * gdn_g[e] * siluf_(z[e]);
              st4bf(y + 256 + c, r); }
            { const f32x4 o = bf4(X.s[4]) + bf4(X.s[5]), og = bf4(X.og);
              const float inv = rsqrtf(red16(hsum4(o * o)) * (1.f / 64.f) + 1e-6f); f32x4 r;
              for (int e = 0; e < 4; ++e) r[e] = o[e] * inv * ml_g[e] * sigmoidf_(og[e]);
              st4bf(y + 512 + c, r); }
            {
                const f32x4 yy = bf4(X.s[6]) + bf4(X.s[7]);
                const float mean = red16(hsum4(yy)) * (1.f / 64.f); const f32x4 dv = yy - mean;
                const float var = red16(hsum4(dv * dv)) * (1.f / 64.f); const float inv = rsqrtf(var + 64e-5f);
                f32x4 cc = bf4(X.r[0]); const f32x4 rr = cc + mr0 * (bf4(X.r[1]) - cc) + mr1 * (bf4(X.r[2]) - cc);
                cc = bf4(X.k[0]); const f32x4 kk = cc + mk0 * (bf4(X.k[1]) - cc) + mk1 * (bf4(X.k[2]) - cc);
                cc = bf4(X.v[0]); const f32x4 vv = cc + mv0 * (bf4(X.v[1]) - cc) + mv1 * (bf4(X.v[2]) - cc);
                const float bsum = red16(hsum4(rr * kk * rk));
                f32x4 o;
                const f32x4 gate = bf4(X.gt);
                for (int e = 0; e < 4; ++e) o[e] = (dv[e] * inv * gnw[e] + gnb[e] + bsum * vv[e]) * gate[e];
                st4bf(y + 768 + c, o);
            }
        }
    }
    __syncthreads();
}

#ifndef EN_GEMM
#define EN_GEMM 1
#endif
#ifndef EN_SCAN
#define EN_SCAN 1
#endif
#ifndef EN_FIN
#define EN_FIN 1
#endif
#ifndef EN_ROW
#define EN_ROW 1
#endif
#ifndef REP_SCAN
#define REP_SCAN 1
#endif
#ifndef REP_GEMM
#define REP_GEMM 1
#endif
#ifndef DBG_PROBE
#define DBG_PROBE 0
#endif
__global__ void __launch_bounds__(512) mega(Params p) {
    extern __shared__ __attribute__((aligned(16))) unsigned char smem[];
    cg::grid_group grid = cg::this_grid();
    const int wv = __builtin_amdgcn_readfirstlane((int)(threadIdx.x >> 6));
    LAS unsigned char* lds = (LAS unsigned char*)smem; LAS float* sm = (LAS float*)smem;
    int repc = 0, repg = 0;
    volatile LAS unsigned* xst = (volatile LAS unsigned*)(lds + 131072);
    if (otid(wv) < 2) xst[otid(wv)] = 0u;
    __syncthreads();
    const XcdBarrier xbar = xcd_barrier_post((unsigned*)(p.ws + WS_BAR), xst, wv);
    for (int ph = p.ph_lo; ph < p.ph_hi; ++ph) {
        if (ph > p.ph_lo) { if (ph == p.ph_lo + 1) grid.sync(); else xcd_barrier(xbar, wv); }
        unsigned char* ws = p.ws; asm volatile("" : "+s"(ws));
        bf16_t* WIN = (bf16_t*)(ws + WS_WIN); bf16_t* WOUT = (bf16_t*)(ws + WS_WOUT); bf16_t* WF1 = (bf16_t*)(ws + WS_WF1); bf16_t* WF2 = (bf16_t*)(ws + WS_WF2);
        bf16_t* Ub = (bf16_t*)(ws + WS_U); float* Gf = (float*)(ws + WS_G); bf16_t* ACT = (bf16_t*)(ws + WS_ACT);
        bf16_t* O1 = (bf16_t*)(ws + WS_U); bf16_t* HD = (bf16_t*)(ws + WS_U); bf16_t* O2 = (bf16_t*)(ws + WS_SC); bf16_t* XB1 = (bf16_t*)(ws + WS_SC + (size_t)T_TOK * DM * 2);
        if (ph == 0) {
            if (DBG_PROBE == 14 && otid(wv) == 0) ((LAS unsigned*)sm)[32761] = (unsigned)__builtin_amdgcn_s_memrealtime();
            phase_convert(p, sm, wv);
            row_pass(wv, nullptr, nullptr, pin(p, 0), nullptr, nullptr, nullptr, pin(p, 1), ACT);
            if (DBG_PROBE == 14) { __syncthreads(); if (otid(wv) == 0) { const unsigned dt = (unsigned)__builtin_amdgcn_s_memrealtime() - ((LAS unsigned*)sm)[32761]; atomicMax((unsigned*)(p.ws + WS_DBG) + 14, dt * 10u); } }
            continue;
        }
        const int l = (ph - 1) / 10, s = (ph - 1) % 10;
        const bool dbg_t = DBG_PROBE >= 4 && l == 0 && s == DBG_PROBE - 4;
        if (dbg_t && otid(wv) == 0) ((LAS unsigned*)sm)[32761] = (unsigned)__builtin_amdgcn_s_memrealtime();
        pg8::StaticOrder S;
        if (REP_GEMM > 1 && (s == 0 || s == 5 || s == 7 || s == 8)) { if (++repg < REP_GEMM) { --ph; } else repg = 0; }
        if (s == 0) { pg8::Gemm g{ACT, WIN + (size_t)l * NIN * DM, T_TOK, NIN, DM}; S.init(g.M, g.N, gridDim.x, blockIdx.x); pg8::EpiU E{Ub, Gf}; pg8::gemm_phase(lds, g, S, E, wv); }
        else if (s == 1) phase_prepass(p, l, xbar, wv);
        else if (s == 2) { pg8::Gemm g{(const bf16_t*)((unsigned char*)p.out + OUT_A2), (const bf16_t*)(ws + WS_BT2) + (size_t)l * N2 * A2K, T_TOK, N2, A2K}; S.init(g.M, g.N, gridDim.x, blockIdx.x);
            pg8::EpiPre E{ws, (unsigned char*)p.out, pin(p, 10) + (size_t)l * 1024, (const float*)(ws + WS_SPT) + (size_t)l * 512, pin(p, 19) + (size_t)l * 512, pin(p, 21) + (size_t)l * 512, wv};
            pg8::gemm_phase<pg8::EpiPre, true>(lds, g, S, E, wv); }
        else if (s == 3) { phase_scan(p, l, sm, wv); if (REP_SCAN > 1) { if (++repc < REP_SCAN) ph -= 2; else repc = 0; } }
        else if (s == 4) phase_finalize(p, l, sm, wv);
        else if (s == 5 || s == 8) { pg8::Gemm g{s == 5 ? ACT : HD, s == 5 ? WOUT + (size_t)l * DM * DM : WF2 + (size_t)l * DM * DFF, T_TOK, DM, s == 5 ? DM : DFF}; S.init(g.M, g.N, gridDim.x, blockIdx.x); pg8::EpiBf E{s == 5 ? O1 : O2, DM}; pg8::gemm_phase(lds, g, S, E, wv); }
        else if (s == 6 || s == 9) { const bool fa = (s == 6);
            row_pass(wv, fa ? O1 : O2, pin(p, fa ? 2 : 4) + (size_t)l * DM, (fa && l == 0) ? pin(p, 0) : nullptr, fa ? (const bf16_t*)p.out : (const bf16_t*)XB1, (!fa && l == 1) ? p.out : nullptr, fa ? XB1 : (bf16_t*)p.out,
                     fa ? pin(p, 3) + (size_t)l * DM : (l == 0 ? pin(p, 1) + DM : nullptr), ACT); }
        else if (s == 7) { pg8::Gemm g{ACT, WF1 + (size_t)l * 2 * DFF * DM, T_TOK, 2 * DFF, DM}; S.init(g.M, g.N, gridDim.x, blockIdx.x); pg8::EpiSwi E{HD}; pg8::gemm_phase(lds, g, S, E, wv); }
        if (dbg_t) { __syncthreads(); if (otid(wv) == 0) { const unsigned dt = (unsigned)__builtin_amdgcn_s_memrealtime() - ((LAS unsigned*)sm)[32761]; atomicMax((unsigned*)(p.ws + WS_DBG) + DBG_PROBE, dt * 10u); } }
    }
    if (DBG_PROBE) { __syncthreads(); if (blockIdx.x == 0 && otid(wv) == 0) { const unsigned v = __hip_atomic_load((const unsigned*)(p.ws + WS_DBG) + DBG_PROBE, __ATOMIC_RELAXED, __HIP_MEMORY_SCOPE_AGENT);
        __builtin_amdgcn_s_waitcnt(0); p.out[0] += (float)(v / 1000u); } }
}

extern "C" void kernel_launch(void* const* d_in, const int* in_sizes, int n_in, void* d_out, int out_size, void* d_ws, size_t ws_size, hipStream_t stream) {
    static int grid_blocks = 0;
    if (grid_blocks == 0) {
        if (n_in != 31 || ws_size < WS_END || out_size != T_TOK * DM) { fprintf(stderr, "kernel_launch: unexpected shapes (n_in %d, ws %zu need %zu, out %d)\n", n_in, ws_size, (size_t)WS_END, out_size); grid_blocks = -1; return; }
        int dev = 0, cus = 0, per_cu = 0;
        (void)hipGetDevice(&dev);
        (void)hipDeviceGetAttribute(&cus, hipDeviceAttributeMultiprocessorCount, dev);
        if (hipFuncSetAttribute((const void*)mega, hipFuncAttributeMaxDynamicSharedMemorySize, LDS_BYTES) != hipSuccess) { fprintf(stderr, "kernel_launch: hipFuncSetAttribute failed\n"); grid_blocks = -1; return; }
        if (hipOccupancyMaxActiveBlocksPerMultiprocessor(&per_cu, (const void*)mega, 512, LDS_BYTES) != hipSuccess || per_cu < 1) { fprintf(stderr, "kernel_launch: occupancy query says %d blocks per CU\n", per_cu); per_cu = 1; (void)hipGetLastError(); }
        grid_blocks = 256;
        (void)per_cu;
    }
    if (grid_blocks < 0) return;
    if (hipMemsetAsync((char*)d_ws + WS_BAR, 0, (size_t)XCD_BAR_WORDS * 4, stream) != hipSuccess) { fprintf(stderr, "kernel_launch: hipMemsetAsync of the barrier words failed\n"); return; }
    Params p{};
    for (int i = 0; i < 31; ++i) p.in[i] = (const float*)d_in[i];
    p.out = (float*)d_out; p.ws = (unsigned char*)d_ws; p.ph_lo = 0; p.ph_hi = 21;
    void* args[] = {&p};
    hipError_t e = hipLaunchCooperativeKernel((const void*)mega, dim3(grid_blocks), dim3(512), args, LDS_BYTES, stream);
    if (e != hipSuccess) fprintf(stderr, "cooperative launch failed: %s (grid %d)\n", hipGetErrorString(e), grid_blocks);
}
```
